# Optimizing an MI355X kernel written in HIP

```python
import math
import jax, jax.numpy as jnp
from jax import lax
import numpy as np

D_MODEL = 1024
BATCH = 8
SEQ = 2048
DEPTH = 2
DEC_BATCH = 128
DEC_SEQ = 8
PAST_LEN = 16384
PAGE_SIZE = 128

D_MIX = D_MODEL
D_CONV = D_MIX // 2
CONV_GROUPS = 8
CONV_W = 31
D_V = D_MIX - D_CONV
GLA_HEADS = 4
D_K = D_V // 2
HEAD_K = D_K // GLA_HEADS
HEAD_V = D_V // GLA_HEADS
GATE_RANK = 16
GATE_NORM = 16.0
CHUNK = 64
EPS = 1e-6
SPLITS_SIZES = (D_CONV, D_CONV, D_CONV, D_K, D_K, D_V, D_V, GATE_RANK)
D_IN = sum(SPLITS_SIZES)
SPLIT_POINTS = tuple(int(s) for s in np.cumsum(SPLITS_SIZES)[:-1])

kernel_name = "hymba_conformer_conv_gla_decoder_step"


def rms_norm(x, g):
    xf = x.astype(jnp.float32)
    y = xf * lax.rsqrt(jnp.mean(xf * xf, axis=-1, keepdims=True) + EPS)
    return (y * g.astype(jnp.float32)).astype(x.dtype)


def group_layer_norm(x, g, b):
    shp = x.shape
    xf = x.astype(jnp.float32).reshape(shp[:-1] + (CONV_GROUPS, shp[-1] // CONV_GROUPS))
    mu = jnp.mean(xf, axis=-1, keepdims=True)
    var = jnp.mean(jnp.square(xf - mu), axis=-1, keepdims=True)
    y = ((xf - mu) * lax.rsqrt(var + EPS)).reshape(shp)
    return (y * g.astype(jnp.float32) + b.astype(jnp.float32)).astype(x.dtype)


def depthwise_causal_conv(u, buf, w, b):
    full = jnp.concatenate([buf.astype(u.dtype), u], axis=1)
    y = lax.conv_general_dilated(full, w[:, None, :].astype(u.dtype), window_strides=(1,),
                                 padding='VALID', dimension_numbers=('NWC', 'WIO', 'NWC'),
                                 feature_group_count=u.shape[-1])
    return y + b.astype(u.dtype), full[:, -(CONV_W - 1):, :]


def gla_chunked(q, k, v, g, S0):
    B, T, H, dk = q.shape
    c = math.gcd(T, CHUNK)
    n = T // c

    def to_chunks(a):
        return a.astype(jnp.float32).reshape(B, n, c, H, a.shape[-1]).transpose(1, 0, 3, 2, 4)

    qc = to_chunks(q) * (dk ** -0.5)
    kc, vc, gc = to_chunks(k), to_chunks(v), to_chunks(g)
    mask = jnp.tril(jnp.ones((c, c), dtype=bool))

    def step(S, inp):
        qi, ki, vi, gi = inp
        bcum = jnp.cumsum(gi, axis=-2)
        q_t = qi * jnp.exp(bcum)
        k_t = ki * jnp.exp(-bcum)
        attn = jnp.where(mask, jnp.einsum('bhtd,bhsd->bhts', q_t, k_t), 0.0)
        o = jnp.einsum('bhtd,bhdv->bhtv', q_t, S) + jnp.einsum('bhts,bhsv->bhtv', attn, vi)
        b_last = bcum[:, :, -1, :]
        k_dec = ki * jnp.exp(b_last[:, :, None, :] - bcum)
        S = S * jnp.exp(b_last)[..., None] + jnp.einsum('bhsd,bhsv->bhdv', k_dec, vi)
        return S, o

    S, o = lax.scan(step, S0.astype(jnp.float32), (qc, kc, vc, gc))
    o = o.transpose(1, 0, 3, 2, 4).reshape(B, T, H, v.shape[-1])
    return o, S


def mixer_layer(x, conv_buf, S0, norm_g, w_in, w_alpha, b_alpha, conv_w, conv_b,
                cn_g, cn_b, w_pw, b_pw, gla_g, w_out):
    B, T, _ = x.shape
    h = rms_norm(x, norm_g)
    proj = jnp.einsum('btd,de->bte', h, w_in.astype(h.dtype))
    a, gl, zc, q, k, v, zg, lr = jnp.split(proj, SPLIT_POINTS, axis=-1)
    u = a * jax.nn.sigmoid(gl)
    cv, new_buf = depthwise_causal_conv(u, conv_buf, conv_w, conv_b)
    cv = jax.nn.silu(group_layer_norm(cv, cn_g, cn_b))
    cv = jnp.einsum('btc,ce->bte', cv, w_pw.astype(cv.dtype)) + b_pw.astype(cv.dtype)
    cv = cv * jax.nn.silu(zc)
    gk = jax.nn.log_sigmoid((jnp.einsum('btr,rk->btk', lr, w_alpha.astype(lr.dtype))
                             + b_alpha.astype(lr.dtype)).astype(jnp.float32)) / GATE_NORM
    o, S = gla_chunked(q.reshape(B, T, GLA_HEADS, HEAD_K), k.reshape(B, T, GLA_HEADS, HEAD_K),
                       v.reshape(B, T, GLA_HEADS, HEAD_V), gk.reshape(B, T, GLA_HEADS, HEAD_K), S0)
    o = o * lax.rsqrt(jnp.mean(o * o, axis=-1, keepdims=True) + EPS) * gla_g.astype(jnp.float32)
    o = o.reshape(B, T, D_V).astype(x.dtype) * jax.nn.silu(zg)
    out = jnp.einsum('bte,ed->btd', jnp.concatenate([cv, o], axis=-1), w_out.astype(x.dtype))
    return x + out, new_buf, S


def setup_inputs(seed: int = 0) -> dict:
    key = jax.random.key(seed)
    ks = jax.random.split(key, 20)
    f = jnp.float32
    nrm = lambda k_, shp, s: jax.random.normal(k_, shp, f) * s
    return {
        "x_prompt": nrm(ks[0], (BATCH, SEQ, D_MODEL), 1.0),
        "x_sample": nrm(ks[1], (DEC_BATCH, DEC_SEQ, D_MODEL), 1.0),
        "cache_conv": nrm(ks[2], (DEPTH, DEC_BATCH, CONV_W - 1, D_CONV), 0.5),
        "state_gla": nrm(ks[3], (DEPTH, DEC_BATCH, GLA_HEADS, HEAD_K, HEAD_V), 0.5),
        "norm_g": 1.0 + nrm(ks[4], (DEPTH, D_MODEL), 0.02),
        "w_in": nrm(ks[5], (DEPTH, D_MODEL, D_IN), D_MODEL ** -0.5),
        "w_alpha": nrm(ks[6], (DEPTH, GATE_RANK, D_K), GATE_RANK ** -0.5),
        "b_alpha": nrm(ks[7], (DEPTH, D_K), 0.1),
        "conv_w": nrm(ks[8], (DEPTH, CONV_W, D_CONV), CONV_W ** -0.5),
        "conv_b": nrm(ks[9], (DEPTH, D_CONV), 0.02),
        "cn_g": 1.0 + nrm(ks[10], (DEPTH, D_CONV), 0.02),
        "cn_b": nrm(ks[11], (DEPTH, D_CONV), 0.02),
        "w_pw": nrm(ks[12], (DEPTH, D_CONV, D_CONV), D_CONV ** -0.5),
        "b_pw": nrm(ks[13], (DEPTH, D_CONV), 0.02),
        "gla_g": 1.0 + nrm(ks[14], (DEPTH, HEAD_V), 0.02),
        "w_out": nrm(ks[15], (DEPTH, D_MIX, D_MODEL), D_MIX ** -0.5),
        "final_g": 1.0 + nrm(ks[16], (D_MODEL,), 0.02),
    }


def reference(x_prompt, x_sample, cache_conv, state_gla, norm_g, w_in, w_alpha, b_alpha,
              conv_w, conv_b, cn_g, cn_b, w_pw, b_pw, gla_g, w_out, final_g):
    hp, hs = x_prompt, x_sample
    conv_p, gla_p, conv_s, gla_s = [], [], [], []
    for l in range(DEPTH):
        lw = (norm_g[l], w_in[l], w_alpha[l], b_alpha[l], conv_w[l], conv_b[l],
              cn_g[l], cn_b[l], w_pw[l], b_pw[l], gla_g[l], w_out[l])
        buf0 = jnp.zeros((BATCH, CONV_W - 1, D_CONV), hp.dtype)
        S0 = jnp.zeros((BATCH, GLA_HEADS, HEAD_K, HEAD_V), jnp.float32)
        hp, bp, Sp = mixer_layer(hp, buf0, S0, *lw)
        hs, bs, Ss = mixer_layer(hs, cache_conv[l], state_gla[l], *lw)
        conv_p.append(bp); gla_p.append(Sp); conv_s.append(bs); gla_s.append(Ss)
    y_prompt = rms_norm(hp, final_g)
    y_sample = rms_norm(hs, final_g)
    return (y_prompt, y_sample, jnp.stack(conv_p), jnp.stack(gla_p), jnp.stack(conv_s), jnp.stack(gla_s))
```

```cpp
#include <hip/hip_runtime.h>
#include <hip/hip_cooperative_groups.h>
#include <cstdint>
#include <cstdio>
namespace cg = cooperative_groups;

#define LAS __attribute__((address_space(3)))
typedef unsigned short bf16_t;
typedef short bf16x8 __attribute__((ext_vector_type(8)));
typedef float f32x4 __attribute__((ext_vector_type(4)));
typedef unsigned u32x2 __attribute__((ext_vector_type(2)));
typedef unsigned u32x4 __attribute__((ext_vector_type(4)));

constexpr int NTOK = 17408, NPROMPT = 16384;
constexpr int SEQ = 2048, BATCH = 8, DEC_B = 128, DEC_T = 8;
constexpr int NIN = 3200;
constexpr float EPS = 1e-6f;

constexpr size_t OFF_WIN  = 0;
constexpr size_t OFF_WPW  = OFF_WIN  + (size_t)2 * NIN * 1024 * 2;
constexpr size_t OFF_WOUT = OFF_WPW  + (size_t)2 * 512 * 512 * 2;
constexpr size_t OFF_BUFA = OFF_WOUT + (size_t)2 * 1024 * 1024 * 2;
constexpr size_t OFF_BUFB = OFF_BUFA + (size_t)NTOK * 1024 * 2;
constexpr size_t OFF_U    = OFF_BUFB + (size_t)NTOK * 1024 * 2;
constexpr size_t OFF_ZC   = OFF_U    + (size_t)NTOK * 512 * 2;
constexpr size_t OFF_Q    = OFF_ZC   + (size_t)NTOK * 512 * 2;
constexpr size_t OFF_K    = OFF_Q    + (size_t)NTOK * 256 * 2;
constexpr size_t OFF_V    = OFF_K    + (size_t)NTOK * 256 * 2;
constexpr size_t OFF_ZG   = OFF_V    + (size_t)NTOK * 512 * 2;
constexpr size_t OFF_LR   = OFF_ZG   + (size_t)NTOK * 512 * 2;
constexpr size_t OFF_CVG  = OFF_LR   + (size_t)NTOK * 16 * 4;
constexpr size_t OFF_DS   = OFF_CVG  + (size_t)NTOK * 512 * 2;
constexpr size_t OFF_SB   = OFF_DS   + (size_t)1024 * 8192 * 4;
constexpr size_t OFF_DEC  = OFF_SB   + (size_t)1024 * 8192 * 2;
constexpr size_t OFF_SSQ  = OFF_DEC  + (size_t)1024 * 64 * 4;
constexpr size_t WS_NEED  = OFF_SSQ  + (size_t)NTOK * 16 * 4;

constexpr size_t OUT_Y    = 0;
constexpr size_t OUT_CCP  = (size_t)NTOK * 1024;
constexpr size_t OUT_SGP  = OUT_CCP + (size_t)2 * 8 * 30 * 512;
constexpr size_t OUT_CCS  = OUT_SGP + (size_t)2 * 8 * 4 * 64 * 128;
constexpr size_t OUT_SGS  = OUT_CCS + (size_t)2 * 128 * 30 * 512;

struct Params {
    const float *x_prompt, *x_sample, *cache_conv, *state_gla, *norm_g, *w_in, *w_alpha, *b_alpha, *conv_w, *conv_b,
                *cn_g, *cn_b, *w_pw, *b_pw, *gla_g, *w_out, *final_g;
    float* out;
    unsigned char* ws;
};

__device__ __forceinline__ unsigned pk2(float lo, float hi) { unsigned r; asm("v_cvt_pk_bf16_f32 %0, %1, %2" : "=v"(r) : "v"(lo), "v"(hi)); return r; }
__device__ __forceinline__ float bf2f(bf16_t h) { return __uint_as_float(((unsigned)h) << 16); }
__device__ __forceinline__ float bflo(unsigned w) { return __uint_as_float(w << 16); }
__device__ __forceinline__ float bfhi(unsigned w) { return __uint_as_float(w & 0xffff0000u); }
__device__ __forceinline__ float sigmoidf_(float x) { return __builtin_amdgcn_rcpf(1.0f + __expf(-x)); }
__device__ __forceinline__ float siluf_(float x) { return x * sigmoidf_(x); }
__device__ __forceinline__ float wave_sum(float v) {
#pragma unroll
    for (int o = 32; o >= 1; o >>= 1) v += __shfl_xor(v, o);
    return v;
}
__device__ __forceinline__ int tid_() { int t = threadIdx.x; asm volatile("" : "+v"(t)); return t; }
__device__ __forceinline__ const float* xrow_in(const Params& p, int row) {
    return row < NPROMPT ? p.x_prompt + (size_t)row * 1024 : p.x_sample + (size_t)(row - NPROMPT) * 1024;
}

template <class Epi>
__device__ __forceinline__ void gemm_unit(const bf16_t* __restrict__ A, int lda, const bf16_t* __restrict__ Bt, int ldb, int K,
                                          int row0, int brow0, LAS unsigned char* lds, const Epi& epi, int pn) {
    const int tid = tid_(), wid = tid >> 6, lane = tid & 63, wr = wid >> 1, wc = wid & 1, fr = lane & 15, fq = lane >> 4;
    f32x4 acc[4][4];
#pragma unroll
    for (int m = 0; m < 4; ++m)
#pragma unroll
        for (int n = 0; n < 4; ++n) acc[m][n] = (f32x4){0.f, 0.f, 0.f, 0.f};
    const bf16_t* ga[2]; const bf16_t* gb[2];
#pragma unroll
    for (int i = 0; i < 2; ++i) { const int b = tid * 16 + i * 4096, r = b >> 6, c = (b & 63) >> 1;
        ga[i] = A + (size_t)(row0 + r) * lda + c; gb[i] = Bt + (size_t)(brow0 + r) * ldb + c; }
    const int nt = K >> 5;
    epi.pre(row0, lds);
#define GEMM_STAGE(t, buf) do { _Pragma("unroll") for (int i = 0; i < 2; ++i) { \
        __builtin_amdgcn_global_load_lds((const unsigned*)(ga[i] + (t) * 32), (LAS unsigned*)(lds + (buf) * 16384 + tid * 16 + i * 4096), 16, 0, 0); \
        __builtin_amdgcn_global_load_lds((const unsigned*)(gb[i] + (t) * 32), (LAS unsigned*)(lds + (buf) * 16384 + 8192 + tid * 16 + i * 4096), 16, 0, 0); } } while (0)
    GEMM_STAGE(0, 0);
#pragma unroll 1
    for (int t = 0; t < nt; ++t) {
        asm volatile("s_waitcnt vmcnt(0)" ::: "memory");
        __syncthreads();
        if (t + 1 < nt) GEMM_STAGE(t + 1, (t + 1) & 1);
        LAS unsigned char* sa = lds + (t & 1) * 16384; LAS unsigned char* sb = sa + 8192;
        bf16x8 af[4], bfr[4];
#pragma unroll
        for (int m = 0; m < 4; ++m) af[m] = *(LAS bf16x8*)(sa + (wr * 64 + m * 16 + fr) * 64 + fq * 16);
#pragma unroll
        for (int n = 0; n < 4; ++n) bfr[n] = *(LAS bf16x8*)(sb + (wc * 64 + n * 16 + fr) * 64 + fq * 16);
#pragma unroll
        for (int m = 0; m < 4; ++m)
#pragma unroll
            for (int n = 0; n < 4; ++n) acc[m][n] = __builtin_amdgcn_mfma_f32_16x16x32_bf16(bfr[n], af[m], acc[m][n], 0, 0, 0);
    }
#undef GEMM_STAGE
    epi(acc, row0, pn, wr, wc, fr, fq, lds);
    __syncthreads();
}

__device__ __forceinline__ bool gemm_next(int it, int nN, int& pm, int& pn, int first_unit_offset = 0) {
    const int nb = gridDim.x, bid = blockIdx.x;
    if ((nb & 7) == 0) {
        const int xcd = bid & 7, j = bid >> 3, nj = nb >> 3; const int u = j + it * nj;
        if (u >= 17 * nN) return false;
        pm = xcd + 8 * (u / nN); pn = u % nN; return true;
    } else {
        const int u = bid + it * nb; if (u >= 136 * nN) return false; pm = u / nN; pn = u % nN; return true;
    }
}

struct EpiIn {
    const float* ssq; bf16_t *U, *ZC, *Q, *Kb, *V, *ZG; float* LR;
    __device__ __forceinline__ void pre(int row0, LAS unsigned char* lds) const {
        LAS float* rs = (LAS float*)(lds + 32768);
        const int tid = tid_();
        if (tid < 128) { const f32x4* s = (const f32x4*)(ssq + (size_t)(row0 + tid) * 16); f32x4 a = s[0], b = s[1], c = s[2], d = s[3];
            float t = (a[0] + a[1] + a[2] + a[3]) + (b[0] + b[1] + b[2] + b[3]) + (c[0] + c[1] + c[2] + c[3]) + (d[0] + d[1] + d[2] + d[3]);
            rs[tid] = rsqrtf(t * (1.0f / 1024.0f) + EPS); }
    }
    __device__ __forceinline__ void operator()(f32x4 (&acc)[4][4], int row0, int pn, int wr, int wc, int fr, int fq, LAS unsigned char* lds) const {
        const LAS float* rs = (const LAS float*)(lds + 32768);
#pragma unroll
        for (int m = 0; m < 4; ++m) {
            const int rl = wr * 64 + m * 16 + fr; const size_t row = (size_t)(row0 + rl); const float r = rs[rl];
            if (pn < 8) {
#pragma unroll
                for (int n = 0; n < 2; ++n) { f32x4 a = acc[m][n] * r, g = acc[m][n + 2] * r; u32x2 w;
                    w.x = pk2(a[0] * sigmoidf_(g[0]), a[1] * sigmoidf_(g[1])); w.y = pk2(a[2] * sigmoidf_(g[2]), a[3] * sigmoidf_(g[3]));
                    *(u32x2*)(U + row * 512 + pn * 64 + wc * 32 + n * 16 + fq * 4) = w; }
            } else if (pn < 12) {
#pragma unroll
                for (int n = 0; n < 4; ++n) { f32x4 a = acc[m][n] * r; u32x2 w; w.x = pk2(siluf_(a[0]), siluf_(a[1])); w.y = pk2(siluf_(a[2]), siluf_(a[3]));
                    *(u32x2*)(ZC + row * 512 + (pn - 8) * 128 + wc * 64 + n * 16 + fq * 4) = w; }
            } else if (pn < 14) {
#pragma unroll
                for (int n = 0; n < 4; ++n) { f32x4 a = acc[m][n] * (r * 0.125f); u32x2 w; w.x = pk2(a[0], a[1]); w.y = pk2(a[2], a[3]);
                    *(u32x2*)(Q + row * 256 + (pn - 12) * 128 + wc * 64 + n * 16 + fq * 4) = w; }
            } else if (pn < 16) {
#pragma unroll
                for (int n = 0; n < 4; ++n) { f32x4 a = acc[m][n] * r; u32x2 w; w.x = pk2(a[0], a[1]); w.y = pk2(a[2], a[3]);
                    *(u32x2*)(Kb + row * 256 + (pn - 14) * 128 + wc * 64 + n * 16 + fq * 4) = w; }
            } else if (pn < 20) {
#pragma unroll
                for (int n = 0; n < 4; ++n) { f32x4 a = acc[m][n] * r; u32x2 w; w.x = pk2(a[0], a[1]); w.y = pk2(a[2], a[3]);
                    *(u32x2*)(V + row * 512 + (pn - 16) * 128 + wc * 64 + n * 16 + fq * 4) = w; }
            } else if (pn < 24) {
#pragma unroll
                for (int n = 0; n < 4; ++n) { f32x4 a = acc[m][n] * r; u32x2 w; w.x = pk2(siluf_(a[0]), siluf_(a[1])); w.y = pk2(siluf_(a[2]), siluf_(a[3]));
                    *(u32x2*)(ZG + row * 512 + (pn - 20) * 128 + wc * 64 + n * 16 + fq * 4) = w; }
            } else {
                if (wc == 0) { f32x4 a = acc[m][0] * r; *(f32x4*)(LR + row * 16 + fq * 4) = a; }
            }
        }
    }
};

struct EpiPw {
    const float* bias; const bf16_t* ZC; bf16_t* MIX;
    __device__ __forceinline__ void pre(int, LAS unsigned char*) const {}
    __device__ __forceinline__ void operator()(f32x4 (&acc)[4][4], int row0, int pn, int wr, int wc, int fr, int fq, LAS unsigned char*) const {
#pragma unroll
        for (int n = 0; n < 4; ++n) {
            const int col = pn * 128 + wc * 64 + n * 16 + fq * 4; const f32x4 b = *(const f32x4*)(bias + col);
#pragma unroll
            for (int m = 0; m < 4; ++m) { const size_t row = (size_t)(row0 + wr * 64 + m * 16 + fr);
                const u32x2 z = *(const u32x2*)(ZC + row * 512 + col); f32x4 a = acc[m][n] + b; u32x2 w;
                w.x = pk2(a[0] * bflo(z.x), a[1] * bfhi(z.x)); w.y = pk2(a[2] * bflo(z.y), a[3] * bfhi(z.y));
                *(u32x2*)(MIX + row * 1024 + col) = w; }
        }
    }
};

struct EpiOut {
    const Params* p; int layer; float* XO; bf16_t* XB; float* ssq;
    __device__ __forceinline__ void pre(int, LAS unsigned char*) const {}
    __device__ __forceinline__ void operator()(f32x4 (&acc)[4][4], int row0, int pn, int wr, int wc, int fr, int fq, LAS unsigned char*) const {
#pragma unroll
        for (int m = 0; m < 4; ++m) {
            const int row = row0 + wr * 64 + m * 16 + fr;
            const float* xr = layer == 0 ? xrow_in(*p, row) : XO + (size_t)row * 1024;
            float s = 0.f;
#pragma unroll
            for (int n = 0; n < 4; ++n) { const int col = pn * 128 + wc * 64 + n * 16 + fq * 4;
                f32x4 a = acc[m][n] + *(const f32x4*)(xr + col);
                *(f32x4*)(XO + (size_t)row * 1024 + col) = a;
                if (layer == 0) { u32x2 w; w.x = pk2(a[0], a[1]); w.y = pk2(a[2], a[3]); *(u32x2*)(XB + (size_t)row * 1024 + col) = w; }
                s += (a[0] * a[0] + a[1] * a[1]) + (a[2] * a[2] + a[3] * a[3]); }
            s += __shfl_xor(s, 16); s += __shfl_xor(s, 32);
            if (fq == 0) ssq[(size_t)row * 16 + pn * 2 + wc] = s;
        }
    }
};

__device__ __forceinline__ int inproj_src_col(int r) {
    if (r < 1024) { const int T = r >> 7, within = r & 127, wc = within >> 6, idx = within & 63, f = idx >> 4, i = idx & 15;
        const int ch = T * 64 + wc * 32 + (f & 1) * 16 + i; return f < 2 ? ch : 512 + ch; }
    if (r < 3088) return r;
    return -1;
}
__device__ void prep_w_tile(const float* W, int ldw, const float* g, bf16_t* Wt, int K, int r0, int k0, bool permute, LAS unsigned char* lds) {
    LAS float* tile = (LAS float*)lds;
    const int tid = tid_(), rr = tid & 63, r = r0 + rr;
    const int n = permute ? inproj_src_col(r) : r;
#pragma unroll 4
    for (int i = 0; i < 16; ++i) { const int kk = i * 4 + (tid >> 6);
        float v = n >= 0 ? W[(size_t)(k0 + kk) * ldw + n] : 0.f; if (g) v *= g[k0 + kk]; tile[kk * 65 + rr] = v; }
    __syncthreads();
#pragma unroll 4
    for (int i = 0; i < 8; ++i) { const int idx = i * 256 + tid, rr2 = idx >> 5, kp = idx & 31;
        *(unsigned*)(Wt + (size_t)(r0 + rr2) * K + k0 + 2 * kp) = pk2(tile[(2 * kp) * 65 + rr2], tile[(2 * kp + 1) * 65 + rr2]); }
    __syncthreads();
}
__device__ void phase_prep(const Params& p, LAS unsigned char* lds) {
    bf16_t* WIN = (bf16_t*)(p.ws + OFF_WIN); bf16_t* WPW = (bf16_t*)(p.ws + OFF_WPW); bf16_t* WOUT = (bf16_t*)(p.ws + OFF_WOUT);
    bf16_t* XB = (bf16_t*)(p.ws + OFF_BUFA); float* SSQ = (float*)(p.ws + OFF_SSQ);
    const int nb = gridDim.x, bid = blockIdx.x;
    for (int u = bid; u < 2240; u += nb) {
        if (u < 1600) { const int l = u / 800, v = u % 800, rt = v / 16, kt = v % 16;
            prep_w_tile(p.w_in + (size_t)l * 1024 * 3088, 3088, p.norm_g + l * 1024, WIN + (size_t)l * NIN * 1024, 1024, rt * 64, kt * 64, true, lds);
        } else if (u < 1728) { const int w = u - 1600, l = w / 64, v = w % 64, rt = v / 8, kt = v % 8;
            prep_w_tile(p.w_pw + (size_t)l * 512 * 512, 512, nullptr, WPW + (size_t)l * 512 * 512, 512, rt * 64, kt * 64, false, lds);
        } else { const int w = u - 1728, l = w / 256, v = w % 256, rt = v / 16, kt = v % 16;
            prep_w_tile(p.w_out + (size_t)l * 1024 * 1024, 1024, nullptr, WOUT + (size_t)l * 1024 * 1024, 1024, rt * 64, kt * 64, false, lds);
        }
    }
    const int tid0 = tid_(); const int wid = tid0 >> 6, lane = tid0 & 63;
    for (int row = bid * 4 + wid; row < NTOK; row += nb * 4) {
        const float* xr = xrow_in(p, row); float s = 0.f;
#pragma unroll
        for (int i = 0; i < 4; ++i) { const int col = i * 256 + lane * 4; const f32x4 a = *(const f32x4*)(xr + col);
            s += (a[0] * a[0] + a[1] * a[1]) + (a[2] * a[2] + a[3] * a[3]);
            u32x2 w; w.x = pk2(a[0], a[1]); w.y = pk2(a[2], a[3]); *(u32x2*)(XB + (size_t)row * 1024 + col) = w; }
        s = wave_sum(s);
        if (lane < 16) SSQ[(size_t)row * 16 + lane] = lane == 0 ? s : 0.f;
    }
}

template <int NT>
__device__ __forceinline__ void compute_bcum(const Params& p, int layer, int h, const float* LR, int row0, LAS float* G) {
    const int tid = tid_(), d = tid & 63, tq = tid >> 6;
    float wa[16];
#pragma unroll
    for (int r = 0; r < 16; ++r) wa[r] = p.w_alpha[(size_t)layer * 16 * 256 + r * 256 + h * 64 + d];
    const float ba = p.b_alpha[layer * 256 + h * 64 + d];
    constexpr int PER = NT / 4;
#pragma unroll 2
    for (int i = 0; i < PER; ++i) { const int t = tq * PER + i;
        const f32x4* lp = (const f32x4*)(LR + (size_t)(row0 + t) * 16);
        float z = ba;
#pragma unroll
        for (int r4 = 0; r4 < 4; ++r4) { const f32x4 v = lp[r4]; z += v[0] * wa[r4 * 4] + v[1] * wa[r4 * 4 + 1] + v[2] * wa[r4 * 4 + 2] + v[3] * wa[r4 * 4 + 3]; }
        const float ls = fminf(z, 0.f) - log1pf(expf(-fabsf(z)));
        G[t * 64 + d] = ls * (1.0f / 16.0f);
    }
    __syncthreads();
    if (tid < 64) { float run = 0.f;
#pragma unroll 8
        for (int t = 0; t < NT; ++t) { run += G[t * 64 + d]; G[t * 64 + d] = run; } }
    __syncthreads();
}

__device__ void conv_unit(const Params& p, int layer, bool sample, int b_or_pair, int tile, int cs, LAS unsigned char* lds) {
    const bf16_t* U = (const bf16_t*)(p.ws + OFF_U); bf16_t* CVG = (bf16_t*)(p.ws + OFF_CVG);
    LAS bf16_t* ub = (LAS bf16_t*)lds;
    const int tid = tid_(), wid = tid >> 6, lane = tid & 63;
    const int t0 = tile * 64;
    if (!sample) {
        for (int c = tid; c < 94 * 16; c += 256) { const int i = c >> 4, cc = c & 15; const int time = t0 - 30 + i;
            u32x4 v = (u32x4){0u, 0u, 0u, 0u};
            if (time >= 0) v = *(const u32x4*)(U + (size_t)(b_or_pair * SEQ + time) * 512 + cs * 128 + cc * 8);
            *(LAS u32x4*)(ub + i * 128 + cc * 8) = v; }
    } else {
        for (int c = tid; c < 76 * 16; c += 256) { const int i = c >> 4, cc = c & 15; const int sq = i >= 38, ii = i - sq * 38; const int s = b_or_pair * 2 + sq;
            u32x4 v;
            if (ii < 30) { const float* src = p.cache_conv + (((size_t)layer * DEC_B + s) * 30 + ii) * 512 + cs * 128 + cc * 8;
                const f32x4 a = *(const f32x4*)src, bb = *(const f32x4*)(src + 4);
                v.x = pk2(a[0], a[1]); v.y = pk2(a[2], a[3]); v.z = pk2(bb[0], bb[1]); v.w = pk2(bb[2], bb[3]);
                if (ii >= 8) { float* dst = p.out + OUT_CCS + (((size_t)layer * DEC_B + s) * 30 + (ii - 8)) * 512 + cs * 128 + cc * 8;
                    *(f32x4*)dst = a; *(f32x4*)(dst + 4) = bb; }
            } else v = *(const u32x4*)(U + (size_t)(NPROMPT + s * 8 + (ii - 30)) * 512 + cs * 128 + cc * 8);
            *(LAS u32x4*)(ub + i * 128 + cc * 8) = v; }
    }
    __syncthreads();
    const int gi = wid & 1, half = wid >> 1; const int chl = gi * 64 + lane, ch = cs * 128 + chl;
    float w[31];
#pragma unroll
    for (int j = 0; j < 31; ++j) w[j] = p.conv_w[((size_t)layer * 31 + j) * 512 + ch];
    const float cb = p.conv_b[layer * 512 + ch], lg = p.cn_g[layer * 512 + ch], lb = p.cn_b[layer * 512 + ch];
    const int rb = sample ? half * 38 : half * 32;
    const int nsteps = sample ? 2 : 8;
    const size_t grow0 = sample ? (size_t)(NPROMPT + (b_or_pair * 2 + half) * 8) : (size_t)(b_or_pair * SEQ + t0 + half * 32);
    for (int st = 0; st < nsteps; ++st) {
        float vals[34];
#pragma unroll
        for (int i = 0; i < 34; ++i) vals[i] = bf2f(ub[(rb + st * 4 + i) * 128 + chl]);
#pragma unroll
        for (int q = 0; q < 4; ++q) {
            float x = cb;
#pragma unroll
            for (int j = 0; j < 31; ++j) x = fmaf(w[j], vals[q + j], x);
            const float mu = wave_sum(x) * (1.0f / 64.0f); const float dlt = x - mu;
            const float var = wave_sum(dlt * dlt) * (1.0f / 64.0f);
            const float y = dlt * rsqrtf(var + EPS) * lg + lb;
            const float sv = siluf_(y);
            CVG[(grow0 + st * 4 + q) * 512 + ch] = (bf16_t)(pk2(sv, 0.f) & 0xffffu);
        }
    }
    if (!sample) {
        if (tile == 31) { for (int c = tid; c < 30 * 128; c += 256) { const int j = c >> 7, cc = c & 127;
            p.out[OUT_CCP + (((size_t)layer * BATCH + b_or_pair) * 30 + j) * 512 + cs * 128 + cc] = bf2f(ub[(64 + j) * 128 + cc]); } }
    } else {
        for (int c = tid; c < 2 * 8 * 128; c += 256) { const int sq = c >> 10, j = (c >> 7) & 7, cc = c & 127; const int s = b_or_pair * 2 + sq;
            p.out[OUT_CCS + (((size_t)layer * DEC_B + s) * 30 + 22 + j) * 512 + cs * 128 + cc] = bf2f(ub[(sq * 38 + 30 + j) * 128 + cc]); }
    }
    __syncthreads();
}

__device__ void gla_ds_unit(const Params& p, int layer, int unit, LAS unsigned char* lds) {
    const int h = unit & 3, bc = unit >> 2; const int row0 = bc * 64;
    const bf16_t* Kb = (const bf16_t*)(p.ws + OFF_K); const bf16_t* V = (const bf16_t*)(p.ws + OFF_V); const float* LR = (const float*)(p.ws + OFF_LR);
    float* DS = (float*)(p.ws + OFF_DS) + (size_t)unit * 8192; float* DEC = (float*)(p.ws + OFF_DEC) + (size_t)unit * 64;
    LAS float* G = (LAS float*)lds;
    LAS bf16_t* KT = (LAS bf16_t*)(lds + 16384);
    LAS bf16_t* VT = (LAS bf16_t*)(lds + 16384 + 9216);
    compute_bcum<64>(p, layer, h, LR, row0, G);
    const int tid = tid_(), t = tid >> 2, qd = tid & 3;
    {
        const u32x4* src = (const u32x4*)(Kb + (size_t)(row0 + t) * 256 + h * 64 + qd * 16);
        const u32x4 a = src[0], b = src[1]; const unsigned wv[8] = {a.x, a.y, a.z, a.w, b.x, b.y, b.z, b.w};
#pragma unroll
        for (int e = 0; e < 8; ++e) { const int d0 = qd * 16 + 2 * e;
            const float f0 = bflo(wv[e]) * __expf(G[63 * 64 + d0] - G[t * 64 + d0]);
            const float f1 = bfhi(wv[e]) * __expf(G[63 * 64 + d0 + 1] - G[t * 64 + d0 + 1]);
            const unsigned pk = pk2(f0, f1);
            KT[d0 * 72 + t] = (bf16_t)(pk & 0xffffu); KT[(d0 + 1) * 72 + t] = (bf16_t)(pk >> 16); }
        const u32x4* vs = (const u32x4*)(V + (size_t)(row0 + t) * 512 + h * 128 + qd * 32);
#pragma unroll
        for (int c = 0; c < 4; ++c) { const u32x4 a2 = vs[c]; const unsigned w2[4] = {a2.x, a2.y, a2.z, a2.w};
#pragma unroll
            for (int e = 0; e < 4; ++e) { const int dv = qd * 32 + c * 8 + 2 * e;
                VT[dv * 72 + t] = (bf16_t)(w2[e] & 0xffffu); VT[(dv + 1) * 72 + t] = (bf16_t)(w2[e] >> 16); } }
        if (tid < 64) DEC[tid] = __expf(G[63 * 64 + tid]);
    }
    __syncthreads();
    const int wid = tid >> 6, lane = tid & 63, fr = lane & 15, fq = lane >> 4;
    f32x4 acc[2][4];
#pragma unroll
    for (int m = 0; m < 2; ++m)
#pragma unroll
        for (int n = 0; n < 4; ++n) acc[m][n] = (f32x4){0.f, 0.f, 0.f, 0.f};
#pragma unroll
    for (int kk = 0; kk < 2; ++kk) {
        bf16x8 vf[2], kf[4];
#pragma unroll
        for (int m = 0; m < 2; ++m) vf[m] = *(LAS bf16x8*)(VT + (wid * 32 + m * 16 + fr) * 72 + kk * 32 + fq * 8);
#pragma unroll
        for (int n = 0; n < 4; ++n) kf[n] = *(LAS bf16x8*)(KT + (n * 16 + fr) * 72 + kk * 32 + fq * 8);
#pragma unroll
        for (int m = 0; m < 2; ++m)
#pragma unroll
            for (int n = 0; n < 4; ++n) acc[m][n] = __builtin_amdgcn_mfma_f32_16x16x32_bf16(kf[n], vf[m], acc[m][n], 0, 0, 0);
    }
#pragma unroll
    for (int m = 0; m < 2; ++m)
#pragma unroll
        for (int n = 0; n < 4; ++n) *(f32x4*)(DS + (size_t)(wid * 32 + m * 16 + fr) * 64 + n * 16 + fq * 4) = acc[m][n];
    __syncthreads();
}

__device__ void gla_sample_unit(const Params& p, int layer, int unit, LAS unsigned char* lds) {
    const int h = unit & 3, s = unit >> 2; const int row0 = NPROMPT + s * 8;
    const bf16_t* Q = (const bf16_t*)(p.ws + OFF_Q); const bf16_t* Kb = (const bf16_t*)(p.ws + OFF_K); const bf16_t* V = (const bf16_t*)(p.ws + OFF_V);
    const bf16_t* ZG = (const bf16_t*)(p.ws + OFF_ZG); const float* LR = (const float*)(p.ws + OFF_LR); bf16_t* MIX = (bf16_t*)(p.ws + OFF_BUFA);
    const float* S0 = p.state_gla + (((size_t)layer * DEC_B + s) * 4 + h) * 8192;
    float* SN = p.out + OUT_SGS + (((size_t)layer * DEC_B + s) * 4 + h) * 8192;
    LAS float* G = (LAS float*)lds;
    LAS float* QT = G + 512;
    LAS float* KT = QT + 512;
    LAS float* KD = KT + 512;
    LAS float* DCY = KD + 512;
    LAS float* ATT = DCY + 64;
    LAS float* VV = ATT + 64;
    LAS float* OP = VV + 1024;
    LAS float* RED = OP + 2048;
    compute_bcum<8>(p, layer, h, LR, row0, G);
    const int tid = tid_();
#pragma unroll
    for (int i = 0; i < 2; ++i) { const int e = tid + i * 256, t = e >> 6, d = e & 63;
        const float bc = G[t * 64 + d], bl = G[7 * 64 + d];
        const float q = bf2f(Q[(size_t)(row0 + t) * 256 + h * 64 + d]), k = bf2f(Kb[(size_t)(row0 + t) * 256 + h * 64 + d]);
        QT[e] = q * __expf(bc); KT[e] = k * __expf(-bc); KD[e] = k * __expf(bl - bc);
        if (t == 7) DCY[d] = __expf(bl); }
#pragma unroll
    for (int i = 0; i < 4; ++i) { const int e = tid + i * 256, t = e >> 7, v = e & 127; VV[e] = bf2f(V[(size_t)(row0 + t) * 512 + h * 128 + v]); }
    __syncthreads();
    if (tid < 64) { const int t = tid >> 3, s2 = tid & 7; float a = 0.f;
        if (s2 <= t) { for (int d = 0; d < 64; ++d) a += QT[t * 64 + d] * KT[s2 * 64 + d]; }
        ATT[tid] = a; }
    __syncthreads();
    const int vcol = tid & 127, dh = tid >> 7;
    float o[8], v8[8];
#pragma unroll
    for (int t = 0; t < 8; ++t) { o[t] = 0.f; v8[t] = VV[t * 128 + vcol]; }
#pragma unroll 4
    for (int dd = 0; dd < 32; ++dd) { const int d = dh * 32 + dd; const float s0 = S0[d * 128 + vcol];
        float sn = s0 * DCY[d];
#pragma unroll
        for (int t = 0; t < 8; ++t) { o[t] = fmaf(QT[t * 64 + d], s0, o[t]); sn = fmaf(KD[t * 64 + d], v8[t], sn); }
        SN[d * 128 + vcol] = sn; }
    if (dh == 0) {
#pragma unroll
        for (int t = 0; t < 8; ++t)
#pragma unroll
            for (int s2 = 0; s2 < 8; ++s2) o[t] = fmaf(ATT[t * 8 + s2], v8[s2], o[t]);
    }
#pragma unroll
    for (int t = 0; t < 8; ++t) OP[(dh * 8 + t) * 128 + vcol] = o[t];
    __syncthreads();
    float val[4];
#pragma unroll
    for (int i = 0; i < 4; ++i) { const int t = dh * 4 + i; val[i] = OP[t * 128 + vcol] + OP[(8 + t) * 128 + vcol];
        const float ps = wave_sum(val[i] * val[i]); if ((tid & 63) == 0) RED[t * 4 + ((tid >> 6) & 1)] = ps; }
    __syncthreads();
    const float gg = p.gla_g[layer * 128 + vcol];
#pragma unroll
    for (int i = 0; i < 4; ++i) { const int t = dh * 4 + i; const float ms = (RED[t * 4] + RED[t * 4 + 1]) * (1.0f / 128.0f);
        const float zg = bf2f(ZG[(size_t)(row0 + t) * 512 + h * 128 + vcol]);
        const float r = val[i] * rsqrtf(ms + EPS) * gg * zg;
        MIX[(size_t)(row0 + t) * 1024 + 512 + h * 128 + vcol] = (bf16_t)(pk2(r, 0.f) & 0xffffu); }
    __syncthreads();
}

__device__ void scan_unit(const Params& p, int layer, int unit) {
    const int part = unit & 7, h = (unit >> 3) & 3, b = unit >> 5;
    const float* DS = (const float*)(p.ws + OFF_DS); const float* DEC = (const float*)(p.ws + OFF_DEC); bf16_t* SB = (bf16_t*)(p.ws + OFF_SB);
    const int e = part * 1024 + tid_() * 4; const int dk = e & 63, dv = e >> 6;
    f32x4 S = (f32x4){0.f, 0.f, 0.f, 0.f};
#pragma unroll 8
    for (int i = 0; i < 32; ++i) { const size_t ug = (size_t)((b * 32 + i) * 4 + h);
        const f32x4 cur = *(const f32x4*)(DS + ug * 8192 + e); const f32x4 dc = *(const f32x4*)(DEC + ug * 64 + dk);
        u32x2 w; w.x = pk2(S[0], S[1]); w.y = pk2(S[2], S[3]); *(u32x2*)(SB + ug * 8192 + e) = w;
        S = S * dc + cur; }
    float* o = p.out + OUT_SGP + (((size_t)layer * BATCH + b) * 4 + h) * 8192;
#pragma unroll
    for (int j = 0; j < 4; ++j) o[(dk + j) * 128 + dv] = S[j];
}

__device__ void gla_out_unit(const Params& p, int layer, int unit, LAS unsigned char* lds) {
    const int h = unit & 3, bc = unit >> 2; const int row0 = bc * 64;
    const bf16_t* Q = (const bf16_t*)(p.ws + OFF_Q); const bf16_t* Kb = (const bf16_t*)(p.ws + OFF_K); const bf16_t* V = (const bf16_t*)(p.ws + OFF_V);
    const bf16_t* ZG = (const bf16_t*)(p.ws + OFF_ZG); const float* LR = (const float*)(p.ws + OFF_LR); bf16_t* MIX = (bf16_t*)(p.ws + OFF_BUFA);
    const bf16_t* SB = (const bf16_t*)(p.ws + OFF_SB) + (size_t)unit * 8192;
    LAS float* G = (LAS float*)lds;
    LAS bf16_t* QT = (LAS bf16_t*)(lds + 16384);
    LAS bf16_t* KT = (LAS bf16_t*)(lds + 16384 + 9216);
    LAS bf16_t* VT = (LAS bf16_t*)(lds + 16384 + 18432);
    LAS bf16_t* PP = (LAS bf16_t*)(lds + 16384 + 18432 + 18432);
    compute_bcum<64>(p, layer, h, LR, row0, G);
    const int tid = tid_();
    {   const int t = tid >> 2, qd = tid & 3;
        const u32x4* qs = (const u32x4*)(Q + (size_t)(row0 + t) * 256 + h * 64 + qd * 16);
        const u32x4* ks = (const u32x4*)(Kb + (size_t)(row0 + t) * 256 + h * 64 + qd * 16);
        const u32x4 qa = qs[0], qb = qs[1], ka = ks[0], kb = ks[1];
        const unsigned qw[8] = {qa.x, qa.y, qa.z, qa.w, qb.x, qb.y, qb.z, qb.w}; const unsigned kw[8] = {ka.x, ka.y, ka.z, ka.w, kb.x, kb.y, kb.z, kb.w};
        unsigned qo[8], ko[8];
#pragma unroll
        for (int e = 0; e < 8; ++e) { const int d0 = qd * 16 + 2 * e; const float g0 = G[t * 64 + d0], g1 = G[t * 64 + d0 + 1];
            const float e0 = __expf(g0), e1 = __expf(g1);
            qo[e] = pk2(bflo(qw[e]) * e0, bfhi(qw[e]) * e1);
            ko[e] = pk2(bflo(kw[e]) * __builtin_amdgcn_rcpf(e0), bfhi(kw[e]) * __builtin_amdgcn_rcpf(e1)); }
        *(LAS u32x4*)(QT + t * 72 + qd * 16) = (u32x4){qo[0], qo[1], qo[2], qo[3]}; *(LAS u32x4*)(QT + t * 72 + qd * 16 + 8) = (u32x4){qo[4], qo[5], qo[6], qo[7]};
        *(LAS u32x4*)(KT + t * 72 + qd * 16) = (u32x4){ko[0], ko[1], ko[2], ko[3]}; *(LAS u32x4*)(KT + t * 72 + qd * 16 + 8) = (u32x4){ko[4], ko[5], ko[6], ko[7]};
        const u32x4* vs = (const u32x4*)(V + (size_t)(row0 + t) * 512 + h * 128 + qd * 32);
#pragma unroll
        for (int c = 0; c < 4; ++c) { const u32x4 a2 = vs[c]; const unsigned w2[4] = {a2.x, a2.y, a2.z, a2.w};
#pragma unroll
            for (int e = 0; e < 4; ++e) { const int dv = qd * 32 + c * 8 + 2 * e;
                VT[dv * 72 + t] = (bf16_t)(w2[e] & 0xffffu); VT[(dv + 1) * 72 + t] = (bf16_t)(w2[e] >> 16); } }
    }
    __syncthreads();
    const int wid = tid >> 6, lane = tid & 63, fr = lane & 15, fq = lane >> 4;
    LAS bf16_t* PW = PP + wid * 16 * 72;
    {
        bf16x8 qf[2];
#pragma unroll
        for (int kk = 0; kk < 2; ++kk) qf[kk] = *(LAS bf16x8*)(QT + (wid * 16 + fr) * 72 + kk * 32 + fq * 8);
#pragma unroll
        for (int n = 0; n < 4; ++n) {
            f32x4 a = (f32x4){0.f, 0.f, 0.f, 0.f};
#pragma unroll
            for (int kk = 0; kk < 2; ++kk) { const bf16x8 kf = *(LAS bf16x8*)(KT + (n * 16 + fr) * 72 + kk * 32 + fq * 8);
                a = __builtin_amdgcn_mfma_f32_16x16x32_bf16(kf, qf[kk], a, 0, 0, 0); }
            const int tg = wid * 16 + fr, sg = n * 16 + fq * 4;
            u32x2 w; w.x = pk2(sg <= tg ? a[0] : 0.f, sg + 1 <= tg ? a[1] : 0.f); w.y = pk2(sg + 2 <= tg ? a[2] : 0.f, sg + 3 <= tg ? a[3] : 0.f);
            *(LAS u32x2*)(PW + fr * 72 + n * 16 + fq * 4) = w;
        }
    }
    __builtin_amdgcn_s_waitcnt(0xc07f);
    __builtin_amdgcn_wave_barrier();
    f32x4 acc[8];
#pragma unroll
    for (int n = 0; n < 8; ++n) acc[n] = (f32x4){0.f, 0.f, 0.f, 0.f};
#pragma unroll
    for (int kk = 0; kk < 2; ++kk) {
        const bf16x8 qf = *(LAS bf16x8*)(QT + (wid * 16 + fr) * 72 + kk * 32 + fq * 8);
        const bf16x8 pf = *(LAS bf16x8*)(PW + fr * 72 + kk * 32 + fq * 8);
#pragma unroll
        for (int n = 0; n < 8; ++n) {
            const bf16x8 sf = *(const bf16x8*)(SB + (size_t)(n * 16 + fr) * 64 + kk * 32 + fq * 8);
            const bf16x8 vf = *(LAS bf16x8*)(VT + (n * 16 + fr) * 72 + kk * 32 + fq * 8);
            acc[n] = __builtin_amdgcn_mfma_f32_16x16x32_bf16(sf, qf, acc[n], 0, 0, 0);
            acc[n] = __builtin_amdgcn_mfma_f32_16x16x32_bf16(vf, pf, acc[n], 0, 0, 0);
        }
    }
    float ss = 0.f;
#pragma unroll
    for (int n = 0; n < 8; ++n) ss += (acc[n][0] * acc[n][0] + acc[n][1] * acc[n][1]) + (acc[n][2] * acc[n][2] + acc[n][3] * acc[n][3]);
    ss += __shfl_xor(ss, 16); ss += __shfl_xor(ss, 32);
    const float rinv = rsqrtf(ss * (1.0f / 128.0f) + EPS);
    const size_t row = (size_t)(row0 + wid * 16 + fr);
#pragma unroll
    for (int n = 0; n < 8; ++n) { const int dv = n * 16 + fq * 4; const f32x4 gg = *(const f32x4*)(p.gla_g + layer * 128 + dv);
        const u32x2 z = *(const u32x2*)(ZG + row * 512 + h * 128 + dv); u32x2 w;
        w.x = pk2(acc[n][0] * rinv * gg[0] * bflo(z.x), acc[n][1] * rinv * gg[1] * bfhi(z.x));
        w.y = pk2(acc[n][2] * rinv * gg[2] * bflo(z.y), acc[n][3] * rinv * gg[3] * bfhi(z.y));
        *(u32x2*)(MIX + row * 1024 + 512 + h * 128 + dv) = w; }
    __syncthreads();
}

__global__ void __launch_bounds__(256, 2) hymba_mega(Params p) {
    __shared__ __attribute__((aligned(16))) unsigned char smem[65536];
    LAS unsigned char* lds = (LAS unsigned char*)smem;
    cg::grid_group grid = cg::this_grid();
    const int nb = gridDim.x, bid = blockIdx.x;
    float* SSQ = (float*)(p.ws + OFF_SSQ);
    bf16_t* BUFA = (bf16_t*)(p.ws + OFF_BUFA); bf16_t* BUFB = (bf16_t*)(p.ws + OFF_BUFB);

    phase_prep(p, lds);
    grid.sync();
#pragma unroll 1
    for (int layer = 0; layer < 2; ++layer) {
        {
            EpiIn e; e.ssq = SSQ; e.U = (bf16_t*)(p.ws + OFF_U); e.ZC = (bf16_t*)(p.ws + OFF_ZC); e.Q = (bf16_t*)(p.ws + OFF_Q); e.Kb = (bf16_t*)(p.ws + OFF_K);
            e.V = (bf16_t*)(p.ws + OFF_V); e.ZG = (bf16_t*)(p.ws + OFF_ZG); e.LR = (float*)(p.ws + OFF_LR);
            const bf16_t* A = layer == 0 ? BUFA : BUFB; const bf16_t* Bt = (const bf16_t*)(p.ws + OFF_WIN) + (size_t)layer * NIN * 1024;
            int pm, pn;
            for (int it = 0; gemm_next(it, 25, pm, pn); ++it) gemm_unit(A, 1024, Bt, 1024, 1024, pm * 128, pn * 128, lds, e, pn);
        }
        grid.sync();
        for (int u = bid; u < 2816; u += nb) {
            if (u < 1024) gla_ds_unit(p, layer, u, lds);
            else if (u < 2048) { const int v = u - 1024; conv_unit(p, layer, false, v >> 7, (v >> 2) & 31, v & 3, lds); }
            else if (u < 2304) { const int v = u - 2048; conv_unit(p, layer, true, v >> 2, 0, v & 3, lds); }
            else gla_sample_unit(p, layer, u - 2304, lds);
        }
        grid.sync();
        {
            for (int u = bid; u < 256; u += nb) scan_unit(p, layer, u);
            EpiPw e; e.bias = p.b_pw + layer * 512; e.ZC = (const bf16_t*)(p.ws + OFF_ZC); e.MIX = BUFA;
            const bf16_t* A = (const bf16_t*)(p.ws + OFF_CVG); const bf16_t* Bt = (const bf16_t*)(p.ws + OFF_WPW) + (size_t)layer * 512 * 512;
            int pm, pn;
            for (int it = 0; gemm_next(it, 4, pm, pn); ++it) gemm_unit(A, 512, Bt, 512, 512, pm * 128, pn * 128, lds, e, pn);
        }
        grid.sync();
        for (int u = bid; u < 1024; u += nb) gla_out_unit(p, layer, u, lds);
        grid.sync();
        {
            EpiOut e; e.p = &p; e.layer = layer; e.XO = p.out + OUT_Y; e.XB = BUFB; e.ssq = SSQ;
            const bf16_t* Bt = (const bf16_t*)(p.ws + OFF_WOUT) + (size_t)layer * 1024 * 1024;
            int pm, pn;
            for (int it = 0; gemm_next(it, 8, pm, pn); ++it) gemm_unit(BUFA, 1024, Bt, 1024, 1024, pm * 128, pn * 128, lds, e, pn);
        }
        grid.sync();
    }
    {
        const int tid0 = tid_(); const int wid = tid0 >> 6, lane = tid0 & 63;
        for (int row = bid * 4 + wid; row < NTOK; row += nb * 4) {
            float s = lane < 16 ? SSQ[(size_t)row * 16 + lane] : 0.f; s = wave_sum(s);
            const float r = rsqrtf(s * (1.0f / 1024.0f) + EPS);
            float* xr = p.out + OUT_Y + (size_t)row * 1024;
#pragma unroll
            for (int i = 0; i < 4; ++i) { const int col = i * 256 + lane * 4; f32x4 a = *(const f32x4*)(xr + col); const f32x4 g = *(const f32x4*)(p.final_g + col);
                a = a * r * g; *(f32x4*)(xr + col) = a; }
        }
    }
}

extern "C" void kernel_launch(void* const* d_in, const int* in_sizes, int n_in, void* d_out, int out_size, void* d_ws, size_t ws_size, hipStream_t stream) {
    static int grid_blocks = 0;
    if (!grid_blocks) {
        int dev = 0, cus = 0, per_cu = 0;
        hipGetDevice(&dev);
        hipDeviceGetAttribute(&cus, hipDeviceAttributeMultiprocessorCount, dev);
        hipOccupancyMaxActiveBlocksPerMultiprocessor(&per_cu, hymba_mega, 256, 0);
        if (per_cu > 2) per_cu = 2;
        if (per_cu < 1) per_cu = 1;
        grid_blocks = cus * per_cu;
    }
    if (ws_size < WS_NEED) fprintf(stderr, "workspace too small: %zu < %zu\n", ws_size, (size_t)WS_NEED);
    Params p{};
    p.x_prompt = (const float*)d_in[0]; p.x_sample = (const float*)d_in[1]; p.cache_conv = (const float*)d_in[2]; p.state_gla = (const float*)d_in[3];
    p.norm_g = (const float*)d_in[4]; p.w_in = (const float*)d_in[5]; p.w_alpha = (const float*)d_in[6]; p.b_alpha = (const float*)d_in[7];
    p.conv_w = (const float*)d_in[8]; p.conv_b = (const float*)d_in[9]; p.cn_g = (const float*)d_in[10]; p.cn_b = (const float*)d_in[11];
    p.w_pw = (const float*)d_in[12]; p.b_pw = (const float*)d_in[13]; p.gla_g = (const float*)d_in[14]; p.w_out = (const float*)d_in[15]; p.final_g = (const float*)d_in[16];
    p.out = (float*)d_out; p.ws = (unsigned char*)d_ws;
    void* args[] = {&p};
    hipError_t e = hipLaunchCooperativeKernel((void*)hymba_mega, dim3(grid_blocks), dim3(256), args, 0, stream);
    if (e != hipSuccess) fprintf(stderr, "cooperative launch failed: %s (grid %d)\n", hipGetErrorString(e), grid_blocks);
}
```

```cpp
#include <hip/hip_runtime.h>
#include <hip/hip_cooperative_groups.h>
#include <cstdint>
#include <cstdio>
namespace cg = cooperative_groups;

#define LAS __attribute__((address_space(3)))
typedef unsigned short bf16_t;
typedef short bf16x8 __attribute__((ext_vector_type(8)));
typedef float f32x4 __attribute__((ext_vector_type(4)));
typedef unsigned u32x2 __attribute__((ext_vector_type(2)));
typedef unsigned u32x4 __attribute__((ext_vector_type(4)));

constexpr int NTOK = 17408, NPROMPT = 16384;
constexpr int SEQ = 2048, BATCH = 8, DEC_B = 128, DEC_T = 8;
constexpr int NIN = 3200;
constexpr float EPS = 1e-6f;

constexpr size_t OFF_WIN  = 0;
constexpr size_t OFF_WPW  = OFF_WIN  + (size_t)2 * NIN * 1024 * 2;
constexpr size_t OFF_WOUT = OFF_WPW  + (size_t)2 * 512 * 512 * 2;
constexpr size_t OFF_BUFA = OFF_WOUT + (size_t)2 * 1024 * 1024 * 2;
constexpr size_t OFF_BUFB = OFF_BUFA + (size_t)NTOK * 1024 * 2;
constexpr size_t OFF_U    = OFF_BUFB + (size_t)NTOK * 1024 * 2;
constexpr size_t OFF_ZC   = OFF_U    + (size_t)NTOK * 512 * 2;
constexpr size_t OFF_Q    = OFF_ZC   + (size_t)NTOK * 512 * 2;
constexpr size_t OFF_K    = OFF_Q    + (size_t)NTOK * 256 * 2;
constexpr size_t OFF_V    = OFF_K    + (size_t)NTOK * 256 * 2;
constexpr size_t OFF_ZG   = OFF_V    + (size_t)NTOK * 512 * 2;
constexpr size_t OFF_LR   = OFF_ZG   + (size_t)NTOK * 512 * 2;
constexpr size_t OFF_CVG  = OFF_LR   + (size_t)NTOK * 16 * 4;
constexpr size_t OFF_DS   = OFF_CVG  + (size_t)NTOK * 512 * 2;
constexpr size_t OFF_SB   = OFF_DS   + (size_t)1024 * 8192 * 4;
constexpr size_t OFF_DEC  = OFF_SB   + (size_t)1024 * 8192 * 2;
constexpr size_t OFF_SSQ  = OFF_DEC  + (size_t)1024 * 64 * 4;
constexpr size_t OFF_BAR  = OFF_SSQ  + (size_t)NTOK * 16 * 4;
constexpr size_t WS_NEED  = OFF_BAR  + 16384;

constexpr size_t OUT_Y    = 0;
constexpr size_t OUT_CCP  = (size_t)NTOK * 1024;
constexpr size_t OUT_SGP  = OUT_CCP + (size_t)2 * 8 * 30 * 512;
constexpr size_t OUT_CCS  = OUT_SGP + (size_t)2 * 8 * 4 * 64 * 128;
constexpr size_t OUT_SGS  = OUT_CCS + (size_t)2 * 128 * 30 * 512;

struct Params {
    const float *x_prompt, *x_sample, *cache_conv, *state_gla, *norm_g, *w_in, *w_alpha, *b_alpha, *conv_w, *conv_b,
                *cn_g, *cn_b, *w_pw, *b_pw, *gla_g, *w_out, *final_g;
    float* out;
    unsigned char* ws;
};

__device__ __forceinline__ unsigned pk2(float lo, float hi) { unsigned r; asm("v_cvt_pk_bf16_f32 %0, %1, %2" : "=v"(r) : "v"(lo), "v"(hi)); return r; }
__device__ __forceinline__ float bf2f(bf16_t h) { return __uint_as_float(((unsigned)h) << 16); }
__device__ __forceinline__ float bflo(unsigned w) { return __uint_as_float(w << 16); }
__device__ __forceinline__ float bfhi(unsigned w) { return __uint_as_float(w & 0xffff0000u); }
__device__ __forceinline__ float sigmoidf_(float x) { return __builtin_amdgcn_rcpf(1.0f + __expf(-x)); }
__device__ __forceinline__ float siluf_(float x) { return x * sigmoidf_(x); }
__device__ __forceinline__ float wave_sum(float v) {
#pragma unroll
    for (int o = 32; o >= 1; o >>= 1) v += __shfl_xor(v, o);
    return v;
}
__device__ __forceinline__ int tid_() { int t = threadIdx.x; asm volatile("" : "+v"(t)); return t; }
__device__ __forceinline__ const float* xrow_in(const Params& p, int row) {
    return row < NPROMPT ? p.x_prompt + (size_t)row * 1024 : p.x_sample + (size_t)(row - NPROMPT) * 1024;
}

template <class Epi>
__device__ __forceinline__ void gemm_unit(const bf16_t* __restrict__ A, int lda, const bf16_t* __restrict__ Bt, int ldb, int K,
                                          int row0, int brow0, LAS unsigned char* lds, const Epi& epi, int pn) {
    const int tid = tid_(), wid = tid >> 6, lane = tid & 63, wr = wid >> 1, wc = wid & 1, fr = lane & 15, fq = lane >> 4;
    f32x4 acc[4][4];
#pragma unroll
    for (int m = 0; m < 4; ++m)
#pragma unroll
        for (int n = 0; n < 4; ++n) acc[m][n] = (f32x4){0.f, 0.f, 0.f, 0.f};
    const bf16_t* ga[2]; const bf16_t* gb[2];
#pragma unroll
    for (int i = 0; i < 2; ++i) { const int b = tid * 16 + i * 4096, r = b >> 6, c = (b & 63) >> 1;
        ga[i] = A + (size_t)(row0 + r) * lda + c; gb[i] = Bt + (size_t)(brow0 + r) * ldb + c; }
    const int nt = K >> 5;
    epi.pre(row0, lds);
#define GEMM_STAGE(t, buf) do { _Pragma("unroll") for (int i = 0; i < 2; ++i) { \
        __builtin_amdgcn_global_load_lds((const unsigned*)(ga[i] + (t) * 32), (LAS unsigned*)(lds + (buf) * 16384 + tid * 16 + i * 4096), 16, 0, 0); \
        __builtin_amdgcn_global_load_lds((const unsigned*)(gb[i] + (t) * 32), (LAS unsigned*)(lds + (buf) * 16384 + 8192 + tid * 16 + i * 4096), 16, 0, 0); } } while (0)
    GEMM_STAGE(0, 0);
#pragma unroll 1
    for (int t = 0; t < nt; ++t) {
        asm volatile("s_waitcnt vmcnt(0)" ::: "memory");
        __syncthreads();
        if (t + 1 < nt) GEMM_STAGE(t + 1, (t + 1) & 1);
        LAS unsigned char* sa = lds + (t & 1) * 16384; LAS unsigned char* sb = sa + 8192;
        bf16x8 af[4], bfr[4];
#pragma unroll
        for (int m = 0; m < 4; ++m) af[m] = *(LAS bf16x8*)(sa + (wr * 64 + m * 16 + fr) * 64 + fq * 16);
#pragma unroll
        for (int n = 0; n < 4; ++n) bfr[n] = *(LAS bf16x8*)(sb + (wc * 64 + n * 16 + fr) * 64 + fq * 16);
#pragma unroll
        for (int m = 0; m < 4; ++m)
#pragma unroll
            for (int n = 0; n < 4; ++n) acc[m][n] = __builtin_amdgcn_mfma_f32_16x16x32_bf16(bfr[n], af[m], acc[m][n], 0, 0, 0);
    }
#undef GEMM_STAGE
    epi(acc, row0, pn, wr, wc, fr, fq, lds);
    __syncthreads();
}

__device__ __forceinline__ bool gemm_next(int it, int nN, int& pm, int& pn, int first_unit_offset = 0) {
    const int nb = gridDim.x, bid = blockIdx.x;
    if ((nb & 7) == 0) {
        const int xcd = bid & 7, j = bid >> 3, nj = nb >> 3; const int u = j + it * nj;
        if (u >= 17 * nN) return false;
        pm = xcd + 8 * (u / nN); pn = u % nN; return true;
    } else {
        const int u = bid + it * nb; if (u >= 136 * nN) return false; pm = u / nN; pn = u % nN; return true;
    }
}

struct EpiIn {
    const float* ssq; bf16_t *U, *ZC, *Q, *Kb, *V, *ZG; float* LR;
    __device__ __forceinline__ void pre(int row0, LAS unsigned char* lds) const {
        LAS float* rs = (LAS float*)(lds + 32768);
        const int tid = tid_();
        if (tid < 128) { const f32x4* s = (const f32x4*)(ssq + (size_t)(row0 + tid) * 16); f32x4 a = s[0], b = s[1], c = s[2], d = s[3];
            float t = (a[0] + a[1] + a[2] + a[3]) + (b[0] + b[1] + b[2] + b[3]) + (c[0] + c[1] + c[2] + c[3]) + (d[0] + d[1] + d[2] + d[3]);
            rs[tid] = rsqrtf(t * (1.0f / 1024.0f) + EPS); }
    }
    __device__ __forceinline__ void operator()(f32x4 (&acc)[4][4], int row0, int pn, int wr, int wc, int fr, int fq, LAS unsigned char* lds) const {
        const LAS float* rs = (const LAS float*)(lds + 32768);
#pragma unroll
        for (int m = 0; m < 4; ++m) {
            const int rl = wr * 64 + m * 16 + fr; const size_t row = (size_t)(row0 + rl); const float r = rs[rl];
            if (pn < 8) {
#pragma unroll
                for (int n = 0; n < 2; ++n) { f32x4 a = acc[m][n] * r, g = acc[m][n + 2] * r; u32x2 w;
                    w.x = pk2(a[0] * sigmoidf_(g[0]), a[1] * sigmoidf_(g[1])); w.y = pk2(a[2] * sigmoidf_(g[2]), a[3] * sigmoidf_(g[3]));
                    *(u32x2*)(U + row * 512 + pn * 64 + wc * 32 + n * 16 + fq * 4) = w; }
            } else if (pn < 12) {
#pragma unroll
                for (int n = 0; n < 4; ++n) { f32x4 a = acc[m][n] * r; u32x2 w; w.x = pk2(siluf_(a[0]), siluf_(a[1])); w.y = pk2(siluf_(a[2]), siluf_(a[3]));
                    *(u32x2*)(ZC + row * 512 + (pn - 8) * 128 + wc * 64 + n * 16 + fq * 4) = w; }
            } else if (pn < 14) {
#pragma unroll
                for (int n = 0; n < 4; ++n) { f32x4 a = acc[m][n] * (r * 0.125f); u32x2 w; w.x = pk2(a[0], a[1]); w.y = pk2(a[2], a[3]);
                    *(u32x2*)(Q + row * 256 + (pn - 12) * 128 + wc * 64 + n * 16 + fq * 4) = w; }
            } else if (pn < 16) {
#pragma unroll
                for (int n = 0; n < 4; ++n) { f32x4 a = acc[m][n] * r; u32x2 w; w.x = pk2(a[0], a[1]); w.y = pk2(a[2], a[3]);
                    *(u32x2*)(Kb + row * 256 + (pn - 14) * 128 + wc * 64 + n * 16 + fq * 4) = w; }
            } else if (pn < 20) {
#pragma unroll
                for (int n = 0; n < 4; ++n) { f32x4 a = acc[m][n] * r; u32x2 w; w.x = pk2(a[0], a[1]); w.y = pk2(a[2], a[3]);
                    *(u32x2*)(V + row * 512 + (pn - 16) * 128 + wc * 64 + n * 16 + fq * 4) = w; }
            } else if (pn < 24) {
#pragma unroll
                for (int n = 0; n < 4; ++n) { f32x4 a = acc[m][n] * r; u32x2 w; w.x = pk2(siluf_(a[0]), siluf_(a[1])); w.y = pk2(siluf_(a[2]), siluf_(a[3]));
                    *(u32x2*)(ZG + row * 512 + (pn - 20) * 128 + wc * 64 + n * 16 + fq * 4) = w; }
            } else {
                if (wc == 0) { f32x4 a = acc[m][0] * r; *(f32x4*)(LR + row * 16 + fq * 4) = a; }
            }
        }
    }
};

struct EpiPw {
    const float* bias; const bf16_t* ZC; bf16_t* MIX;
    __device__ __forceinline__ void pre(int, LAS unsigned char*) const {}
    __device__ __forceinline__ void operator()(f32x4 (&acc)[4][4], int row0, int pn, int wr, int wc, int fr, int fq, LAS unsigned char*) const {
#pragma unroll
        for (int n = 0; n < 4; ++n) {
            const int col = pn * 128 + wc * 64 + n * 16 + fq * 4; const f32x4 b = *(const f32x4*)(bias + col);
#pragma unroll
            for (int m = 0; m < 4; ++m) { const size_t row = (size_t)(row0 + wr * 64 + m * 16 + fr);
                const u32x2 z = *(const u32x2*)(ZC + row * 512 + col); f32x4 a = acc[m][n] + b; u32x2 w;
                w.x = pk2(a[0] * bflo(z.x), a[1] * bfhi(z.x)); w.y = pk2(a[2] * bflo(z.y), a[3] * bfhi(z.y));
                *(u32x2*)(MIX + row * 1024 + col) = w; }
        }
    }
};

struct EpiOut {
    const Params* p; int layer; float* XO; bf16_t* XB; float* ssq;
    __device__ __forceinline__ void pre(int, LAS unsigned char*) const {}
    __device__ __forceinline__ void operator()(f32x4 (&acc)[4][4], int row0, int pn, int wr, int wc, int fr, int fq, LAS unsigned char*) const {
#pragma unroll
        for (int m = 0; m < 4; ++m) {
            const int row = row0 + wr * 64 + m * 16 + fr;
            const float* xr = layer == 0 ? xrow_in(*p, row) : XO + (size_t)row * 1024;
            float s = 0.f;
#pragma unroll
            for (int n = 0; n < 4; ++n) { const int col = pn * 128 + wc * 64 + n * 16 + fq * 4;
                f32x4 a = acc[m][n] + *(const f32x4*)(xr + col);
                *(f32x4*)(XO + (size_t)row * 1024 + col) = a;
                if (layer == 0) { u32x2 w; w.x = pk2(a[0], a[1]); w.y = pk2(a[2], a[3]); *(u32x2*)(XB + (size_t)row * 1024 + col) = w; }
                s += (a[0] * a[0] + a[1] * a[1]) + (a[2] * a[2] + a[3] * a[3]); }
            s += __shfl_xor(s, 16); s += __shfl_xor(s, 32);
            if (fq == 0) ssq[(size_t)row * 16 + pn * 2 + wc] = s;
        }
    }
};

__device__ __forceinline__ int inproj_src_col(int r) {
    if (r < 1024) { const int T = r >> 7, within = r & 127, wc = within >> 6, idx = within & 63, f = idx >> 4, i = idx & 15;
        const int ch = T * 64 + wc * 32 + (f & 1) * 16 + i; return f < 2 ? ch : 512 + ch; }
    if (r < 3088) return r;
    return -1;
}
__device__ void prep_w_tile(const float* W, int ldw, const float* g, bf16_t* Wt, int K, int r0, int k0, bool permute, LAS unsigned char* lds) {
    LAS float* tile = (LAS float*)lds;
    const int tid = tid_(), rr = tid & 63, r = r0 + rr;
    const int n = permute ? inproj_src_col(r) : r;
#pragma unroll 4
    for (int i = 0; i < 16; ++i) { const int kk = i * 4 + (tid >> 6);
        float v = n >= 0 ? W[(size_t)(k0 + kk) * ldw + n] : 0.f; if (g) v *= g[k0 + kk]; tile[kk * 65 + rr] = v; }
    __syncthreads();
#pragma unroll 4
    for (int i = 0; i < 8; ++i) { const int idx = i * 256 + tid, rr2 = idx >> 5, kp = idx & 31;
        *(unsigned*)(Wt + (size_t)(r0 + rr2) * K + k0 + 2 * kp) = pk2(tile[(2 * kp) * 65 + rr2], tile[(2 * kp + 1) * 65 + rr2]); }
    __syncthreads();
}
__device__ void phase_prep(const Params& p, LAS unsigned char* lds) {
    bf16_t* WIN = (bf16_t*)(p.ws + OFF_WIN); bf16_t* WPW = (bf16_t*)(p.ws + OFF_WPW); bf16_t* WOUT = (bf16_t*)(p.ws + OFF_WOUT);
    bf16_t* XB = (bf16_t*)(p.ws + OFF_BUFA); float* SSQ = (float*)(p.ws + OFF_SSQ);
    const int nb = gridDim.x, bid = blockIdx.x;
    for (int u = bid; u < 2240; u += nb) {
        if (u < 1600) { const int l = u / 800, v = u % 800, rt = v / 16, kt = v % 16;
            prep_w_tile(p.w_in + (size_t)l * 1024 * 3088, 3088, p.norm_g + l * 1024, WIN + (size_t)l * NIN * 1024, 1024, rt * 64, kt * 64, true, lds);
        } else if (u < 1728) { const int w = u - 1600, l = w / 64, v = w % 64, rt = v / 8, kt = v % 8;
            prep_w_tile(p.w_pw + (size_t)l * 512 * 512, 512, nullptr, WPW + (size_t)l * 512 * 512, 512, rt * 64, kt * 64, false, lds);
        } else { const int w = u - 1728, l = w / 256, v = w % 256, rt = v / 16, kt = v % 16;
            prep_w_tile(p.w_out + (size_t)l * 1024 * 1024, 1024, nullptr, WOUT + (size_t)l * 1024 * 1024, 1024, rt * 64, kt * 64, false, lds);
        }
    }
    const int tid0 = tid_(); const int wid = tid0 >> 6, lane = tid0 & 63;
    for (int row = bid * 4 + wid; row < NTOK; row += nb * 4) {
        const float* xr = xrow_in(p, row); float s = 0.f;
#pragma unroll
        for (int i = 0; i < 4; ++i) { const int col = i * 256 + lane * 4; const f32x4 a = *(const f32x4*)(xr + col);
            s += (a[0] * a[0] + a[1] * a[1]) + (a[2] * a[2] + a[3] * a[3]);
            u32x2 w; w.x = pk2(a[0], a[1]); w.y = pk2(a[2], a[3]); *(u32x2*)(XB + (size_t)row * 1024 + col) = w; }
        s = wave_sum(s);
        if (lane < 16) SSQ[(size_t)row * 16 + lane] = lane == 0 ? s : 0.f;
    }
}

template <int NT>
__device__ __forceinline__ void compute_bcum(const Params& p, int layer, int h, const float* LR, int row0, LAS float* G) {
    const int tid = tid_(), d = tid & 63, tq = tid >> 6;
    float wa[16];
#pragma unroll
    for (int r = 0; r < 16; ++r) wa[r] = p.w_alpha[(size_t)layer * 16 * 256 + r * 256 + h * 64 + d];
    const float ba = p.b_alpha[layer * 256 + h * 64 + d];
    constexpr int PER = NT / 4;
#pragma unroll 2
    for (int i = 0; i < PER; ++i) { const int t = tq * PER + i;
        const f32x4* lp = (const f32x4*)(LR + (size_t)(row0 + t) * 16);
        float z = ba;
#pragma unroll
        for (int r4 = 0; r4 < 4; ++r4) { const f32x4 v = lp[r4]; z += v[0] * wa[r4 * 4] + v[1] * wa[r4 * 4 + 1] + v[2] * wa[r4 * 4 + 2] + v[3] * wa[r4 * 4 + 3]; }
        const float ls = fminf(z, 0.f) - log1pf(expf(-fabsf(z)));
        G[t * 64 + d] = ls * (1.0f / 16.0f);
    }
    __syncthreads();
    if (tid < 64) { float run = 0.f;
#pragma unroll 8
        for (int t = 0; t < NT; ++t) { run += G[t * 64 + d]; G[t * 64 + d] = run; } }
    __syncthreads();
}

__device__ void conv_unit(const Params& p, int layer, bool sample, int b_or_pair, int tile, int cs, LAS unsigned char* lds) {
    const bf16_t* U = (const bf16_t*)(p.ws + OFF_U); bf16_t* CVG = (bf16_t*)(p.ws + OFF_CVG);
    LAS bf16_t* ub = (LAS bf16_t*)lds;
    const int tid = tid_(), wid = tid >> 6, lane = tid & 63;
    const int t0 = tile * 64;
    if (!sample) {
        for (int c = tid; c < 94 * 16; c += 256) { const int i = c >> 4, cc = c & 15; const int time = t0 - 30 + i;
            u32x4 v = (u32x4){0u, 0u, 0u, 0u};
            if (time >= 0) v = *(const u32x4*)(U + (size_t)(b_or_pair * SEQ + time) * 512 + cs * 128 + cc * 8);
            *(LAS u32x4*)(ub + i * 128 + cc * 8) = v; }
    } else {
        for (int c = tid; c < 76 * 16; c += 256) { const int i = c >> 4, cc = c & 15; const int sq = i >= 38, ii = i - sq * 38; const int s = b_or_pair * 2 + sq;
            u32x4 v;
            if (ii < 30) { const float* src = p.cache_conv + (((size_t)layer * DEC_B + s) * 30 + ii) * 512 + cs * 128 + cc * 8;
                const f32x4 a = *(const f32x4*)src, bb = *(const f32x4*)(src + 4);
                v.x = pk2(a[0], a[1]); v.y = pk2(a[2], a[3]); v.z = pk2(bb[0], bb[1]); v.w = pk2(bb[2], bb[3]);
                if (ii >= 8) { float* dst = p.out + OUT_CCS + (((size_t)layer * DEC_B + s) * 30 + (ii - 8)) * 512 + cs * 128 + cc * 8;
                    *(f32x4*)dst = a; *(f32x4*)(dst + 4) = bb; }
            } else v = *(const u32x4*)(U + (size_t)(NPROMPT + s * 8 + (ii - 30)) * 512 + cs * 128 + cc * 8);
            *(LAS u32x4*)(ub + i * 128 + cc * 8) = v; }
    }
    __syncthreads();
    const int gi = wid & 1, half = wid >> 1; const int chl = gi * 64 + lane, ch = cs * 128 + chl;
    float w[31];
#pragma unroll
    for (int j = 0; j < 31; ++j) w[j] = p.conv_w[((size_t)layer * 31 + j) * 512 + ch];
    const float cb = p.conv_b[layer * 512 + ch], lg = p.cn_g[layer * 512 + ch], lb = p.cn_b[layer * 512 + ch];
    const int rb = sample ? half * 38 : half * 32;
    const int nsteps = sample ? 2 : 8;
    const size_t grow0 = sample ? (size_t)(NPROMPT + (b_or_pair * 2 + half) * 8) : (size_t)(b_or_pair * SEQ + t0 + half * 32);
    for (int st = 0; st < nsteps; ++st) {
        float vals[34];
#pragma unroll
        for (int i = 0; i < 34; ++i) vals[i] = bf2f(ub[(rb + st * 4 + i) * 128 + chl]);
#pragma unroll
        for (int q = 0; q < 4; ++q) {
            float x = cb;
#pragma unroll
            for (int j = 0; j < 31; ++j) x = fmaf(w[j], vals[q + j], x);
            const float mu = wave_sum(x) * (1.0f / 64.0f); const float dlt = x - mu;
            const float var = wave_sum(dlt * dlt) * (1.0f / 64.0f);
            const float y = dlt * rsqrtf(var + EPS) * lg + lb;
            const float sv = siluf_(y);
            CVG[(grow0 + st * 4 + q) * 512 + ch] = (bf16_t)(pk2(sv, 0.f) & 0xffffu);
        }
    }
    if (!sample) {
        if (tile == 31) { for (int c = tid; c < 30 * 128; c += 256) { const int j = c >> 7, cc = c & 127;
            p.out[OUT_CCP + (((size_t)layer * BATCH + b_or_pair) * 30 + j) * 512 + cs * 128 + cc] = bf2f(ub[(64 + j) * 128 + cc]); } }
    } else {
        for (int c = tid; c < 2 * 8 * 128; c += 256) { const int sq = c >> 10, j = (c >> 7) & 7, cc = c & 127; const int s = b_or_pair * 2 + sq;
            p.out[OUT_CCS + (((size_t)layer * DEC_B + s) * 30 + 22 + j) * 512 + cs * 128 + cc] = bf2f(ub[(sq * 38 + 30 + j) * 128 + cc]); }
    }
    __syncthreads();
}

__device__ void gla_ds_unit(const Params& p, int layer, int unit, LAS unsigned char* lds) {
    const int h = unit & 3, bc = unit >> 2; const int row0 = bc * 64;
    const bf16_t* Kb = (const bf16_t*)(p.ws + OFF_K); const bf16_t* V = (const bf16_t*)(p.ws + OFF_V); const float* LR = (const float*)(p.ws + OFF_LR);
    float* DS = (float*)(p.ws + OFF_DS) + (size_t)unit * 8192; float* DEC = (float*)(p.ws + OFF_DEC) + (size_t)unit * 64;
    LAS float* G = (LAS float*)lds;
    LAS bf16_t* KT = (LAS bf16_t*)(lds + 16384);
    LAS bf16_t* VT = (LAS bf16_t*)(lds + 16384 + 9216);
    compute_bcum<64>(p, layer, h, LR, row0, G);
    const int tid = tid_(), t = tid >> 2, qd = tid & 3;
    {
        const u32x4* src = (const u32x4*)(Kb + (size_t)(row0 + t) * 256 + h * 64 + qd * 16);
        const u32x4 a = src[0], b = src[1]; const unsigned wv[8] = {a.x, a.y, a.z, a.w, b.x, b.y, b.z, b.w};
#pragma unroll
        for (int e = 0; e < 8; ++e) { const int d0 = qd * 16 + 2 * e;
            const float f0 = bflo(wv[e]) * __expf(G[63 * 64 + d0] - G[t * 64 + d0]);
            const float f1 = bfhi(wv[e]) * __expf(G[63 * 64 + d0 + 1] - G[t * 64 + d0 + 1]);
            const unsigned pk = pk2(f0, f1);
            KT[d0 * 72 + t] = (bf16_t)(pk & 0xffffu); KT[(d0 + 1) * 72 + t] = (bf16_t)(pk >> 16); }
        const u32x4* vs = (const u32x4*)(V + (size_t)(row0 + t) * 512 + h * 128 + qd * 32);
#pragma unroll
        for (int c = 0; c < 4; ++c) { const u32x4 a2 = vs[c]; const unsigned w2[4] = {a2.x, a2.y, a2.z, a2.w};
#pragma unroll
            for (int e = 0; e < 4; ++e) { const int dv = qd * 32 + c * 8 + 2 * e;
                VT[dv * 72 + t] = (bf16_t)(w2[e] & 0xffffu); VT[(dv + 1) * 72 + t] = (bf16_t)(w2[e] >> 16); } }
        if (tid < 64) DEC[tid] = __expf(G[63 * 64 + tid]);
    }
    __syncthreads();
    const int wid = tid >> 6, lane = tid & 63, fr = lane & 15, fq = lane >> 4;
    f32x4 acc[2][4];
#pragma unroll
    for (int m = 0; m < 2; ++m)
#pragma unroll
        for (int n = 0; n < 4; ++n) acc[m][n] = (f32x4){0.f, 0.f, 0.f, 0.f};
#pragma unroll
    for (int kk = 0; kk < 2; ++kk) {
        bf16x8 vf[2], kf[4];
#pragma unroll
        for (int m = 0; m < 2; ++m) vf[m] = *(LAS bf16x8*)(VT + (wid * 32 + m * 16 + fr) * 72 + kk * 32 + fq * 8);
#pragma unroll
        for (int n = 0; n < 4; ++n) kf[n] = *(LAS bf16x8*)(KT + (n * 16 + fr) * 72 + kk * 32 + fq * 8);
#pragma unroll
        for (int m = 0; m < 2; ++m)
#pragma unroll
            for (int n = 0; n < 4; ++n) acc[m][n] = __builtin_amdgcn_mfma_f32_16x16x32_bf16(kf[n], vf[m], acc[m][n], 0, 0, 0);
    }
#pragma unroll
    for (int m = 0; m < 2; ++m)
#pragma unroll
        for (int n = 0; n < 4; ++n) *(f32x4*)(DS + (size_t)(wid * 32 + m * 16 + fr) * 64 + n * 16 + fq * 4) = acc[m][n];
    __syncthreads();
}

__device__ void gla_sample_unit(const Params& p, int layer, int unit, LAS unsigned char* lds) {
    const int h = unit & 3, s = unit >> 2; const int row0 = NPROMPT + s * 8;
    const bf16_t* Q = (const bf16_t*)(p.ws + OFF_Q); const bf16_t* Kb = (const bf16_t*)(p.ws + OFF_K); const bf16_t* V = (const bf16_t*)(p.ws + OFF_V);
    const bf16_t* ZG = (const bf16_t*)(p.ws + OFF_ZG); const float* LR = (const float*)(p.ws + OFF_LR); bf16_t* MIX = (bf16_t*)(p.ws + OFF_BUFA);
    const float* S0 = p.state_gla + (((size_t)layer * DEC_B + s) * 4 + h) * 8192;
    float* SN = p.out + OUT_SGS + (((size_t)layer * DEC_B + s) * 4 + h) * 8192;
    LAS float* G = (LAS float*)lds;
    LAS float* QT = G + 512;
    LAS float* KT = QT + 512;
    LAS float* KD = KT + 512;
    LAS float* DCY = KD + 512;
    LAS float* ATT = DCY + 64;
    LAS float* VV = ATT + 64;
    LAS float* OP = VV + 1024;
    LAS float* RED = OP + 2048;
    compute_bcum<8>(p, layer, h, LR, row0, G);
    const int tid = tid_();
#pragma unroll
    for (int i = 0; i < 2; ++i) { const int e = tid + i * 256, t = e >> 6, d = e & 63;
        const float bc = G[t * 64 + d], bl = G[7 * 64 + d];
        const float q = bf2f(Q[(size_t)(row0 + t) * 256 + h * 64 + d]), k = bf2f(Kb[(size_t)(row0 + t) * 256 + h * 64 + d]);
        QT[e] = q * __expf(bc); KT[e] = k * __expf(-bc); KD[e] = k * __expf(bl - bc);
        if (t == 7) DCY[d] = __expf(bl); }
#pragma unroll
    for (int i = 0; i < 4; ++i) { const int e = tid + i * 256, t = e >> 7, v = e & 127; VV[e] = bf2f(V[(size_t)(row0 + t) * 512 + h * 128 + v]); }
    __syncthreads();
    if (tid < 64) { const int t = tid >> 3, s2 = tid & 7; float a = 0.f;
        if (s2 <= t) { for (int d = 0; d < 64; ++d) a += QT[t * 64 + d] * KT[s2 * 64 + d]; }
        ATT[tid] = a; }
    __syncthreads();
    const int vcol = tid & 127, dh = tid >> 7;
    float o[8], v8[8];
#pragma unroll
    for (int t = 0; t < 8; ++t) { o[t] = 0.f; v8[t] = VV[t * 128 + vcol]; }
#pragma unroll 4
    for (int dd = 0; dd < 32; ++dd) { const int d = dh * 32 + dd; const float s0 = S0[d * 128 + vcol];
        float sn = s0 * DCY[d];
#pragma unroll
        for (int t = 0; t < 8; ++t) { o[t] = fmaf(QT[t * 64 + d], s0, o[t]); sn = fmaf(KD[t * 64 + d], v8[t], sn); }
        SN[d * 128 + vcol] = sn; }
    if (dh == 0) {
#pragma unroll
        for (int t = 0; t < 8; ++t)
#pragma unroll
            for (int s2 = 0; s2 < 8; ++s2) o[t] = fmaf(ATT[t * 8 + s2], v8[s2], o[t]);
    }
#pragma unroll
    for (int t = 0; t < 8; ++t) OP[(dh * 8 + t) * 128 + vcol] = o[t];
    __syncthreads();
    float val[4];
#pragma unroll
    for (int i = 0; i < 4; ++i) { const int t = dh * 4 + i; val[i] = OP[t * 128 + vcol] + OP[(8 + t) * 128 + vcol];
        const float ps = wave_sum(val[i] * val[i]); if ((tid & 63) == 0) RED[t * 4 + ((tid >> 6) & 1)] = ps; }
    __syncthreads();
    const float gg = p.gla_g[layer * 128 + vcol];
#pragma unroll
    for (int i = 0; i < 4; ++i) { const int t = dh * 4 + i; const float ms = (RED[t * 4] + RED[t * 4 + 1]) * (1.0f / 128.0f);
        const float zg = bf2f(ZG[(size_t)(row0 + t) * 512 + h * 128 + vcol]);
        const float r = val[i] * rsqrtf(ms + EPS) * gg * zg;
        MIX[(size_t)(row0 + t) * 1024 + 512 + h * 128 + vcol] = (bf16_t)(pk2(r, 0.f) & 0xffffu); }
    __syncthreads();
}

__device__ void scan_unit(const Params& p, int layer, int unit) {
    const int part = unit & 7, h = (unit >> 3) & 3, b = unit >> 5;
    const float* DS = (const float*)(p.ws + OFF_DS); const float* DEC = (const float*)(p.ws + OFF_DEC); bf16_t* SB = (bf16_t*)(p.ws + OFF_SB);
    const int e = part * 1024 + tid_() * 4; const int dk = e & 63, dv = e >> 6;
    f32x4 S = (f32x4){0.f, 0.f, 0.f, 0.f};
#pragma unroll 8
    for (int i = 0; i < 32; ++i) { const size_t ug = (size_t)((b * 32 + i) * 4 + h);
        const f32x4 cur = *(const f32x4*)(DS + ug * 8192 + e); const f32x4 dc = *(const f32x4*)(DEC + ug * 64 + dk);
        u32x2 w; w.x = pk2(S[0], S[1]); w.y = pk2(S[2], S[3]); *(u32x2*)(SB + ug * 8192 + e) = w;
        S = S * dc + cur; }
    float* o = p.out + OUT_SGP + (((size_t)layer * BATCH + b) * 4 + h) * 8192;
#pragma unroll
    for (int j = 0; j < 4; ++j) o[(dk + j) * 128 + dv] = S[j];
}

__device__ void gla_out_unit(const Params& p, int layer, int unit, LAS unsigned char* lds) {
    const int h = unit & 3, bc = unit >> 2; const int row0 = bc * 64;
    const bf16_t* Q = (const bf16_t*)(p.ws + OFF_Q); const bf16_t* Kb = (const bf16_t*)(p.ws + OFF_K); const bf16_t* V = (const bf16_t*)(p.ws + OFF_V);
    const bf16_t* ZG = (const bf16_t*)(p.ws + OFF_ZG); const float* LR = (const float*)(p.ws + OFF_LR); bf16_t* MIX = (bf16_t*)(p.ws + OFF_BUFA);
    const bf16_t* SB = (const bf16_t*)(p.ws + OFF_SB) + (size_t)unit * 8192;
    LAS float* G = (LAS float*)lds;
    LAS bf16_t* QT = (LAS bf16_t*)(lds + 16384);
    LAS bf16_t* KT = (LAS bf16_t*)(lds + 16384 + 9216);
    LAS bf16_t* VT = (LAS bf16_t*)(lds + 16384 + 18432);
    LAS bf16_t* PP = (LAS bf16_t*)(lds + 16384 + 18432 + 18432);
    compute_bcum<64>(p, layer, h, LR, row0, G);
    const int tid = tid_();
    {   const int t = tid >> 2, qd = tid & 3;
        const u32x4* qs = (const u32x4*)(Q + (size_t)(row0 + t) * 256 + h * 64 + qd * 16);
        const u32x4* ks = (const u32x4*)(Kb + (size_t)(row0 + t) * 256 + h * 64 + qd * 16);
        const u32x4 qa = qs[0], qb = qs[1], ka = ks[0], kb = ks[1];
        const unsigned qw[8] = {qa.x, qa.y, qa.z, qa.w, qb.x, qb.y, qb.z, qb.w}; const unsigned kw[8] = {ka.x, ka.y, ka.z, ka.w, kb.x, kb.y, kb.z, kb.w};
        unsigned qo[8], ko[8];
#pragma unroll
        for (int e = 0; e < 8; ++e) { const int d0 = qd * 16 + 2 * e; const float g0 = G[t * 64 + d0], g1 = G[t * 64 + d0 + 1];
            const float e0 = __expf(g0), e1 = __expf(g1);
            qo[e] = pk2(bflo(qw[e]) * e0, bfhi(qw[e]) * e1);
            ko[e] = pk2(bflo(kw[e]) * __builtin_amdgcn_rcpf(e0), bfhi(kw[e]) * __builtin_amdgcn_rcpf(e1)); }
        *(LAS u32x4*)(QT + t * 72 + qd * 16) = (u32x4){qo[0], qo[1], qo[2], qo[3]}; *(LAS u32x4*)(QT + t * 72 + qd * 16 + 8) = (u32x4){qo[4], qo[5], qo[6], qo[7]};
        *(LAS u32x4*)(KT + t * 72 + qd * 16) = (u32x4){ko[0], ko[1], ko[2], ko[3]}; *(LAS u32x4*)(KT + t * 72 + qd * 16 + 8) = (u32x4){ko[4], ko[5], ko[6], ko[7]};
        const u32x4* vs = (const u32x4*)(V + (size_t)(row0 + t) * 512 + h * 128 + qd * 32);
#pragma unroll
        for (int c = 0; c < 4; ++c) { const u32x4 a2 = vs[c]; const unsigned w2[4] = {a2.x, a2.y, a2.z, a2.w};
#pragma unroll
            for (int e = 0; e < 4; ++e) { const int dv = qd * 32 + c * 8 + 2 * e;
                VT[dv * 72 + t] = (bf16_t)(w2[e] & 0xffffu); VT[(dv + 1) * 72 + t] = (bf16_t)(w2[e] >> 16); } }
    }
    __syncthreads();
    const int wid = tid >> 6, lane = tid & 63, fr = lane & 15, fq = lane >> 4;
    LAS bf16_t* PW = PP + wid * 16 * 72;
    {
        bf16x8 qf[2];
#pragma unroll
        for (int kk = 0; kk < 2; ++kk) qf[kk] = *(LAS bf16x8*)(QT + (wid * 16 + fr) * 72 + kk * 32 + fq * 8);
#pragma unroll
        for (int n = 0; n < 4; ++n) {
            f32x4 a = (f32x4){0.f, 0.f, 0.f, 0.f};
#pragma unroll
            for (int kk = 0; kk < 2; ++kk) { const bf16x8 kf = *(LAS bf16x8*)(KT + (n * 16 + fr) * 72 + kk * 32 + fq * 8);
                a = __builtin_amdgcn_mfma_f32_16x16x32_bf16(kf, qf[kk], a, 0, 0, 0); }
            const int tg = wid * 16 + fr, sg = n * 16 + fq * 4;
            u32x2 w; w.x = pk2(sg <= tg ? a[0] : 0.f, sg + 1 <= tg ? a[1] : 0.f); w.y = pk2(sg + 2 <= tg ? a[2] : 0.f, sg + 3 <= tg ? a[3] : 0.f);
            *(LAS u32x2*)(PW + fr * 72 + n * 16 + fq * 4) = w;
        }
    }
    __builtin_amdgcn_s_waitcnt(0xc07f);
    __builtin_amdgcn_wave_barrier();
    f32x4 acc[8];
#pragma unroll
    for (int n = 0; n < 8; ++n) acc[n] = (f32x4){0.f, 0.f, 0.f, 0.f};
#pragma unroll
    for (int kk = 0; kk < 2; ++kk) {
        const bf16x8 qf = *(LAS bf16x8*)(QT + (wid * 16 + fr) * 72 + kk * 32 + fq * 8);
        const bf16x8 pf = *(LAS bf16x8*)(PW + fr * 72 + kk * 32 + fq * 8);
#pragma unroll
        for (int n = 0; n < 8; ++n) {
            const bf16x8 sf = *(const bf16x8*)(SB + (size_t)(n * 16 + fr) * 64 + kk * 32 + fq * 8);
            const bf16x8 vf = *(LAS bf16x8*)(VT + (n * 16 + fr) * 72 + kk * 32 + fq * 8);
            acc[n] = __builtin_amdgcn_mfma_f32_16x16x32_bf16(sf, qf, acc[n], 0, 0, 0);
            acc[n] = __builtin_amdgcn_mfma_f32_16x16x32_bf16(vf, pf, acc[n], 0, 0, 0);
        }
    }
    float ss = 0.f;
#pragma unroll
    for (int n = 0; n < 8; ++n) ss += (acc[n][0] * acc[n][0] + acc[n][1] * acc[n][1]) + (acc[n][2] * acc[n][2] + acc[n][3] * acc[n][3]);
    ss += __shfl_xor(ss, 16); ss += __shfl_xor(ss, 32);
    const float rinv = rsqrtf(ss * (1.0f / 128.0f) + EPS);
    const size_t row = (size_t)(row0 + wid * 16 + fr);
#pragma unroll
    for (int n = 0; n < 8; ++n) { const int dv = n * 16 + fq * 4; const f32x4 gg = *(const f32x4*)(p.gla_g + layer * 128 + dv);
        const u32x2 z = *(const u32x2*)(ZG + row * 512 + h * 128 + dv); u32x2 w;
        w.x = pk2(acc[n][0] * rinv * gg[0] * bflo(z.x), acc[n][1] * rinv * gg[1] * bfhi(z.x));
        w.y = pk2(acc[n][2] * rinv * gg[2] * bflo(z.y), acc[n][3] * rinv * gg[3] * bfhi(z.y));
        *(u32x2*)(MIX + row * 1024 + 512 + h * 128 + dv) = w; }
    __syncthreads();
}


#define XB_TMO      128
#define XB_XCNT(j)  (256  + 64 * (j))
#define XB_XSUB(j)  (1280 + 64 * (j))
#define XB_XGEN(j)  (2304 + 64 * (j))
#define XB_TOP      3328
#define XB_TOPGEN   3392
#define XCD_BAR_WORDS 3456
#define XB_SPIN_CAP (1u << 22)
__device__ __forceinline__ unsigned xb_ld(unsigned* p)              { return __hip_atomic_load(p, __ATOMIC_RELAXED, __HIP_MEMORY_SCOPE_AGENT); }
__device__ __forceinline__ unsigned xb_add(unsigned* p, unsigned v) { return __hip_atomic_fetch_add(p, v, __ATOMIC_RELAXED, __HIP_MEMORY_SCOPE_AGENT); }
__device__ __forceinline__ unsigned xb_xcc_id() { return (unsigned)__builtin_amdgcn_s_getreg((3 << 11) | 20) & 0xFu; }
#define XB_SPIN(cond, bar) do { unsigned _sp = 0; while (cond) { __builtin_amdgcn_s_sleep(1); \
    if ((++_sp & 255u) == 0u) { if (xb_ld(&(bar)[XB_TMO])) break; if (_sp > XB_SPIN_CAP) { atomicAdd(&(bar)[XB_TMO], 1u); break; } } } } while (0)
struct XcdBarrier { unsigned* bar; unsigned x; volatile LAS unsigned* st; };
__device__ __forceinline__ XcdBarrier xcd_barrier_post(unsigned* bar, volatile LAS unsigned* st) {
    XcdBarrier b; b.bar = bar; b.x = xb_xcc_id(); b.st = st;
    if (threadIdx.x == 0) (void)xb_add(&bar[XB_XCNT(b.x)], 1u);
    return b;
}
__device__ __forceinline__ void xcd_barrier_complete(unsigned* bar, unsigned x, unsigned& nloc, unsigned& nx) {
    const unsigned G = gridDim.x * gridDim.y * gridDim.z;
    unsigned sum, cnt, mine, sp = 0u;
    for (;;) {
        sum = 0u; cnt = 0u; mine = 0u;
#pragma unroll
        for (unsigned j = 0; j < 16; ++j) { const unsigned c = xb_ld(&bar[XB_XCNT(j)]); sum += c; cnt += (c > 0u) ? 1u : 0u; mine = (j == x) ? c : mine; }
        if (sum == G) break;
        __builtin_amdgcn_s_sleep(1);
        if ((++sp & 255u) == 0u) { if (xb_ld(&bar[XB_TMO])) break; if (sp > XB_SPIN_CAP) { atomicAdd(&bar[XB_TMO], 1u); break; } }
    }
    nloc = mine > 0u ? mine : 1u; nx = cnt > 0u ? cnt : 1u;
}
__device__ __forceinline__ void xcd_barrier(const XcdBarrier& b) {
    asm volatile("s_waitcnt vmcnt(0)" ::: "memory");
    __syncthreads();
    if (threadIdx.x == 0) {
        unsigned* bar = b.bar;
        __builtin_amdgcn_s_waitcnt(0);
        unsigned nloc = b.st[0], nx = b.st[1];
        if (nloc == 0u) { xcd_barrier_complete(bar, b.x, nloc, nx); b.st[0] = nloc; b.st[1] = nx; }
        const unsigned old = xb_add(&bar[XB_XSUB(b.x)], 1u);
        const unsigned gen = old / nloc;
        if (old + 1u == (gen + 1u) * nloc) {
            __builtin_amdgcn_fence(__ATOMIC_RELEASE, "agent");
            asm volatile("s_waitcnt vmcnt(0)" ::: "memory");
            const unsigned og = xb_add(&bar[XB_TOP], 1u);
            const unsigned tg = og / nx;
            if (og + 1u == (tg + 1u) * nx) xb_add(&bar[XB_TOPGEN], 1u);
            else XB_SPIN(xb_ld(&bar[XB_TOPGEN]) == tg, bar);
            __builtin_amdgcn_fence(__ATOMIC_ACQUIRE, "agent");
            xb_add(&bar[XB_XGEN(b.x)], 1u);
            asm volatile("s_waitcnt vmcnt(0)" ::: "memory");
        } else {
            XB_SPIN(xb_ld(&bar[XB_XGEN(b.x)]) == gen, bar);
            __builtin_amdgcn_fence(__ATOMIC_ACQUIRE, "agent");
            asm volatile("s_waitcnt vmcnt(0)" ::: "memory");
        }
    }
    __syncthreads();
}

#ifndef REP_IN
#define REP_IN 1
#endif
#ifndef REP_P2
#define REP_P2 1
#endif
#ifndef REP_P3
#define REP_P3 1
#endif
#ifndef REP_P4
#define REP_P4 1
#endif
#ifndef REP_OUT
#define REP_OUT 1
#endif
#ifndef REP_SYNC
#define REP_SYNC 1
#endif
#define GSYNC() do { for (int _r = 0; _r < REP_SYNC; ++_r) xcd_barrier(xb); } while (0)
__global__ void __launch_bounds__(256, 2) hymba_mega(Params p) {
    __shared__ __attribute__((aligned(16))) unsigned char smem[65536];
    LAS unsigned char* lds = (LAS unsigned char*)smem;
    cg::grid_group grid = cg::this_grid();
    const int nb = gridDim.x, bid = blockIdx.x;
    if (p.ws == nullptr) grid.sync();
    volatile LAS unsigned* xst = (volatile LAS unsigned*)(lds + 65520);
    if (threadIdx.x == 0) { xst[0] = 0u; xst[1] = 0u; }
    __syncthreads();
    XcdBarrier xb = xcd_barrier_post((unsigned*)(p.ws + OFF_BAR), xst);
    float* SSQ = (float*)(p.ws + OFF_SSQ);
    bf16_t* BUFA = (bf16_t*)(p.ws + OFF_BUFA); bf16_t* BUFB = (bf16_t*)(p.ws + OFF_BUFB);

    phase_prep(p, lds);
    grid.sync();
#pragma unroll 1
    for (int layer = 0; layer < 2; ++layer) {
        {
            EpiIn e; e.ssq = SSQ; e.U = (bf16_t*)(p.ws + OFF_U); e.ZC = (bf16_t*)(p.ws + OFF_ZC); e.Q = (bf16_t*)(p.ws + OFF_Q); e.Kb = (bf16_t*)(p.ws + OFF_K);
            e.V = (bf16_t*)(p.ws + OFF_V); e.ZG = (bf16_t*)(p.ws + OFF_ZG); e.LR = (float*)(p.ws + OFF_LR);
            const bf16_t* A = layer == 0 ? BUFA : BUFB; const bf16_t* Bt = (const bf16_t*)(p.ws + OFF_WIN) + (size_t)layer * NIN * 1024;
            int pm, pn;
            for (int rep = 0; rep < REP_IN; ++rep)
            for (int it = 0; gemm_next(it, 25, pm, pn); ++it) gemm_unit(A, 1024, Bt, 1024, 1024, pm * 128, pn * 128, lds, e, pn);
        }
        GSYNC();
        for (int rep = 0; rep < REP_P2; ++rep)
        for (int u = bid; u < 2816; u += nb) {
            if (u < 1024) gla_ds_unit(p, layer, u, lds);
            else if (u < 2048) { const int v = u - 1024; conv_unit(p, layer, false, v >> 7, (v >> 2) & 31, v & 3, lds); }
            else if (u < 2304) { const int v = u - 2048; conv_unit(p, layer, true, v >> 2, 0, v & 3, lds); }
            else gla_sample_unit(p, layer, u - 2304, lds);
        }
        GSYNC();
        {
            for (int rep = 0; rep < REP_P3; ++rep) {
            for (int u = bid; u < 256; u += nb) scan_unit(p, layer, u);
            EpiPw e; e.bias = p.b_pw + layer * 512; e.ZC = (const bf16_t*)(p.ws + OFF_ZC); e.MIX = BUFA;
            const bf16_t* A = (const bf16_t*)(p.ws + OFF_CVG); const bf16_t* Bt = (const bf16_t*)(p.ws + OFF_WPW) + (size_t)layer * 512 * 512;
            int pm, pn;
            for (int it = 0; gemm_next(it, 4, pm, pn); ++it) gemm_unit(A, 512, Bt, 512, 512, pm * 128, pn * 128, lds, e, pn); }
        }
        GSYNC();
        for (int rep = 0; rep < REP_P4; ++rep)
        for (int u = bid; u < 1024; u += nb) gla_out_unit(p, layer, u, lds);
        GSYNC();
        {
            EpiOut e; e.p = &p; e.layer = layer; e.XO = p.out + OUT_Y; e.XB = BUFB; e.ssq = SSQ;
            const bf16_t* Bt = (const bf16_t*)(p.ws + OFF_WOUT) + (size_t)layer * 1024 * 1024;
            int pm, pn;
            for (int rep = 0; rep < (layer == 0 ? REP_OUT : 1); ++rep)
            for (int it = 0; gemm_next(it, 8, pm, pn); ++it) gemm_unit(BUFA, 1024, Bt, 1024, 1024, pm * 128, pn * 128, lds, e, pn);
        }
        GSYNC();
    }
    {
        const int tid0 = tid_(); const int wid = tid0 >> 6, lane = tid0 & 63;
        for (int row = bid * 4 + wid; row < NTOK; row += nb * 4) {
            float s = lane < 16 ? SSQ[(size_t)row * 16 + lane] : 0.f; s = wave_sum(s);
            const float r = rsqrtf(s * (1.0f / 1024.0f) + EPS);
            float* xr = p.out + OUT_Y + (size_t)row * 1024;
#pragma unroll
            for (int i = 0; i < 4; ++i) { const int col = i * 256 + lane * 4; f32x4 a = *(const f32x4*)(xr + col); const f32x4 g = *(const f32x4*)(p.final_g + col);
                a = a * r * g; *(f32x4*)(xr + col) = a; }
        }
    }
}

extern "C" void kernel_launch(void* const* d_in, const int* in_sizes, int n_in, void* d_out, int out_size, void* d_ws, size_t ws_size, hipStream_t stream) {
    static int grid_blocks = 0;
    if (!grid_blocks) {
        int dev = 0, cus = 0, per_cu = 0;
        (void)hipGetDevice(&dev);
        (void)hipDeviceGetAttribute(&cus, hipDeviceAttributeMultiprocessorCount, dev);
        (void)hipOccupancyMaxActiveBlocksPerMultiprocessor(&per_cu, hymba_mega, 256, 0);
        if (per_cu > 2) per_cu = 2;
        if (per_cu < 1) per_cu = 1;
        grid_blocks = cus * per_cu;
    }
    if (ws_size < WS_NEED) fprintf(stderr, "workspace too small: %zu < %zu\n", ws_size, (size_t)WS_NEED);
    Params p{};
    p.x_prompt = (const float*)d_in[0]; p.x_sample = (const float*)d_in[1]; p.cache_conv = (const float*)d_in[2]; p.state_gla = (const float*)d_in[3];
    p.norm_g = (const float*)d_in[4]; p.w_in = (const float*)d_in[5]; p.w_alpha = (const float*)d_in[6]; p.b_alpha = (const float*)d_in[7];
    p.conv_w = (const float*)d_in[8]; p.conv_b = (const float*)d_in[9]; p.cn_g = (const float*)d_in[10]; p.cn_b = (const float*)d_in[11];
    p.w_pw = (const float*)d_in[12]; p.b_pw = (const float*)d_in[13]; p.gla_g = (const float*)d_in[14]; p.w_out = (const float*)d_in[15]; p.final_g = (const float*)d_in[16];
    p.out = (float*)d_out; p.ws = (unsigned char*)d_ws;
    (void)hipMemsetAsync((unsigned char*)d_ws + OFF_BAR, 0, 16384, stream);
    void* args[] = {&p};
    hipError_t e = hipLaunchCooperativeKernel((void*)hymba_mega, dim3(grid_blocks), dim3(256), args, 0, stream);
    if (e != hipSuccess) fprintf(stderr, "cooperative launch failed: %s (grid %d)\n", hipGetErrorString(e), grid_blocks);
}
```

```cpp
#include <hip/hip_runtime.h>
#include <hip/hip_cooperative_groups.h>
#include <cstdint>
#include <cstdio>
namespace cg = cooperative_groups;

#define LAS __attribute__((address_space(3)))
typedef unsigned short bf16_t;
typedef short bf16x8 __attribute__((ext_vector_type(8)));
typedef float f32x4 __attribute__((ext_vector_type(4)));
typedef unsigned u32x2 __attribute__((ext_vector_type(2)));
typedef unsigned u32x4 __attribute__((ext_vector_type(4)));

constexpr int NTOK = 17408, NPROMPT = 16384;
constexpr int SEQ = 2048, BATCH = 8, DEC_B = 128, DEC_T = 8;
constexpr int NIN = 3200;
constexpr float EPS = 1e-6f;

constexpr size_t OFF_WIN  = 0;
constexpr size_t OFF_WPW  = OFF_WIN  + (size_t)2 * NIN * 1024 * 2;
constexpr size_t OFF_WOUT = OFF_WPW  + (size_t)2 * 512 * 512 * 2;
constexpr size_t OFF_BUFA = OFF_WOUT + (size_t)2 * 1024 * 1024 * 2;
constexpr size_t OFF_BUFB = OFF_BUFA + (size_t)NTOK * 1024 * 2;
constexpr size_t OFF_U    = OFF_BUFB + (size_t)NTOK * 1024 * 2;
constexpr size_t OFF_ZC   = OFF_U    + (size_t)NTOK * 512 * 2;
constexpr size_t OFF_Q    = OFF_ZC   + (size_t)NTOK * 512 * 2;
constexpr size_t OFF_K    = OFF_Q    + (size_t)NTOK * 256 * 2;
constexpr size_t OFF_V    = OFF_K    + (size_t)NTOK * 256 * 2;
constexpr size_t OFF_ZG   = OFF_V    + (size_t)NTOK * 512 * 2;
constexpr size_t OFF_LR   = OFF_ZG   + (size_t)NTOK * 512 * 2;
constexpr size_t OFF_CVG  = OFF_LR   + (size_t)NTOK * 16 * 4;
constexpr size_t OFF_DS   = OFF_CVG  + (size_t)NTOK * 512 * 2;
constexpr size_t OFF_SB   = OFF_DS   + (size_t)1024 * 8192 * 4;
constexpr size_t OFF_DEC  = OFF_SB   + (size_t)1024 * 8192 * 2;
constexpr size_t OFF_SSQ  = OFF_DEC  + (size_t)1024 * 64 * 4;
constexpr size_t OFF_BAR  = OFF_SSQ  + (size_t)NTOK * 16 * 4;
constexpr size_t WS_NEED  = OFF_BAR  + 16384;

constexpr size_t OUT_Y    = 0;
constexpr size_t OUT_CCP  = (size_t)NTOK * 1024;
constexpr size_t OUT_SGP  = OUT_CCP + (size_t)2 * 8 * 30 * 512;
constexpr size_t OUT_CCS  = OUT_SGP + (size_t)2 * 8 * 4 * 64 * 128;
constexpr size_t OUT_SGS  = OUT_CCS + (size_t)2 * 128 * 30 * 512;

struct Params {
    const float *x_prompt, *x_sample, *cache_conv, *state_gla, *norm_g, *w_in, *w_alpha, *b_alpha, *conv_w, *conv_b,
                *cn_g, *cn_b, *w_pw, *b_pw, *gla_g, *w_out, *final_g;
    float* out;
    unsigned char* ws;
};

__device__ __forceinline__ unsigned pk2(float lo, float hi) { unsigned r; asm("v_cvt_pk_bf16_f32 %0, %1, %2" : "=v"(r) : "v"(lo), "v"(hi)); return r; }
__device__ __forceinline__ float bf2f(bf16_t h) { return __uint_as_float(((unsigned)h) << 16); }
__device__ __forceinline__ float bflo(unsigned w) { return __uint_as_float(w << 16); }
__device__ __forceinline__ float bfhi(unsigned w) { return __uint_as_float(w & 0xffff0000u); }
__device__ __forceinline__ float sigmoidf_(float x) { return __builtin_amdgcn_rcpf(1.0f + __expf(-x)); }
__device__ __forceinline__ float siluf_(float x) { return x * sigmoidf_(x); }
__device__ __forceinline__ float wave_sum(float v) {
#pragma unroll
    for (int o = 32; o >= 1; o >>= 1) v += __shfl_xor(v, o);
    return v;
}
__device__ __forceinline__ int tid_() { int t = threadIdx.x; asm volatile("" : "+v"(t)); return t; }
__device__ __forceinline__ const float* xrow_in(const Params& p, int row) {
    return row < NPROMPT ? p.x_prompt + (size_t)row * 1024 : p.x_sample + (size_t)(row - NPROMPT) * 1024;
}

template <class Epi>
__device__ __forceinline__ void gemm_unit(const bf16_t* __restrict__ A, int lda, const bf16_t* __restrict__ Bt, int ldb, int K,
                                          int row0, int brow0, LAS unsigned char* lds, const Epi& epi, int pn) {
    const int tid = tid_(), wid = tid >> 6, lane = tid & 63, wr = wid >> 1, wc = wid & 1, fr = lane & 15, fq = lane >> 4;
    f32x4 acc[4][4];
#pragma unroll
    for (int m = 0; m < 4; ++m)
#pragma unroll
        for (int n = 0; n < 4; ++n) acc[m][n] = (f32x4){0.f, 0.f, 0.f, 0.f};
    const int srow = wid * 32 + (lane >> 3), schunk = (lane & 7) ^ (lane >> 3);
    const bf16_t* ga = A + (size_t)(row0 + srow) * lda + schunk * 8;
    const bf16_t* gb = Bt + (size_t)(brow0 + srow) * ldb + schunk * 8;
    const size_t astep = (size_t)8 * lda, bstep = (size_t)8 * ldb;
    const unsigned sdst = (unsigned)(wid * 4096 + lane * 16);
    const int nt = K >> 6;
    epi.pre(row0, lds);
#define GEMM_STAGE(t, buf) do { _Pragma("unroll") for (int i = 0; i < 4; ++i) { \
        __builtin_amdgcn_global_load_lds((const unsigned*)(ga + i * astep + (t) * 64), (LAS unsigned*)(lds + (buf) * 32768 + sdst + i * 1024), 16, 0, 0); \
        __builtin_amdgcn_global_load_lds((const unsigned*)(gb + i * bstep + (t) * 64), (LAS unsigned*)(lds + (buf) * 32768 + 16384 + sdst + i * 1024), 16, 0, 0); } } while (0)
    const unsigned sw0 = (unsigned)((fq ^ (fr & 7)) * 16), sw1 = (unsigned)(((4 + fq) ^ (fr & 7)) * 16);
    const unsigned arow = (unsigned)((wr * 64 + fr) * 128), brow = (unsigned)(16384 + (wc * 64 + fr) * 128);
    GEMM_STAGE(0, 0);
#pragma unroll 2
    for (int t = 0; t < nt; ++t) {
        asm volatile("s_waitcnt vmcnt(0)" ::: "memory");
        __syncthreads();
        if (t + 1 < nt) GEMM_STAGE(t + 1, (t + 1) & 1);
        LAS unsigned char* sb = lds + (t & 1) * 32768;
#pragma unroll
        for (int kk = 0; kk < 2; ++kk) {
            const unsigned sw = kk ? sw1 : sw0;
            bf16x8 af[4], bfr[4];
#pragma unroll
            for (int m = 0; m < 4; ++m) af[m] = *(LAS bf16x8*)(sb + arow + sw + m * 2048);
#pragma unroll
            for (int n = 0; n < 4; ++n) bfr[n] = *(LAS bf16x8*)(sb + brow + sw + n * 2048);
            __builtin_amdgcn_s_setprio(1);
#pragma unroll
            for (int m = 0; m < 4; ++m)
#pragma unroll
                for (int n = 0; n < 4; ++n) acc[m][n] = __builtin_amdgcn_mfma_f32_16x16x32_bf16(bfr[n], af[m], acc[m][n], 0, 0, 0);
            __builtin_amdgcn_s_setprio(0);
        }
    }
#undef GEMM_STAGE
    epi(acc, row0, pn, wr, wc, fr, fq, lds);
    __syncthreads();
}

__device__ __forceinline__ bool gemm_next(int it, int nN, int& pm, int& pn, int first_unit_offset = 0) {
    const int nb = gridDim.x, bid = blockIdx.x;
    if ((nb & 7) == 0) {
        const int xcd = bid & 7, j = bid >> 3, nj = nb >> 3; const int u = j + it * nj;
        if (u >= 17 * nN) return false;
        pm = xcd + 8 * (u / nN); pn = u % nN; return true;
    } else {
        const int u = bid + it * nb; if (u >= 136 * nN) return false; pm = u / nN; pn = u % nN; return true;
    }
}

struct EpiIn {
    const float* ssq; bf16_t *U, *ZC, *Q, *Kb, *V, *ZG; float* LR;
    __device__ __forceinline__ void pre(int row0, LAS unsigned char* lds) const {
        LAS float* rs = (LAS float*)(lds + 65536);
        const int tid = tid_();
        if (tid < 128) { const f32x4* s = (const f32x4*)(ssq + (size_t)(row0 + tid) * 16); f32x4 a = s[0], b = s[1], c = s[2], d = s[3];
            float t = (a[0] + a[1] + a[2] + a[3]) + (b[0] + b[1] + b[2] + b[3]) + (c[0] + c[1] + c[2] + c[3]) + (d[0] + d[1] + d[2] + d[3]);
            rs[tid] = rsqrtf(t * (1.0f / 1024.0f) + EPS); }
    }
    __device__ __forceinline__ void operator()(f32x4 (&acc)[4][4], int row0, int pn, int wr, int wc, int fr, int fq, LAS unsigned char* lds) const {
        const LAS float* rs = (const LAS float*)(lds + 65536);
#pragma unroll
        for (int m = 0; m < 4; ++m) {
            const int rl = wr * 64 + m * 16 + fr; const size_t row = (size_t)(row0 + rl); const float r = rs[rl];
            if (pn < 8) {
#pragma unroll
                for (int n = 0; n < 2; ++n) { f32x4 a = acc[m][n] * r, g = acc[m][n + 2] * r; u32x2 w;
                    w.x = pk2(a[0] * sigmoidf_(g[0]), a[1] * sigmoidf_(g[1])); w.y = pk2(a[2] * sigmoidf_(g[2]), a[3] * sigmoidf_(g[3]));
                    *(u32x2*)(U + row * 512 + pn * 64 + wc * 32 + n * 16 + fq * 4) = w; }
            } else if (pn < 12) {
#pragma unroll
                for (int n = 0; n < 4; ++n) { f32x4 a = acc[m][n] * r; u32x2 w; w.x = pk2(siluf_(a[0]), siluf_(a[1])); w.y = pk2(siluf_(a[2]), siluf_(a[3]));
                    *(u32x2*)(ZC + row * 512 + (pn - 8) * 128 + wc * 64 + n * 16 + fq * 4) = w; }
            } else if (pn < 14) {
#pragma unroll
                for (int n = 0; n < 4; ++n) { f32x4 a = acc[m][n] * (r * 0.125f); u32x2 w; w.x = pk2(a[0], a[1]); w.y = pk2(a[2], a[3]);
                    *(u32x2*)(Q + row * 256 + (pn - 12) * 128 + wc * 64 + n * 16 + fq * 4) = w; }
            } else if (pn < 16) {
#pragma unroll
                for (int n = 0; n < 4; ++n) { f32x4 a = acc[m][n] * r; u32x2 w; w.x = pk2(a[0], a[1]); w.y = pk2(a[2], a[3]);
                    *(u32x2*)(Kb + row * 256 + (pn - 14) * 128 + wc * 64 + n * 16 + fq * 4) = w; }
            } else if (pn < 20) {
#pragma unroll
                for (int n = 0; n < 4; ++n) { f32x4 a = acc[m][n] * r; u32x2 w; w.x = pk2(a[0], a[1]); w.y = pk2(a[2], a[3]);
                    *(u32x2*)(V + row * 512 + (pn - 16) * 128 + wc * 64 + n * 16 + fq * 4) = w; }
            } else if (pn < 24) {
#pragma unroll
                for (int n = 0; n < 4; ++n) { f32x4 a = acc[m][n] * r; u32x2 w; w.x = pk2(siluf_(a[0]), siluf_(a[1])); w.y = pk2(siluf_(a[2]), siluf_(a[3]));
                    *(u32x2*)(ZG + row * 512 + (pn - 20) * 128 + wc * 64 + n * 16 + fq * 4) = w; }
            } else {
                if (wc == 0) { f32x4 a = acc[m][0] * r; *(f32x4*)(LR + row * 16 + fq * 4) = a; }
            }
        }
    }
};

struct EpiPw {
    const float* bias; const bf16_t* ZC; bf16_t* MIX;
    __device__ __forceinline__ void pre(int, LAS unsigned char*) const {}
    __device__ __forceinline__ void operator()(f32x4 (&acc)[4][4], int row0, int pn, int wr, int wc, int fr, int fq, LAS unsigned char*) const {
#pragma unroll
        for (int n = 0; n < 4; ++n) {
            const int col = pn * 128 + wc * 64 + n * 16 + fq * 4; const f32x4 b = *(const f32x4*)(bias + col);
#pragma unroll
            for (int m = 0; m < 4; ++m) { const size_t row = (size_t)(row0 + wr * 64 + m * 16 + fr);
                const u32x2 z = *(const u32x2*)(ZC + row * 512 + col); f32x4 a = acc[m][n] + b; u32x2 w;
                w.x = pk2(a[0] * bflo(z.x), a[1] * bfhi(z.x)); w.y = pk2(a[2] * bflo(z.y), a[3] * bfhi(z.y));
                *(u32x2*)(MIX + row * 1024 + col) = w; }
        }
    }
};

struct EpiOut {
    const Params* p; int layer; float* XO; bf16_t* XB; float* ssq;
    __device__ __forceinline__ void pre(int, LAS unsigned char*) const {}
    __device__ __forceinline__ void operator()(f32x4 (&acc)[4][4], int row0, int pn, int wr, int wc, int fr, int fq, LAS unsigned char*) const {
#pragma unroll
        for (int m = 0; m < 4; ++m) {
            const int row = row0 + wr * 64 + m * 16 + fr;
            float s = 0.f;
            if (layer == 0) {
                const float* xr = xrow_in(*p, row);
#pragma unroll
                for (int n = 0; n < 4; ++n) { const int col = pn * 128 + wc * 64 + n * 16 + fq * 4;
                    const f32x4 a = acc[m][n] + *(const f32x4*)(xr + col);
                    u32x2 w; w.x = pk2(a[0], a[1]); w.y = pk2(a[2], a[3]); *(u32x2*)(XB + (size_t)row * 1024 + col) = w;
                    const float b0 = bflo(w.x), b1 = bfhi(w.x), b2 = bflo(w.y), b3 = bfhi(w.y);
                    s += (b0 * b0 + b1 * b1) + (b2 * b2 + b3 * b3); }
            } else {
#pragma unroll
                for (int n = 0; n < 4; ++n) { const int col = pn * 128 + wc * 64 + n * 16 + fq * 4;
                    const u32x2 xr = *(const u32x2*)(XB + (size_t)row * 1024 + col);
                    f32x4 a = acc[m][n]; a[0] += bflo(xr.x); a[1] += bfhi(xr.x); a[2] += bflo(xr.y); a[3] += bfhi(xr.y);
                    *(f32x4*)(XO + (size_t)row * 1024 + col) = a;
                    s += (a[0] * a[0] + a[1] * a[1]) + (a[2] * a[2] + a[3] * a[3]); }
            }
            s += __shfl_xor(s, 16); s += __shfl_xor(s, 32);
            if (fq == 0) ssq[(size_t)row * 16 + pn * 2 + wc] = s;
        }
    }
};

__device__ __forceinline__ int inproj_dst_row(int n) {
    if (n < 1024) { const int gl = n >= 512, ch = n & 511; const int T = ch >> 6, wc = (ch >> 5) & 1, f1 = (ch >> 4) & 1, i = ch & 15;
        return T * 128 + wc * 64 + (f1 + 2 * gl) * 16 + i; }
    return n;
}
__device__ void prep_w_tile(const float* W, int ldw, int ncols, const float* g, bf16_t* Wt, int K, int k0, int n0, bool permute, LAS unsigned char* lds) {
    LAS bf16_t* tile = (LAS bf16_t*)lds;
    const int tid = tid_(), c = tid & 63, kq = tid >> 6;
    const int n = n0 + c * 4;
    f32x4 v[8];
#pragma unroll
    for (int i = 0; i < 8; ++i) v[i] = n < ncols ? *(const f32x4*)(W + (size_t)(k0 + kq + 4 * i) * ldw + n) : (f32x4){0.f, 0.f, 0.f, 0.f};
    if (g) {
#pragma unroll
        for (int i = 0; i < 8; ++i) v[i] = v[i] * g[k0 + kq + 4 * i];
    }
#pragma unroll
    for (int i = 0; i < 8; ++i) { u32x2 w; w.x = pk2(v[i][0], v[i][1]); w.y = pk2(v[i][2], v[i][3]); *(LAS u32x2*)(tile + (kq + 4 * i) * 264 + c * 4) = w; }
    __syncthreads();
#pragma unroll
    for (int j = 0; j < 4; ++j) { const int item = tid + j * 256, col = item & 255, ch = item >> 8; const int ns = n0 + col;
        if (ns < ncols) { const int r = permute ? inproj_dst_row(ns) : ns;
            unsigned short e[8];
#pragma unroll
            for (int q = 0; q < 8; ++q) e[q] = tile[(ch * 8 + q) * 264 + col];
            u32x4 w; w.x = e[0] | ((unsigned)e[1] << 16); w.y = e[2] | ((unsigned)e[3] << 16); w.z = e[4] | ((unsigned)e[5] << 16); w.w = e[6] | ((unsigned)e[7] << 16);
            *(u32x4*)(Wt + (size_t)r * K + k0 + ch * 8) = w; } }
    __syncthreads();
}
__device__ __forceinline__ void prep_w_unit(const Params& p, int u, LAS unsigned char* lds) {
    bf16_t* WIN = (bf16_t*)(p.ws + OFF_WIN); bf16_t* WPW = (bf16_t*)(p.ws + OFF_WPW); bf16_t* WOUT = (bf16_t*)(p.ws + OFF_WOUT);
    if (u < 832) { const int l = u / 416, v = u % 416, kt = v / 13, nt = v % 13;
        prep_w_tile(p.w_in + (size_t)l * 1024 * 3088, 3088, 3088, p.norm_g + l * 1024, WIN + (size_t)l * NIN * 1024, 1024, kt * 32, nt * 256, true, lds);
    } else if (u < 896) { const int w = u - 832, l = w / 32, v = w % 32, kt = v / 2, nt = v % 2;
        prep_w_tile(p.w_pw + (size_t)l * 512 * 512, 512, 512, nullptr, WPW + (size_t)l * 512 * 512, 512, kt * 32, nt * 256, false, lds);
    } else if (u < 1152) { const int w = u - 896, l = w / 128, v = w % 128, kt = v / 4, nt = v % 4;
        prep_w_tile(p.w_out + (size_t)l * 1024 * 1024, 1024, 1024, nullptr, WOUT + (size_t)l * 1024 * 1024, 1024, kt * 32, nt * 256, false, lds);
    } else { const int l = u - 1152; u32x4* z = (u32x4*)(WIN + (size_t)l * NIN * 1024 + (size_t)3088 * 1024);
        for (int i = tid_(); i < 112 * 1024 / 8; i += 256) z[i] = (u32x4){0u, 0u, 0u, 0u}; }
}
__device__ void phase_prep(const Params& p, LAS unsigned char* lds) {
    bf16_t* XB = (bf16_t*)(p.ws + OFF_BUFA); float* SSQ = (float*)(p.ws + OFF_SSQ);
    const int nb = gridDim.x, bid = blockIdx.x;
    const int tid0 = tid_(); const int wid = tid0 >> 6, lane = tid0 & 63;
    for (int row = (bid * 4 + wid) * 2; row < NTOK; row += nb * 8) {
        const float* xr0 = xrow_in(p, row); const float* xr1 = xrow_in(p, row + 1);
        f32x4 a[2][4];
#pragma unroll
        for (int i = 0; i < 4; ++i) { a[0][i] = *(const f32x4*)(xr0 + i * 256 + lane * 4); a[1][i] = *(const f32x4*)(xr1 + i * 256 + lane * 4); }
#pragma unroll
        for (int q = 0; q < 2; ++q) { float s = 0.f;
#pragma unroll
            for (int i = 0; i < 4; ++i) { const f32x4 v = a[q][i]; s += (v[0] * v[0] + v[1] * v[1]) + (v[2] * v[2] + v[3] * v[3]);
                u32x2 w; w.x = pk2(v[0], v[1]); w.y = pk2(v[2], v[3]); *(u32x2*)(XB + (size_t)(row + q) * 1024 + i * 256 + lane * 4) = w; }
            s = wave_sum(s);
            if (lane < 16) SSQ[(size_t)(row + q) * 16 + lane] = lane == 0 ? s : 0.f; }
    }
    for (int u = bid; u < 416; u += nb) prep_w_unit(p, u, lds);
    if (bid == nb - 1) prep_w_unit(p, 1152, lds);
}

template <int NT>
__device__ __forceinline__ void compute_bcum(const Params& p, int layer, int h, const float* LR, int row0, LAS float* G, LAS float* LRS) {
    const int tid = tid_(), d = tid & 63, tq = tid >> 6;
    if (tid < NT * 4) *(LAS f32x4*)(LRS + tid * 4) = *(const f32x4*)(LR + (size_t)row0 * 16 + tid * 4);
    float wa[16];
#pragma unroll
    for (int r = 0; r < 16; ++r) wa[r] = p.w_alpha[(size_t)layer * 16 * 256 + r * 256 + h * 64 + d];
    const float ba = p.b_alpha[layer * 256 + h * 64 + d];
    __syncthreads();
    constexpr int PER = NT / 4;
#pragma unroll 4
    for (int i = 0; i < PER; ++i) { const int t = tq * PER + i;
        const LAS f32x4* lp = (const LAS f32x4*)(LRS + t * 16);
        float z = ba;
#pragma unroll
        for (int r4 = 0; r4 < 4; ++r4) { const f32x4 v = lp[r4]; z += v[0] * wa[r4 * 4] + v[1] * wa[r4 * 4 + 1] + v[2] * wa[r4 * 4 + 2] + v[3] * wa[r4 * 4 + 3]; }
        const float ls = fminf(z, 0.f) - __logf(1.0f + __expf(-fabsf(z)));
        G[t * 64 + d] = ls * (1.0f / 16.0f);
    }
    __syncthreads();
    if (tid < 64) { float run = 0.f;
#pragma unroll 8
        for (int t = 0; t < NT; ++t) { run += G[t * 64 + d]; G[t * 64 + d] = run; } }
    __syncthreads();
}

__device__ void conv_unit(const Params& p, int layer, bool sample, int b_or_pair, int tile, int cs, LAS unsigned char* lds) {
    const bf16_t* U = (const bf16_t*)(p.ws + OFF_U); bf16_t* CVG = (bf16_t*)(p.ws + OFF_CVG);
    LAS bf16_t* ub = (LAS bf16_t*)lds;
    const int tid = tid_(), wid = tid >> 6, lane = tid & 63;
    const int t0 = tile * 64;
    if (!sample) {
        for (int c = tid; c < 94 * 16; c += 256) { const int i = c >> 4, cc = c & 15; const int time = t0 - 30 + i;
            u32x4 v = (u32x4){0u, 0u, 0u, 0u};
            if (time >= 0) v = *(const u32x4*)(U + (size_t)(b_or_pair * SEQ + time) * 512 + cs * 128 + cc * 8);
            *(LAS u32x4*)(ub + i * 128 + cc * 8) = v; }
    } else {
        for (int c = tid; c < 76 * 16; c += 256) { const int i = c >> 4, cc = c & 15; const int sq = i >= 38, ii = i - sq * 38; const int s = b_or_pair * 2 + sq;
            u32x4 v;
            if (ii < 30) { const float* src = p.cache_conv + (((size_t)layer * DEC_B + s) * 30 + ii) * 512 + cs * 128 + cc * 8;
                const f32x4 a = *(const f32x4*)src, bb = *(const f32x4*)(src + 4);
                v.x = pk2(a[0], a[1]); v.y = pk2(a[2], a[3]); v.z = pk2(bb[0], bb[1]); v.w = pk2(bb[2], bb[3]);
                if (ii >= 8) { float* dst = p.out + OUT_CCS + (((size_t)layer * DEC_B + s) * 30 + (ii - 8)) * 512 + cs * 128 + cc * 8;
                    *(f32x4*)dst = a; *(f32x4*)(dst + 4) = bb; }
            } else v = *(const u32x4*)(U + (size_t)(NPROMPT + s * 8 + (ii - 30)) * 512 + cs * 128 + cc * 8);
            *(LAS u32x4*)(ub + i * 128 + cc * 8) = v; }
    }
    __syncthreads();
    const int gi = wid & 1, half = wid >> 1; const int chl = gi * 64 + lane, ch = cs * 128 + chl;
    float w[31];
#pragma unroll
    for (int j = 0; j < 31; ++j) w[j] = p.conv_w[((size_t)layer * 31 + j) * 512 + ch];
    const float cb = p.conv_b[layer * 512 + ch], lg = p.cn_g[layer * 512 + ch], lb = p.cn_b[layer * 512 + ch];
    const int rb = sample ? half * 38 : half * 32;
    const int nsteps = sample ? 2 : 8;
    const size_t grow0 = sample ? (size_t)(NPROMPT + (b_or_pair * 2 + half) * 8) : (size_t)(b_or_pair * SEQ + t0 + half * 32);
    for (int st = 0; st < nsteps; ++st) {
        float vals[34];
#pragma unroll
        for (int i = 0; i < 34; ++i) vals[i] = bf2f(ub[(rb + st * 4 + i) * 128 + chl]);
#pragma unroll
        for (int q = 0; q < 4; ++q) {
            float x = cb;
#pragma unroll
            for (int j = 0; j < 31; ++j) x = fmaf(w[j], vals[q + j], x);
            const float mu = wave_sum(x) * (1.0f / 64.0f); const float dlt = x - mu;
            const float var = wave_sum(dlt * dlt) * (1.0f / 64.0f);
            const float y = dlt * rsqrtf(var + EPS) * lg + lb;
            const float sv = siluf_(y);
            CVG[(grow0 + st * 4 + q) * 512 + ch] = (bf16_t)(pk2(sv, 0.f) & 0xffffu);
        }
    }
    if (!sample) {
        if (tile == 31) { for (int c = tid; c < 30 * 128; c += 256) { const int j = c >> 7, cc = c & 127;
            p.out[OUT_CCP + (((size_t)layer * BATCH + b_or_pair) * 30 + j) * 512 + cs * 128 + cc] = bf2f(ub[(64 + j) * 128 + cc]); } }
    } else {
        for (int c = tid; c < 2 * 8 * 128; c += 256) { const int sq = c >> 10, j = (c >> 7) & 7, cc = c & 127; const int s = b_or_pair * 2 + sq;
            p.out[OUT_CCS + (((size_t)layer * DEC_B + s) * 30 + 22 + j) * 512 + cs * 128 + cc] = bf2f(ub[(sq * 38 + 30 + j) * 128 + cc]); }
    }
    __syncthreads();
}

__device__ void gla_ds_unit(const Params& p, int layer, int unit, LAS unsigned char* lds) {
    const int h = unit & 3, bc = unit >> 2; const int row0 = bc * 64;
    const bf16_t* Kb = (const bf16_t*)(p.ws + OFF_K); const bf16_t* V = (const bf16_t*)(p.ws + OFF_V); const float* LR = (const float*)(p.ws + OFF_LR);
    float* DS = (float*)(p.ws + OFF_DS) + (size_t)unit * 8192; float* DEC = (float*)(p.ws + OFF_DEC) + (size_t)unit * 64;
    LAS float* G = (LAS float*)lds;
    LAS bf16_t* KT = (LAS bf16_t*)(lds + 16384);
    LAS bf16_t* VT = (LAS bf16_t*)(lds + 16384 + 9216);
    const int tid = tid_(), t = tid >> 2, qd = tid & 3;
    const u32x4* src = (const u32x4*)(Kb + (size_t)(row0 + t) * 256 + h * 64 + qd * 16);
    const u32x4* vs = (const u32x4*)(V + (size_t)(row0 + t) * 512 + h * 128 + qd * 32);
    const u32x4 a = src[0], b = src[1]; u32x4 vreg[4];
#pragma unroll
    for (int c = 0; c < 4; ++c) vreg[c] = vs[c];
    compute_bcum<64>(p, layer, h, LR, row0, G, (LAS float*)(lds + 16384 + 9216 + 18432));
    {
        const unsigned wv[8] = {a.x, a.y, a.z, a.w, b.x, b.y, b.z, b.w};
#pragma unroll
        for (int e = 0; e < 8; ++e) { const int d0 = qd * 16 + 2 * e;
            const float f0 = bflo(wv[e]) * __expf(G[63 * 64 + d0] - G[t * 64 + d0]);
            const float f1 = bfhi(wv[e]) * __expf(G[63 * 64 + d0 + 1] - G[t * 64 + d0 + 1]);
            const unsigned pk = pk2(f0, f1);
            KT[d0 * 72 + t] = (bf16_t)(pk & 0xffffu); KT[(d0 + 1) * 72 + t] = (bf16_t)(pk >> 16); }
#pragma unroll
        for (int c = 0; c < 4; ++c) { const u32x4 a2 = vreg[c]; const unsigned w2[4] = {a2.x, a2.y, a2.z, a2.w};
#pragma unroll
            for (int e = 0; e < 4; ++e) { const int dv = qd * 32 + c * 8 + 2 * e;
                VT[dv * 72 + t] = (bf16_t)(w2[e] & 0xffffu); VT[(dv + 1) * 72 + t] = (bf16_t)(w2[e] >> 16); } }
        if (tid < 64) DEC[tid] = __expf(G[63 * 64 + tid]);
    }
    __syncthreads();
    const int wid = tid >> 6, lane = tid & 63, fr = lane & 15, fq = lane >> 4;
    f32x4 acc[2][4];
#pragma unroll
    for (int m = 0; m < 2; ++m)
#pragma unroll
        for (int n = 0; n < 4; ++n) acc[m][n] = (f32x4){0.f, 0.f, 0.f, 0.f};
#pragma unroll
    for (int kk = 0; kk < 2; ++kk) {
        bf16x8 vf[2], kf[4];
#pragma unroll
        for (int m = 0; m < 2; ++m) vf[m] = *(LAS bf16x8*)(VT + (wid * 32 + m * 16 + fr) * 72 + kk * 32 + fq * 8);
#pragma unroll
        for (int n = 0; n < 4; ++n) kf[n] = *(LAS bf16x8*)(KT + (n * 16 + fr) * 72 + kk * 32 + fq * 8);
#pragma unroll
        for (int m = 0; m < 2; ++m)
#pragma unroll
            for (int n = 0; n < 4; ++n) acc[m][n] = __builtin_amdgcn_mfma_f32_16x16x32_bf16(kf[n], vf[m], acc[m][n], 0, 0, 0);
    }
#pragma unroll
    for (int m = 0; m < 2; ++m)
#pragma unroll
        for (int n = 0; n < 4; ++n) *(f32x4*)(DS + (size_t)(wid * 32 + m * 16 + fr) * 64 + n * 16 + fq * 4) = acc[m][n];
    __syncthreads();
}

__device__ void gla_sample_unit(const Params& p, int layer, int unit, LAS unsigned char* lds) {
    const int h = unit & 3, s = unit >> 2; const int row0 = NPROMPT + s * 8;
    const bf16_t* Q = (const bf16_t*)(p.ws + OFF_Q); const bf16_t* Kb = (const bf16_t*)(p.ws + OFF_K); const bf16_t* V = (const bf16_t*)(p.ws + OFF_V);
    const bf16_t* ZG = (const bf16_t*)(p.ws + OFF_ZG); const float* LR = (const float*)(p.ws + OFF_LR); bf16_t* MIX = (bf16_t*)(p.ws + OFF_BUFA);
    const float* S0 = p.state_gla + (((size_t)layer * DEC_B + s) * 4 + h) * 8192;
    float* SN = p.out + OUT_SGS + (((size_t)layer * DEC_B + s) * 4 + h) * 8192;
    LAS float* G = (LAS float*)lds;
    LAS float* QT = G + 512;
    LAS float* KT = QT + 512;
    LAS float* KD = KT + 512;
    LAS float* DCY = KD + 512;
    LAS float* ATT = DCY + 64;
    LAS float* VV = ATT + 64;
    LAS float* OP = VV + 1024;
    LAS float* RED = OP + 2048;
    compute_bcum<8>(p, layer, h, LR, row0, G, (LAS float*)(lds + 32768));
    const int tid = tid_();
#pragma unroll
    for (int i = 0; i < 2; ++i) { const int e = tid + i * 256, t = e >> 6, d = e & 63;
        const float bc = G[t * 64 + d], bl = G[7 * 64 + d];
        const float q = bf2f(Q[(size_t)(row0 + t) * 256 + h * 64 + d]), k = bf2f(Kb[(size_t)(row0 + t) * 256 + h * 64 + d]);
        QT[e] = q * __expf(bc); KT[e] = k * __expf(-bc); KD[e] = k * __expf(bl - bc);
        if (t == 7) DCY[d] = __expf(bl); }
#pragma unroll
    for (int i = 0; i < 4; ++i) { const int e = tid + i * 256, t = e >> 7, v = e & 127; VV[e] = bf2f(V[(size_t)(row0 + t) * 512 + h * 128 + v]); }
    __syncthreads();
    if (tid < 64) { const int t = tid >> 3, s2 = tid & 7; float a = 0.f;
        if (s2 <= t) { for (int d = 0; d < 64; ++d) a += QT[t * 64 + d] * KT[s2 * 64 + d]; }
        ATT[tid] = a; }
    __syncthreads();
    const int vcol = tid & 127, dh = tid >> 7;
    float o[8], v8[8];
#pragma unroll
    for (int t = 0; t < 8; ++t) { o[t] = 0.f; v8[t] = VV[t * 128 + vcol]; }
    float s0r[32];
#pragma unroll
    for (int dd = 0; dd < 32; ++dd) s0r[dd] = S0[(dh * 32 + dd) * 128 + vcol];
#pragma unroll
    for (int dd = 0; dd < 32; ++dd) { const int d = dh * 32 + dd; const float s0 = s0r[dd];
        float sn = s0 * DCY[d];
#pragma unroll
        for (int t = 0; t < 8; ++t) { o[t] = fmaf(QT[t * 64 + d], s0, o[t]); sn = fmaf(KD[t * 64 + d], v8[t], sn); }
        SN[d * 128 + vcol] = sn; }
    if (dh == 0) {
#pragma unroll
        for (int t = 0; t < 8; ++t)
#pragma unroll
            for (int s2 = 0; s2 < 8; ++s2) o[t] = fmaf(ATT[t * 8 + s2], v8[s2], o[t]);
    }
#pragma unroll
    for (int t = 0; t < 8; ++t) OP[(dh * 8 + t) * 128 + vcol] = o[t];
    __syncthreads();
    float val[4];
#pragma unroll
    for (int i = 0; i < 4; ++i) { const int t = dh * 4 + i; val[i] = OP[t * 128 + vcol] + OP[(8 + t) * 128 + vcol];
        const float ps = wave_sum(val[i] * val[i]); if ((tid & 63) == 0) RED[t * 4 + ((tid >> 6) & 1)] = ps; }
    __syncthreads();
    const float gg = p.gla_g[layer * 128 + vcol];
#pragma unroll
    for (int i = 0; i < 4; ++i) { const int t = dh * 4 + i; const float ms = (RED[t * 4] + RED[t * 4 + 1]) * (1.0f / 128.0f);
        const float zg = bf2f(ZG[(size_t)(row0 + t) * 512 + h * 128 + vcol]);
        const float r = val[i] * rsqrtf(ms + EPS) * gg * zg;
        MIX[(size_t)(row0 + t) * 1024 + 512 + h * 128 + vcol] = (bf16_t)(pk2(r, 0.f) & 0xffffu); }
    __syncthreads();
}

__device__ void scan_unit(const Params& p, int layer, int unit) {
    typedef float f32x2 __attribute__((ext_vector_type(2)));
    const int part = unit & 15, h = (unit >> 4) & 3, b = unit >> 6;
    const float* DS = (const float*)(p.ws + OFF_DS); const float* DEC = (const float*)(p.ws + OFF_DEC); bf16_t* SB = (bf16_t*)(p.ws + OFF_SB);
    const int e = part * 512 + tid_() * 2; const int dk = e & 63, dv = e >> 6;
    f32x2 S = (f32x2){0.f, 0.f};
#pragma unroll
    for (int i0 = 0; i0 < 32; i0 += 16) {
        f32x2 cur[16], dc[16];
#pragma unroll
        for (int i = 0; i < 16; ++i) { const size_t ug = (size_t)((b * 32 + i0 + i) * 4 + h);
            cur[i] = *(const f32x2*)(DS + ug * 8192 + e); dc[i] = *(const f32x2*)(DEC + ug * 64 + dk); }
#pragma unroll
        for (int i = 0; i < 16; ++i) { const size_t ug = (size_t)((b * 32 + i0 + i) * 4 + h);
            *(unsigned*)(SB + ug * 8192 + e) = pk2(S[0], S[1]);
            S = S * dc[i] + cur[i]; }
    }
    float* o = p.out + OUT_SGP + (((size_t)layer * BATCH + b) * 4 + h) * 8192;
    o[dk * 128 + dv] = S[0]; o[(dk + 1) * 128 + dv] = S[1];
}

__device__ void gla_out_unit(const Params& p, int layer, int unit, LAS unsigned char* lds) {
    const int h = unit & 3, bc = unit >> 2; const int row0 = bc * 64;
    const bf16_t* Q = (const bf16_t*)(p.ws + OFF_Q); const bf16_t* Kb = (const bf16_t*)(p.ws + OFF_K); const bf16_t* V = (const bf16_t*)(p.ws + OFF_V);
    const bf16_t* ZG = (const bf16_t*)(p.ws + OFF_ZG); const float* LR = (const float*)(p.ws + OFF_LR); bf16_t* MIX = (bf16_t*)(p.ws + OFF_BUFA);
    const bf16_t* SB = (const bf16_t*)(p.ws + OFF_SB) + (size_t)unit * 8192;
    LAS float* G = (LAS float*)lds;
    LAS bf16_t* QT = (LAS bf16_t*)(lds + 16384);
    LAS bf16_t* KT = (LAS bf16_t*)(lds + 16384 + 9216);
    LAS bf16_t* VT = (LAS bf16_t*)(lds + 16384 + 18432);
    LAS bf16_t* PP = (LAS bf16_t*)(lds + 16384 + 18432 + 18432);
    const int tid = tid_();
    const int t = tid >> 2, qd = tid & 3;
    const u32x4* qs = (const u32x4*)(Q + (size_t)(row0 + t) * 256 + h * 64 + qd * 16);
    const u32x4* ks = (const u32x4*)(Kb + (size_t)(row0 + t) * 256 + h * 64 + qd * 16);
    const u32x4* vs = (const u32x4*)(V + (size_t)(row0 + t) * 512 + h * 128 + qd * 32);
    const u32x4 qa = qs[0], qb = qs[1], ka = ks[0], kb = ks[1]; u32x4 vreg[4], sreg[4];
#pragma unroll
    for (int c = 0; c < 4; ++c) vreg[c] = vs[c];
#pragma unroll
    for (int c = 0; c < 4; ++c) sreg[c] = *(const u32x4*)(SB + (size_t)(tid + c * 256) * 8);
    compute_bcum<64>(p, layer, h, LR, row0, G, (LAS float*)PP);
    {
        const unsigned qw[8] = {qa.x, qa.y, qa.z, qa.w, qb.x, qb.y, qb.z, qb.w}; const unsigned kw[8] = {ka.x, ka.y, ka.z, ka.w, kb.x, kb.y, kb.z, kb.w};
        unsigned qo[8], ko[8];
#pragma unroll
        for (int e = 0; e < 8; ++e) { const int d0 = qd * 16 + 2 * e; const float g0 = G[t * 64 + d0], g1 = G[t * 64 + d0 + 1];
            const float e0 = __expf(g0), e1 = __expf(g1);
            qo[e] = pk2(bflo(qw[e]) * e0, bfhi(qw[e]) * e1);
            ko[e] = pk2(bflo(kw[e]) * __builtin_amdgcn_rcpf(e0), bfhi(kw[e]) * __builtin_amdgcn_rcpf(e1)); }
        *(LAS u32x4*)(QT + t * 72 + qd * 16) = (u32x4){qo[0], qo[1], qo[2], qo[3]}; *(LAS u32x4*)(QT + t * 72 + qd * 16 + 8) = (u32x4){qo[4], qo[5], qo[6], qo[7]};
        *(LAS u32x4*)(KT + t * 72 + qd * 16) = (u32x4){ko[0], ko[1], ko[2], ko[3]}; *(LAS u32x4*)(KT + t * 72 + qd * 16 + 8) = (u32x4){ko[4], ko[5], ko[6], ko[7]};
#pragma unroll
        for (int c = 0; c < 4; ++c) { const u32x4 a2 = vreg[c]; const unsigned w2[4] = {a2.x, a2.y, a2.z, a2.w};
#pragma unroll
            for (int e = 0; e < 4; ++e) { const int dv = qd * 32 + c * 8 + 2 * e;
                VT[dv * 72 + t] = (bf16_t)(w2[e] & 0xffffu); VT[(dv + 1) * 72 + t] = (bf16_t)(w2[e] >> 16); } }
    }
    __syncthreads();
    {
#pragma unroll
        for (int c = 0; c < 4; ++c) { const int ci = tid + c * 256, r = ci >> 3, ch = ci & 7;
            *(LAS u32x4*)(lds + r * 128 + ((ch ^ (r & 7)) * 16)) = sreg[c]; }
    }
    __syncthreads();
    const int wid = tid >> 6, lane = tid & 63, fr = lane & 15, fq = lane >> 4;
    LAS bf16_t* PW = PP + wid * 16 * 72;
    {
        bf16x8 qf[2];
#pragma unroll
        for (int kk = 0; kk < 2; ++kk) qf[kk] = *(LAS bf16x8*)(QT + (wid * 16 + fr) * 72 + kk * 32 + fq * 8);
#pragma unroll
        for (int n = 0; n < 4; ++n) {
            f32x4 a = (f32x4){0.f, 0.f, 0.f, 0.f};
#pragma unroll
            for (int kk = 0; kk < 2; ++kk) { const bf16x8 kf = *(LAS bf16x8*)(KT + (n * 16 + fr) * 72 + kk * 32 + fq * 8);
                a = __builtin_amdgcn_mfma_f32_16x16x32_bf16(kf, qf[kk], a, 0, 0, 0); }
            const int tg = wid * 16 + fr, sg = n * 16 + fq * 4;
            u32x2 w; w.x = pk2(sg <= tg ? a[0] : 0.f, sg + 1 <= tg ? a[1] : 0.f); w.y = pk2(sg + 2 <= tg ? a[2] : 0.f, sg + 3 <= tg ? a[3] : 0.f);
            *(LAS u32x2*)(PW + fr * 72 + n * 16 + fq * 4) = w;
        }
    }
    __builtin_amdgcn_s_waitcnt(0xc07f);
    __builtin_amdgcn_wave_barrier();
    f32x4 acc[8];
#pragma unroll
    for (int n = 0; n < 8; ++n) acc[n] = (f32x4){0.f, 0.f, 0.f, 0.f};
#pragma unroll
    for (int kk = 0; kk < 2; ++kk) {
        const bf16x8 qf = *(LAS bf16x8*)(QT + (wid * 16 + fr) * 72 + kk * 32 + fq * 8);
        const bf16x8 pf = *(LAS bf16x8*)(PW + fr * 72 + kk * 32 + fq * 8);
#pragma unroll
        for (int n = 0; n < 8; ++n) {
            const bf16x8 sf = *(LAS bf16x8*)(lds + (n * 16 + fr) * 128 + (((kk * 4 + fq) ^ (fr & 7)) * 16));
            const bf16x8 vf = *(LAS bf16x8*)(VT + (n * 16 + fr) * 72 + kk * 32 + fq * 8);
            acc[n] = __builtin_amdgcn_mfma_f32_16x16x32_bf16(sf, qf, acc[n], 0, 0, 0);
            acc[n] = __builtin_amdgcn_mfma_f32_16x16x32_bf16(vf, pf, acc[n], 0, 0, 0);
        }
    }
    float ss = 0.f;
#pragma unroll
    for (int n = 0; n < 8; ++n) ss += (acc[n][0] * acc[n][0] + acc[n][1] * acc[n][1]) + (acc[n][2] * acc[n][2] + acc[n][3] * acc[n][3]);
    ss += __shfl_xor(ss, 16); ss += __shfl_xor(ss, 32);
    const float rinv = rsqrtf(ss * (1.0f / 128.0f) + EPS);
    const size_t row = (size_t)(row0 + wid * 16 + fr);
#pragma unroll
    for (int n = 0; n < 8; ++n) { const int dv = n * 16 + fq * 4; const f32x4 gg = *(const f32x4*)(p.gla_g + layer * 128 + dv);
        const u32x2 z = *(const u32x2*)(ZG + row * 512 + h * 128 + dv); u32x2 w;
        w.x = pk2(acc[n][0] * rinv * gg[0] * bflo(z.x), acc[n][1] * rinv * gg[1] * bfhi(z.x));
        w.y = pk2(acc[n][2] * rinv * gg[2] * bflo(z.y), acc[n][3] * rinv * gg[3] * bfhi(z.y));
        *(u32x2*)(MIX + row * 1024 + 512 + h * 128 + dv) = w; }
    __syncthreads();
}


#define XB_TMO      128
#define XB_XCNT(j)  (256  + 64 * (j))
#define XB_XSUB(j)  (1280 + 64 * (j))
#define XB_XGEN(j)  (2304 + 64 * (j))
#define XB_TOP      3328
#define XB_TOPGEN   3392
#define XCD_BAR_WORDS 3456
#define XB_SPIN_CAP (1u << 22)
__device__ __forceinline__ unsigned xb_ld(unsigned* p)              { return __hip_atomic_load(p, __ATOMIC_RELAXED, __HIP_MEMORY_SCOPE_AGENT); }
__device__ __forceinline__ unsigned xb_add(unsigned* p, unsigned v) { return __hip_atomic_fetch_add(p, v, __ATOMIC_RELAXED, __HIP_MEMORY_SCOPE_AGENT); }
__device__ __forceinline__ unsigned xb_xcc_id() { return (unsigned)__builtin_amdgcn_s_getreg((3 << 11) | 20) & 0xFu; }
#define XB_SPIN(cond, bar) do { unsigned _sp = 0; while (cond) { __builtin_amdgcn_s_sleep(1); \
    if ((++_sp & 255u) == 0u) { if (xb_ld(&(bar)[XB_TMO])) break; if (_sp > XB_SPIN_CAP) { atomicAdd(&(bar)[XB_TMO], 1u); break; } } } } while (0)
struct XcdBarrier { unsigned* bar; unsigned x; volatile LAS unsigned* st; };
__device__ __forceinline__ XcdBarrier xcd_barrier_post(unsigned* bar, volatile LAS unsigned* st) {
    XcdBarrier b; b.bar = bar; b.x = xb_xcc_id(); b.st = st;
    if (threadIdx.x == 0) (void)xb_add(&bar[XB_XCNT(b.x)], 1u);
    return b;
}
__device__ __forceinline__ void xcd_barrier_complete(unsigned* bar, unsigned x, unsigned& nloc, unsigned& nx) {
    const unsigned G = gridDim.x * gridDim.y * gridDim.z;
    unsigned sum, cnt, mine, sp = 0u;
    for (;;) {
        sum = 0u; cnt = 0u; mine = 0u;
#pragma unroll
        for (unsigned j = 0; j < 16; ++j) { const unsigned c = xb_ld(&bar[XB_XCNT(j)]); sum += c; cnt += (c > 0u) ? 1u : 0u; mine = (j == x) ? c : mine; }
        if (sum == G) break;
        __builtin_amdgcn_s_sleep(1);
        if ((++sp & 255u) == 0u) { if (xb_ld(&bar[XB_TMO])) break; if (sp > XB_SPIN_CAP) { atomicAdd(&bar[XB_TMO], 1u); break; } }
    }
    nloc = mine > 0u ? mine : 1u; nx = cnt > 0u ? cnt : 1u;
}
__device__ __forceinline__ void xcd_barrier(const XcdBarrier& b) {
    asm volatile("s_waitcnt vmcnt(0)" ::: "memory");
    __syncthreads();
    if (threadIdx.x == 0) {
        unsigned* bar = b.bar;
        __builtin_amdgcn_s_waitcnt(0);
        unsigned nloc = b.st[0], nx = b.st[1];
        if (nloc == 0u) { xcd_barrier_complete(bar, b.x, nloc, nx); b.st[0] = nloc; b.st[1] = nx; }
        const unsigned old = xb_add(&bar[XB_XSUB(b.x)], 1u);
        const unsigned gen = old / nloc;
        if (old + 1u == (gen + 1u) * nloc) {
            __builtin_amdgcn_fence(__ATOMIC_RELEASE, "agent");
            asm volatile("s_waitcnt vmcnt(0)" ::: "memory");
            const unsigned og = xb_add(&bar[XB_TOP], 1u);
            const unsigned tg = og / nx;
            if (og + 1u == (tg + 1u) * nx) xb_add(&bar[XB_TOPGEN], 1u);
            else XB_SPIN(xb_add(&bar[XB_TOPGEN], 0u) == tg, bar);
            __builtin_amdgcn_fence(__ATOMIC_ACQUIRE, "agent");
            xb_add(&bar[XB_XGEN(b.x)], 1u);
            asm volatile("s_waitcnt vmcnt(0)" ::: "memory");
        } else {
            XB_SPIN(xb_ld(&bar[XB_XGEN(b.x)]) == gen, bar);
            __builtin_amdgcn_fence(__ATOMIC_ACQUIRE, "agent");
            asm volatile("s_waitcnt vmcnt(0)" ::: "memory");
        }
    }
    __syncthreads();
}

#ifndef REP_PREP
#define REP_PREP 1
#endif
#ifndef REP_IN
#define REP_IN 1
#endif
#ifndef REP_P2
#define REP_P2 1
#endif
#ifndef REP_P3
#define REP_P3 1
#endif
#ifndef REP_P4
#define REP_P4 1
#endif
#ifndef REP_OUT
#define REP_OUT 1
#endif
#ifndef REP_SYNC
#define REP_SYNC 1
#endif
#ifndef PROBE_MASK
#define PROBE_MASK 0
#endif
#define PROBE_MULT 4
#define TSTAMP() do { if (PROBE_MASK) { if (blockIdx.x == 0 && threadIdx.x == 0) { tsl[tsi] = __builtin_amdgcn_s_memrealtime(); } ++tsi; } } while (0)
#define GSYNC() do { for (int _r = 0; _r < REP_SYNC; ++_r) xcd_barrier(xb); TSTAMP(); } while (0)
__global__ void __launch_bounds__(256, 2) hymba_mega(Params p) {
    __shared__ __attribute__((aligned(16))) unsigned char smem[66560];
    LAS unsigned char* lds = (LAS unsigned char*)smem;
    cg::grid_group grid = cg::this_grid();
    const int nb = gridDim.x, bid = blockIdx.x;
    if (p.ws == nullptr) grid.sync();
    volatile LAS unsigned* xst = (volatile LAS unsigned*)(lds + 66048);
    if (threadIdx.x == 0) { xst[0] = 0u; xst[1] = 0u; }
    __syncthreads();
    XcdBarrier xb = xcd_barrier_post((unsigned*)(p.ws + OFF_BAR), xst);
    volatile LAS unsigned long long* tsl = (volatile LAS unsigned long long*)(lds + 66064); int tsi = 0;
    TSTAMP();
    float* SSQ = (float*)(p.ws + OFF_SSQ);
    bf16_t* BUFA = (bf16_t*)(p.ws + OFF_BUFA); bf16_t* BUFB = (bf16_t*)(p.ws + OFF_BUFB);

    for (int rep = 0; rep < REP_PREP; ++rep) phase_prep(p, lds);
    grid.sync();
#pragma unroll 1
    for (int layer = 0; layer < 2; ++layer) {
        {
            EpiIn e; e.ssq = SSQ; e.U = (bf16_t*)(p.ws + OFF_U); e.ZC = (bf16_t*)(p.ws + OFF_ZC); e.Q = (bf16_t*)(p.ws + OFF_Q); e.Kb = (bf16_t*)(p.ws + OFF_K);
            e.V = (bf16_t*)(p.ws + OFF_V); e.ZG = (bf16_t*)(p.ws + OFF_ZG); e.LR = (float*)(p.ws + OFF_LR);
            const bf16_t* A = layer == 0 ? BUFA : BUFB; const bf16_t* Bt = (const bf16_t*)(p.ws + OFF_WIN) + (size_t)layer * NIN * 1024;
            int pm, pn;
            for (int rep = 0; rep < REP_IN; ++rep)
            for (int it = 0; gemm_next(it, 25, pm, pn); ++it) gemm_unit(A, 1024, Bt, 1024, 1024, pm * 128, pn * 128, lds, e, pn);
        }
        GSYNC();
        for (int rep = 0; rep < REP_P2; ++rep)
        for (int u = bid; u < 2816; u += nb) {
            if (u < 1024) gla_ds_unit(p, layer, u, lds);
            else if (u < 2048) { const int v = u - 1024; conv_unit(p, layer, false, v >> 7, (v >> 2) & 31, v & 3, lds); }
            else if (u < 2304) { const int v = u - 2048; conv_unit(p, layer, true, v >> 2, 0, v & 3, lds); }
            else gla_sample_unit(p, layer, u - 2304, lds);
        }
        if (layer == 0) { for (int u = 416 + bid; u < 1152; u += nb) prep_w_unit(p, u, lds); if (bid == nb - 1) prep_w_unit(p, 1153, lds); }
        GSYNC();
        {
            for (int rep = 0; rep < REP_P3; ++rep) {
            for (int u = bid; u < 512; u += nb) scan_unit(p, layer, u);
            EpiPw e; e.bias = p.b_pw + layer * 512; e.ZC = (const bf16_t*)(p.ws + OFF_ZC); e.MIX = BUFA;
            const bf16_t* A = (const bf16_t*)(p.ws + OFF_CVG); const bf16_t* Bt = (const bf16_t*)(p.ws + OFF_WPW) + (size_t)layer * 512 * 512;
            int pm, pn;
            for (int it = 0; gemm_next(it, 4, pm, pn); ++it) gemm_unit(A, 512, Bt, 512, 512, pm * 128, pn * 128, lds, e, pn); }
        }
        GSYNC();
        for (int rep = 0; rep < REP_P4; ++rep)
        for (int u = bid; u < 1024; u += nb) gla_out_unit(p, layer, u, lds);
        GSYNC();
        {
            EpiOut e; e.p = &p; e.layer = layer; e.XO = p.out + OUT_Y; e.XB = BUFB; e.ssq = SSQ;
            const bf16_t* Bt = (const bf16_t*)(p.ws + OFF_WOUT) + (size_t)layer * 1024 * 1024;
            int pm, pn;
            for (int rep = 0; rep < (layer == 0 ? REP_OUT : 1); ++rep)
            for (int it = 0; gemm_next(it, 8, pm, pn); ++it) gemm_unit(BUFA, 1024, Bt, 1024, 1024, pm * 128, pn * 128, lds, e, pn);
        }
        GSYNC();
    }
    {
        const int tid0 = tid_(); const int wid = tid0 >> 6, lane = tid0 & 63;
        for (int row = bid * 4 + wid; row < NTOK; row += nb * 4) {
            float s = lane < 16 ? SSQ[(size_t)row * 16 + lane] : 0.f; s = wave_sum(s);
            const float r = rsqrtf(s * (1.0f / 1024.0f) + EPS);
            float* xr = p.out + OUT_Y + (size_t)row * 1024;
#pragma unroll
            for (int i = 0; i < 4; ++i) { const int col = i * 256 + lane * 4; f32x4 a = *(const f32x4*)(xr + col); const f32x4 g = *(const f32x4*)(p.final_g + col);
                a = a * r * g; *(f32x4*)(xr + col) = a; }
        }
    }
    if (PROBE_MASK) {
        if (blockIdx.x == 0 && threadIdx.x == 0) {
            const unsigned long long tend = __builtin_amdgcn_s_memrealtime(); tsl[12] = tend;
            unsigned long long d = 0;
            for (int i = 0; i < 12; ++i) if ((PROBE_MASK >> i) & 1) d += tsl[i + 1] - tsl[i];
            while (__builtin_amdgcn_s_memrealtime() - tend < (unsigned long long)PROBE_MULT * d) __builtin_amdgcn_s_sleep(8);
        }
    }
}

extern "C" void kernel_launch(void* const* d_in, const int* in_sizes, int n_in, void* d_out, int out_size, void* d_ws, size_t ws_size, hipStream_t stream) {
    static int grid_blocks = 0;
    if (!grid_blocks) {
        int dev = 0, cus = 0, per_cu = 0;
        (void)hipGetDevice(&dev);
        (void)hipDeviceGetAttribute(&cus, hipDeviceAttributeMultiprocessorCount, dev);
        (void)hipOccupancyMaxActiveBlocksPerMultiprocessor(&per_cu, hymba_mega, 256, 0);
        if (per_cu > 2) per_cu = 2;
        if (per_cu < 1) per_cu = 1;
        grid_blocks = cus * per_cu;
    }
    if (ws_size < WS_NEED) fprintf(stderr, "workspace too small: %zu < %zu\n", ws_size, (size_t)WS_NEED);
    Params p{};
    p.x_prompt = (const float*)d_in[0]; p.x_sample = (const float*)d_in[1]; p.cache_conv = (const float*)d_in[2]; p.state_gla = (const float*)d_in[3];
    p.norm_g = (const float*)d_in[4]; p.w_in = (const float*)d_in[5]; p.w_alpha = (const float*)d_in[6]; p.b_alpha = (const float*)d_in[7];
    p.conv_w = (const float*)d_in[8]; p.conv_b = (const float*)d_in[9]; p.cn_g = (const float*)d_in[10]; p.cn_b = (const float*)d_in[11];
    p.w_pw = (const float*)d_in[12]; p.b_pw = (const float*)d_in[13]; p.gla_g = (const float*)d_in[14]; p.w_out = (const float*)d_in[15]; p.final_g = (const float*)d_in[16];
    p.out = (float*)d_out; p.ws = (unsigned char*)d_ws;
    (void)hipMemsetAsync((unsigned char*)d_ws + OFF_BAR, 0, 16384, stream);
    void* args[] = {&p};
    hipError_t e = hipLaunchCooperativeKernel((void*)hymba_mega, dim3(grid_blocks), dim3(256), args, 0, stream);
    if (e != hipSuccess) fprintf(stderr, "cooperative launch failed: %s (grid %d)\n", hipGetErrorString(e), grid_blocks);
}
```

```cpp
#include <hip/hip_runtime.h>
#include <hip/hip_cooperative_groups.h>
#include <cstdint>
#include <cstdio>
namespace cg = cooperative_groups;

#define LAS __attribute__((address_space(3)))
typedef unsigned short bf16_t;
typedef short bf16x8 __attribute__((ext_vector_type(8)));
typedef float f32x4 __attribute__((ext_vector_type(4)));
typedef unsigned u32x2 __attribute__((ext_vector_type(2)));
typedef unsigned u32x4 __attribute__((ext_vector_type(4)));

constexpr int NTOK = 17408, NPROMPT = 16384;
constexpr int SEQ = 2048, BATCH = 8, DEC_B = 128, DEC_T = 8;
constexpr int NIN = 3200;
constexpr float EPS = 1e-6f;

constexpr size_t OFF_WIN  = 0;
constexpr size_t OFF_WPW  = OFF_WIN  + (size_t)2 * NIN * 1024 * 2;
constexpr size_t OFF_WOUT = OFF_WPW  + (size_t)2 * 512 * 512 * 2;
constexpr size_t OFF_BUFA = OFF_WOUT + (size_t)2 * 1024 * 1024 * 2;
constexpr size_t OFF_BUFB = OFF_BUFA + (size_t)NTOK * 1024 * 2;
constexpr size_t OFF_U    = OFF_BUFB + (size_t)NTOK * 1024 * 2;
constexpr size_t OFF_ZC   = OFF_U    + (size_t)NTOK * 512 * 2;
constexpr size_t OFF_Q    = OFF_ZC   + (size_t)NTOK * 512 * 2;
constexpr size_t OFF_K    = OFF_Q    + (size_t)NTOK * 256 * 2;
constexpr size_t OFF_V    = OFF_K    + (size_t)NTOK * 256 * 2;
constexpr size_t OFF_ZG   = OFF_V    + (size_t)NTOK * 512 * 2;
constexpr size_t OFF_LR   = OFF_ZG   + (size_t)NTOK * 512 * 2;
constexpr size_t OFF_CVG  = OFF_LR   + (size_t)NTOK * 16 * 4;
constexpr size_t OFF_DS   = OFF_CVG  + (size_t)NTOK * 512 * 2;
constexpr size_t OFF_SB   = OFF_DS   + (size_t)1024 * 8192 * 4;
constexpr size_t OFF_DEC  = OFF_SB   + (size_t)1024 * 8192 * 2;
constexpr size_t OFF_SSQ  = OFF_DEC  + (size_t)1024 * 64 * 4;
constexpr size_t OFF_BAR  = OFF_SSQ  + (size_t)NTOK * 16 * 4;
constexpr size_t WS_NEED  = OFF_BAR  + 16384;

constexpr size_t OUT_Y    = 0;
constexpr size_t OUT_CCP  = (size_t)NTOK * 1024;
constexpr size_t OUT_SGP  = OUT_CCP + (size_t)2 * 8 * 30 * 512;
constexpr size_t OUT_CCS  = OUT_SGP + (size_t)2 * 8 * 4 * 64 * 128;
constexpr size_t OUT_SGS  = OUT_CCS + (size_t)2 * 128 * 30 * 512;

struct Params {
    const float *x_prompt, *x_sample, *cache_conv, *state_gla, *norm_g, *w_in, *w_alpha, *b_alpha, *conv_w, *conv_b,
                *cn_g, *cn_b, *w_pw, *b_pw, *gla_g, *w_out, *final_g;
    float* out;
    unsigned char* ws;
};

__device__ __forceinline__ unsigned pk2(float lo, float hi) { unsigned r; asm("v_cvt_pk_bf16_f32 %0, %1, %2" : "=v"(r) : "v"(lo), "v"(hi)); return r; }
__device__ __forceinline__ float bf2f(bf16_t h) { return __uint_as_float(((unsigned)h) << 16); }
__device__ __forceinline__ float bflo(unsigned w) { return __uint_as_float(w << 16); }
__device__ __forceinline__ float bfhi(unsigned w) { return __uint_as_float(w & 0xffff0000u); }
__device__ __forceinline__ float sigmoidf_(float x) { return __builtin_amdgcn_rcpf(1.0f + __expf(-x)); }
__device__ __forceinline__ float siluf_(float x) { return x * sigmoidf_(x); }
__device__ __forceinline__ float wave_sum(float v) {
#pragma unroll
    for (int o = 32; o >= 1; o >>= 1) v += __shfl_xor(v, o);
    return v;
}
__device__ __forceinline__ int tid_() { int t = threadIdx.x; asm volatile("" : "+v"(t)); return t; }
__device__ __forceinline__ const float* xrow_in(const Params& p, int row) {
    return row < NPROMPT ? p.x_prompt + (size_t)row * 1024 : p.x_sample + (size_t)(row - NPROMPT) * 1024;
}

template <class Epi>
__device__ __forceinline__ void gemm_unit(const bf16_t* __restrict__ A, int lda, const bf16_t* __restrict__ Bt, int ldb, int K,
                                          int row0, int brow0, LAS unsigned char* lds, const Epi& epi, int pn) {
    const int tid = tid_(), wid = tid >> 6, lane = tid & 63, wr = wid >> 1, wc = wid & 1, fr = lane & 15, fq = lane >> 4;
    f32x4 acc[4][4];
#pragma unroll
    for (int m = 0; m < 4; ++m)
#pragma unroll
        for (int n = 0; n < 4; ++n) acc[m][n] = (f32x4){0.f, 0.f, 0.f, 0.f};
    const int srow = wid * 32 + (lane >> 3), schunk = (lane & 7) ^ (lane >> 3);
    const bf16_t* ga = A + (size_t)(row0 + srow) * lda + schunk * 8;
    const bf16_t* gb = Bt + (size_t)(brow0 + srow) * ldb + schunk * 8;
    const size_t astep = (size_t)8 * lda, bstep = (size_t)8 * ldb;
    const unsigned sdst = (unsigned)(wid * 4096 + lane * 16);
    const int nt = K >> 6;
    epi.pre(row0, lds);
#define GEMM_STAGE(t, buf) do { _Pragma("unroll") for (int i = 0; i < 4; ++i) { \
        __builtin_amdgcn_global_load_lds((const unsigned*)(ga + i * astep + (t) * 64), (LAS unsigned*)(lds + (buf) * 32768 + sdst + i * 1024), 16, 0, 0); \
        __builtin_amdgcn_global_load_lds((const unsigned*)(gb + i * bstep + (t) * 64), (LAS unsigned*)(lds + (buf) * 32768 + 16384 + sdst + i * 1024), 16, 0, 0); } } while (0)
    const unsigned sw0 = (unsigned)((fq ^ (fr & 7)) * 16), sw1 = (unsigned)(((4 + fq) ^ (fr & 7)) * 16);
    const unsigned arow = (unsigned)((wr * 64 + fr) * 128), brow = (unsigned)(16384 + (wc * 64 + fr) * 128);
    GEMM_STAGE(0, 0);
#pragma unroll 2
    for (int t = 0; t < nt; ++t) {
        asm volatile("s_waitcnt vmcnt(0)" ::: "memory");
        __syncthreads();
        if (t + 1 < nt) GEMM_STAGE(t + 1, (t + 1) & 1);
        LAS unsigned char* sb = lds + (t & 1) * 32768;
#pragma unroll
        for (int kk = 0; kk < 2; ++kk) {
            const unsigned sw = kk ? sw1 : sw0;
            bf16x8 af[4], bfr[4];
#pragma unroll
            for (int m = 0; m < 4; ++m) af[m] = *(LAS bf16x8*)(sb + arow + sw + m * 2048);
#pragma unroll
            for (int n = 0; n < 4; ++n) bfr[n] = *(LAS bf16x8*)(sb + brow + sw + n * 2048);
            __builtin_amdgcn_s_setprio(1);
#pragma unroll
            for (int m = 0; m < 4; ++m)
#pragma unroll
                for (int n = 0; n < 4; ++n) acc[m][n] = __builtin_amdgcn_mfma_f32_16x16x32_bf16(bfr[n], af[m], acc[m][n], 0, 0, 0);
            __builtin_amdgcn_s_setprio(0);
        }
    }
#undef GEMM_STAGE
    epi(acc, row0, pn, wr, wc, fr, fq, lds);
    __syncthreads();
}

__device__ __forceinline__ bool gemm_next(int it, int nN, int& pm, int& pn, int first_unit_offset = 0) {
    const int nb = gridDim.x, bid = blockIdx.x;
    if ((nb & 7) == 0) {
        const int xcd = bid & 7, j = bid >> 3, nj = nb >> 3; const int u = j + it * nj;
        if (u >= 17 * nN) return false;
        pm = xcd + 8 * (u / nN); pn = u % nN; return true;
    } else {
        const int u = bid + it * nb; if (u >= 136 * nN) return false; pm = u / nN; pn = u % nN; return true;
    }
}

struct EpiIn {
    const float* ssq; bf16_t *U, *ZC, *Q, *Kb, *V, *ZG; float* LR;
    __device__ __forceinline__ void pre(int row0, LAS unsigned char* lds) const {
        LAS float* rs = (LAS float*)(lds + 65536);
        const int tid = tid_();
        if (tid < 128) { const f32x4* s = (const f32x4*)(ssq + (size_t)(row0 + tid) * 16); f32x4 a = s[0], b = s[1], c = s[2], d = s[3];
            float t = (a[0] + a[1] + a[2] + a[3]) + (b[0] + b[1] + b[2] + b[3]) + (c[0] + c[1] + c[2] + c[3]) + (d[0] + d[1] + d[2] + d[3]);
            rs[tid] = rsqrtf(t * (1.0f / 1024.0f) + EPS); }
    }
    __device__ __forceinline__ void operator()(f32x4 (&acc)[4][4], int row0, int pn, int wr, int wc, int fr, int fq, LAS unsigned char* lds) const {
        const LAS float* rs = (const LAS float*)(lds + 65536);
#pragma unroll
        for (int m = 0; m < 4; ++m) {
            const int rl = wr * 64 + m * 16 + fr; const size_t row = (size_t)(row0 + rl); const float r = rs[rl];
            if (pn < 8) {
#pragma unroll
                for (int n = 0; n < 2; ++n) { f32x4 a = acc[m][n] * r, g = acc[m][n + 2] * r; u32x2 w;
                    w.x = pk2(a[0] * sigmoidf_(g[0]), a[1] * sigmoidf_(g[1])); w.y = pk2(a[2] * sigmoidf_(g[2]), a[3] * sigmoidf_(g[3]));
                    *(u32x2*)(U + row * 512 + pn * 64 + wc * 32 + n * 16 + fq * 4) = w; }
            } else if (pn < 12) {
#pragma unroll
                for (int n = 0; n < 4; ++n) { f32x4 a = acc[m][n] * r; u32x2 w; w.x = pk2(siluf_(a[0]), siluf_(a[1])); w.y = pk2(siluf_(a[2]), siluf_(a[3]));
                    *(u32x2*)(ZC + row * 512 + (pn - 8) * 128 + wc * 64 + n * 16 + fq * 4) = w; }
            } else if (pn < 14) {
#pragma unroll
                for (int n = 0; n < 4; ++n) { f32x4 a = acc[m][n] * (r * 0.125f); u32x2 w; w.x = pk2(a[0], a[1]); w.y = pk2(a[2], a[3]);
                    *(u32x2*)(Q + row * 256 + (pn - 12) * 128 + wc * 64 + n * 16 + fq * 4) = w; }
            } else if (pn < 16) {
#pragma unroll
                for (int n = 0; n < 4; ++n) { f32x4 a = acc[m][n] * r; u32x2 w; w.x = pk2(a[0], a[1]); w.y = pk2(a[2], a[3]);
                    *(u32x2*)(Kb + row * 256 + (pn - 14) * 128 + wc * 64 + n * 16 + fq * 4) = w; }
            } else if (pn < 20) {
#pragma unroll
                for (int n = 0; n < 4; ++n) { f32x4 a = acc[m][n] * r; u32x2 w; w.x = pk2(a[0], a[1]); w.y = pk2(a[2], a[3]);
                    *(u32x2*)(V + row * 512 + (pn - 16) * 128 + wc * 64 + n * 16 + fq * 4) = w; }
            } else if (pn < 24) {
#pragma unroll
                for (int n = 0; n < 4; ++n) { f32x4 a = acc[m][n] * r; u32x2 w; w.x = pk2(siluf_(a[0]), siluf_(a[1])); w.y = pk2(siluf_(a[2]), siluf_(a[3]));
                    *(u32x2*)(ZG + row * 512 + (pn - 20) * 128 + wc * 64 + n * 16 + fq * 4) = w; }
            } else {
                if (wc == 0) { f32x4 a = acc[m][0] * r; *(f32x4*)(LR + row * 16 + fq * 4) = a; }
            }
        }
    }
};

struct EpiPw {
    const float* bias; const bf16_t* ZC; bf16_t* MIX;
    __device__ __forceinline__ void pre(int, LAS unsigned char*) const {}
    __device__ __forceinline__ void operator()(f32x4 (&acc)[4][4], int row0, int pn, int wr, int wc, int fr, int fq, LAS unsigned char*) const {
#pragma unroll
        for (int n = 0; n < 4; ++n) {
            const int col = pn * 128 + wc * 64 + n * 16 + fq * 4; const f32x4 b = *(const f32x4*)(bias + col);
#pragma unroll
            for (int m = 0; m < 4; ++m) { const size_t row = (size_t)(row0 + wr * 64 + m * 16 + fr);
                const u32x2 z = *(const u32x2*)(ZC + row * 512 + col); f32x4 a = acc[m][n] + b; u32x2 w;
                w.x = pk2(a[0] * bflo(z.x), a[1] * bfhi(z.x)); w.y = pk2(a[2] * bflo(z.y), a[3] * bfhi(z.y));
                *(u32x2*)(MIX + row * 1024 + col) = w; }
        }
    }
};

struct EpiOut {
    const Params* p; int layer; float* XO; bf16_t* XB; float* ssq;
    __device__ __forceinline__ void pre(int, LAS unsigned char*) const {}
    __device__ __forceinline__ void operator()(f32x4 (&acc)[4][4], int row0, int pn, int wr, int wc, int fr, int fq, LAS unsigned char*) const {
#pragma unroll
        for (int m = 0; m < 4; ++m) {
            const int row = row0 + wr * 64 + m * 16 + fr;
            float s = 0.f;
            if (layer == 0) {
                const float* xr = xrow_in(*p, row);
#pragma unroll
                for (int n = 0; n < 4; ++n) { const int col = pn * 128 + wc * 64 + n * 16 + fq * 4;
                    const f32x4 a = acc[m][n] + *(const f32x4*)(xr + col);
                    u32x2 w; w.x = pk2(a[0], a[1]); w.y = pk2(a[2], a[3]); *(u32x2*)(XB + (size_t)row * 1024 + col) = w;
                    const float b0 = bflo(w.x), b1 = bfhi(w.x), b2 = bflo(w.y), b3 = bfhi(w.y);
                    s += (b0 * b0 + b1 * b1) + (b2 * b2 + b3 * b3); }
            } else {
#pragma unroll
                for (int n = 0; n < 4; ++n) { const int col = pn * 128 + wc * 64 + n * 16 + fq * 4;
                    const u32x2 xr = *(const u32x2*)(XB + (size_t)row * 1024 + col);
                    f32x4 a = acc[m][n]; a[0] += bflo(xr.x); a[1] += bfhi(xr.x); a[2] += bflo(xr.y); a[3] += bfhi(xr.y);
                    *(f32x4*)(XO + (size_t)row * 1024 + col) = a;
                    s += (a[0] * a[0] + a[1] * a[1]) + (a[2] * a[2] + a[3] * a[3]); }
            }
            s += __shfl_xor(s, 16); s += __shfl_xor(s, 32);
            if (fq == 0) ssq[(size_t)row * 16 + pn * 2 + wc] = s;
        }
    }
};

__device__ __forceinline__ int inproj_dst_row(int n) {
    if (n < 1024) { const int gl = n >= 512, ch = n & 511; const int T = ch >> 6, wc = (ch >> 5) & 1, f1 = (ch >> 4) & 1, i = ch & 15;
        return T * 128 + wc * 64 + (f1 + 2 * gl) * 16 + i; }
    return n;
}
__device__ void prep_w_tile(const float* W, int ldw, int ncols, const float* g, bf16_t* Wt, int K, int k0, int n0, bool permute, LAS unsigned char* lds) {
    LAS bf16_t* tile = (LAS bf16_t*)lds;
    const int tid = tid_(), c = tid & 63, kq = tid >> 6;
    const int n = n0 + c * 4;
    f32x4 v[8];
#pragma unroll
    for (int i = 0; i < 8; ++i) v[i] = n < ncols ? *(const f32x4*)(W + (size_t)(k0 + kq + 4 * i) * ldw + n) : (f32x4){0.f, 0.f, 0.f, 0.f};
    if (g) {
#pragma unroll
        for (int i = 0; i < 8; ++i) v[i] = v[i] * g[k0 + kq + 4 * i];
    }
#pragma unroll
    for (int i = 0; i < 8; ++i) { u32x2 w; w.x = pk2(v[i][0], v[i][1]); w.y = pk2(v[i][2], v[i][3]); *(LAS u32x2*)(tile + (kq + 4 * i) * 264 + c * 4) = w; }
    __syncthreads();
#pragma unroll
    for (int j = 0; j < 4; ++j) { const int item = tid + j * 256, col = item & 255, ch = item >> 8; const int ns = n0 + col;
        if (ns < ncols) { const int r = permute ? inproj_dst_row(ns) : ns;
            unsigned short e[8];
#pragma unroll
            for (int q = 0; q < 8; ++q) e[q] = tile[(ch * 8 + q) * 264 + col];
            u32x4 w; w.x = e[0] | ((unsigned)e[1] << 16); w.y = e[2] | ((unsigned)e[3] << 16); w.z = e[4] | ((unsigned)e[5] << 16); w.w = e[6] | ((unsigned)e[7] << 16);
            *(u32x4*)(Wt + (size_t)r * K + k0 + ch * 8) = w; } }
    __syncthreads();
}
__device__ __forceinline__ void prep_w_unit(const Params& p, int u, LAS unsigned char* lds) {
    bf16_t* WIN = (bf16_t*)(p.ws + OFF_WIN); bf16_t* WPW = (bf16_t*)(p.ws + OFF_WPW); bf16_t* WOUT = (bf16_t*)(p.ws + OFF_WOUT);
    if (u < 832) { const int l = u / 416, v = u % 416, kt = v / 13, nt = v % 13;
        prep_w_tile(p.w_in + (size_t)l * 1024 * 3088, 3088, 3088, p.norm_g + l * 1024, WIN + (size_t)l * NIN * 1024, 1024, kt * 32, nt * 256, true, lds);
    } else if (u < 896) { const int w = u - 832, l = w / 32, v = w % 32, kt = v / 2, nt = v % 2;
        prep_w_tile(p.w_pw + (size_t)l * 512 * 512, 512, 512, nullptr, WPW + (size_t)l * 512 * 512, 512, kt * 32, nt * 256, false, lds);
    } else if (u < 1152) { const int w = u - 896, l = w / 128, v = w % 128, kt = v / 4, nt = v % 4;
        prep_w_tile(p.w_out + (size_t)l * 1024 * 1024, 1024, 1024, nullptr, WOUT + (size_t)l * 1024 * 1024, 1024, kt * 32, nt * 256, false, lds);
    } else { const int l = u - 1152; u32x4* z = (u32x4*)(WIN + (size_t)l * NIN * 1024 + (size_t)3088 * 1024);
        for (int i = tid_(); i < 112 * 1024 / 8; i += 256) z[i] = (u32x4){0u, 0u, 0u, 0u}; }
}
__device__ void phase_prep(const Params& p, LAS unsigned char* lds) {
    bf16_t* XB = (bf16_t*)(p.ws + OFF_BUFA); float* SSQ = (float*)(p.ws + OFF_SSQ);
    const int nb = gridDim.x, bid = blockIdx.x;
    const int tid0 = tid_(); const int wid = tid0 >> 6, lane = tid0 & 63;
    for (int row = (bid * 4 + wid) * 2; row < NTOK; row += nb * 8) {
        const float* xr0 = xrow_in(p, row); const float* xr1 = xrow_in(p, row + 1);
        f32x4 a[2][4];
#pragma unroll
        for (int i = 0; i < 4; ++i) { a[0][i] = *(const f32x4*)(xr0 + i * 256 + lane * 4); a[1][i] = *(const f32x4*)(xr1 + i * 256 + lane * 4); }
#pragma unroll
        for (int q = 0; q < 2; ++q) { float s = 0.f;
#pragma unroll
            for (int i = 0; i < 4; ++i) { const f32x4 v = a[q][i]; s += (v[0] * v[0] + v[1] * v[1]) + (v[2] * v[2] + v[3] * v[3]);
                u32x2 w; w.x = pk2(v[0], v[1]); w.y = pk2(v[2], v[3]); *(u32x2*)(XB + (size_t)(row + q) * 1024 + i * 256 + lane * 4) = w; }
            s = wave_sum(s);
            if (lane < 16) SSQ[(size_t)(row + q) * 16 + lane] = lane == 0 ? s : 0.f; }
    }
    for (int u = bid; u < 416; u += nb) prep_w_unit(p, u, lds);
    if (bid == nb - 1) prep_w_unit(p, 1152, lds);
}

template <int NT>
__device__ __forceinline__ void compute_bcum(const Params& p, int layer, int h, const float* LR, int row0, LAS float* G, LAS float* LRS) {
    const int tid = tid_(), d = tid & 63, tq = tid >> 6;
    if (tid < NT * 4) *(LAS f32x4*)(LRS + tid * 4) = *(const f32x4*)(LR + (size_t)row0 * 16 + tid * 4);
    float wa[16];
#pragma unroll
    for (int r = 0; r < 16; ++r) wa[r] = p.w_alpha[(size_t)layer * 16 * 256 + r * 256 + h * 64 + d];
    const float ba = p.b_alpha[layer * 256 + h * 64 + d];
    __syncthreads();
    constexpr int PER = NT / 4;
#pragma unroll 4
    for (int i = 0; i < PER; ++i) { const int t = tq * PER + i;
        const LAS f32x4* lp = (const LAS f32x4*)(LRS + t * 16);
        float z = ba;
#pragma unroll
        for (int r4 = 0; r4 < 4; ++r4) { const f32x4 v = lp[r4]; z += v[0] * wa[r4 * 4] + v[1] * wa[r4 * 4 + 1] + v[2] * wa[r4 * 4 + 2] + v[3] * wa[r4 * 4 + 3]; }
        const float ls = fminf(z, 0.f) - __logf(1.0f + __expf(-fabsf(z)));
        G[t * 64 + d] = ls * (1.0f / 16.0f);
    }
    __syncthreads();
    if (tid < 64) { float run = 0.f;
#pragma unroll 8
        for (int t = 0; t < NT; ++t) { run += G[t * 64 + d]; G[t * 64 + d] = run; } }
    __syncthreads();
}

__device__ void conv_unit(const Params& p, int layer, bool sample, int b_or_pair, int tile, int cs, LAS unsigned char* lds) {
    const bf16_t* U = (const bf16_t*)(p.ws + OFF_U); bf16_t* CVG = (bf16_t*)(p.ws + OFF_CVG);
    LAS bf16_t* ub = (LAS bf16_t*)lds;
    const int tid = tid_(), wid = tid >> 6, lane = tid & 63;
    const int t0 = tile * 64;
    if (!sample) {
        for (int c = tid; c < 94 * 16; c += 256) { const int i = c >> 4, cc = c & 15; const int time = t0 - 30 + i;
            u32x4 v = (u32x4){0u, 0u, 0u, 0u};
            if (time >= 0) v = *(const u32x4*)(U + (size_t)(b_or_pair * SEQ + time) * 512 + cs * 128 + cc * 8);
            *(LAS u32x4*)(ub + i * 128 + cc * 8) = v; }
    } else {
        for (int c = tid; c < 76 * 16; c += 256) { const int i = c >> 4, cc = c & 15; const int sq = i >= 38, ii = i - sq * 38; const int s = b_or_pair * 2 + sq;
            u32x4 v;
            if (ii < 30) { const float* src = p.cache_conv + (((size_t)layer * DEC_B + s) * 30 + ii) * 512 + cs * 128 + cc * 8;
                const f32x4 a = *(const f32x4*)src, bb = *(const f32x4*)(src + 4);
                v.x = pk2(a[0], a[1]); v.y = pk2(a[2], a[3]); v.z = pk2(bb[0], bb[1]); v.w = pk2(bb[2], bb[3]);
                if (ii >= 8) { float* dst = p.out + OUT_CCS + (((size_t)layer * DEC_B + s) * 30 + (ii - 8)) * 512 + cs * 128 + cc * 8;
                    *(f32x4*)dst = a; *(f32x4*)(dst + 4) = bb; }
            } else v = *(const u32x4*)(U + (size_t)(NPROMPT + s * 8 + (ii - 30)) * 512 + cs * 128 + cc * 8);
            *(LAS u32x4*)(ub + i * 128 + cc * 8) = v; }
    }
    __syncthreads();
    const int gi = wid & 1, half = wid >> 1; const int chl = gi * 64 + lane, ch = cs * 128 + chl;
    float w[31];
#pragma unroll
    for (int j = 0; j < 31; ++j) w[j] = p.conv_w[((size_t)layer * 31 + j) * 512 + ch];
    const float cb = p.conv_b[layer * 512 + ch], lg = p.cn_g[layer * 512 + ch], lb = p.cn_b[layer * 512 + ch];
    const int rb = sample ? half * 38 : half * 32;
    const int nsteps = sample ? 2 : 8;
    const size_t grow0 = sample ? (size_t)(NPROMPT + (b_or_pair * 2 + half) * 8) : (size_t)(b_or_pair * SEQ + t0 + half * 32);
    for (int st = 0; st < nsteps; ++st) {
        float vals[34];
#pragma unroll
        for (int i = 0; i < 34; ++i) vals[i] = bf2f(ub[(rb + st * 4 + i) * 128 + chl]);
#pragma unroll
        for (int q = 0; q < 4; ++q) {
            float x = cb;
#pragma unroll
            for (int j = 0; j < 31; ++j) x = fmaf(w[j], vals[q + j], x);
            const float mu = wave_sum(x) * (1.0f / 64.0f); const float dlt = x - mu;
            const float var = wave_sum(dlt * dlt) * (1.0f / 64.0f);
            const float y = dlt * rsqrtf(var + EPS) * lg + lb;
            const float sv = siluf_(y);
            CVG[(grow0 + st * 4 + q) * 512 + ch] = (bf16_t)(pk2(sv, 0.f) & 0xffffu);
        }
    }
    if (!sample) {
        if (tile == 31) { for (int c = tid; c < 30 * 128; c += 256) { const int j = c >> 7, cc = c & 127;
            p.out[OUT_CCP + (((size_t)layer * BATCH + b_or_pair) * 30 + j) * 512 + cs * 128 + cc] = bf2f(ub[(64 + j) * 128 + cc]); } }
    } else {
        for (int c = tid; c < 2 * 8 * 128; c += 256) { const int sq = c >> 10, j = (c >> 7) & 7, cc = c & 127; const int s = b_or_pair * 2 + sq;
            p.out[OUT_CCS + (((size_t)layer * DEC_B + s) * 30 + 22 + j) * 512 + cs * 128 + cc] = bf2f(ub[(sq * 38 + 30 + j) * 128 + cc]); }
    }
    __syncthreads();
}

__device__ void gla_ds_unit(const Params& p, int layer, int unit, LAS unsigned char* lds) {
    const int h = unit & 3, bc = unit >> 2; const int row0 = bc * 64;
    const bf16_t* Kb = (const bf16_t*)(p.ws + OFF_K); const bf16_t* V = (const bf16_t*)(p.ws + OFF_V); const float* LR = (const float*)(p.ws + OFF_LR);
    float* DS = (float*)(p.ws + OFF_DS) + (size_t)unit * 8192; float* DEC = (float*)(p.ws + OFF_DEC) + (size_t)unit * 64;
    LAS float* G = (LAS float*)lds;
    LAS bf16_t* KT = (LAS bf16_t*)(lds + 16384);
    LAS bf16_t* VT = (LAS bf16_t*)(lds + 16384 + 9216);
    const int tid = tid_(), t = tid >> 2, qd = tid & 3;
    const u32x4* src = (const u32x4*)(Kb + (size_t)(row0 + t) * 256 + h * 64 + qd * 16);
    const u32x4* vs = (const u32x4*)(V + (size_t)(row0 + t) * 512 + h * 128 + qd * 32);
    const u32x4 a = src[0], b = src[1]; u32x4 vreg[4];
#pragma unroll
    for (int c = 0; c < 4; ++c) vreg[c] = vs[c];
    compute_bcum<64>(p, layer, h, LR, row0, G, (LAS float*)(lds + 16384 + 9216 + 18432));
    {
        const unsigned wv[8] = {a.x, a.y, a.z, a.w, b.x, b.y, b.z, b.w};
#pragma unroll
        for (int e = 0; e < 8; ++e) { const int d0 = qd * 16 + 2 * e;
            const float f0 = bflo(wv[e]) * __expf(G[63 * 64 + d0] - G[t * 64 + d0]);
            const float f1 = bfhi(wv[e]) * __expf(G[63 * 64 + d0 + 1] - G[t * 64 + d0 + 1]);
            const unsigned pk = pk2(f0, f1);
            KT[d0 * 72 + t] = (bf16_t)(pk & 0xffffu); KT[(d0 + 1) * 72 + t] = (bf16_t)(pk >> 16); }
#pragma unroll
        for (int c = 0; c < 4; ++c) { const u32x4 a2 = vreg[c]; const unsigned w2[4] = {a2.x, a2.y, a2.z, a2.w};
#pragma unroll
            for (int e = 0; e < 4; ++e) { const int dv = qd * 32 + c * 8 + 2 * e;
                VT[dv * 72 + t] = (bf16_t)(w2[e] & 0xffffu); VT[(dv + 1) * 72 + t] = (bf16_t)(w2[e] >> 16); } }
        if (tid < 64) DEC[tid] = __expf(G[63 * 64 + tid]);
    }
    __syncthreads();
    const int wid = tid >> 6, lane = tid & 63, fr = lane & 15, fq = lane >> 4;
    f32x4 acc[2][4];
#pragma unroll
    for (int m = 0; m < 2; ++m)
#pragma unroll
        for (int n = 0; n < 4; ++n) acc[m][n] = (f32x4){0.f, 0.f, 0.f, 0.f};
#pragma unroll
    for (int kk = 0; kk < 2; ++kk) {
        bf16x8 vf[2], kf[4];
#pragma unroll
        for (int m = 0; m < 2; ++m) vf[m] = *(LAS bf16x8*)(VT + (wid * 32 + m * 16 + fr) * 72 + kk * 32 + fq * 8);
#pragma unroll
        for (int n = 0; n < 4; ++n) kf[n] = *(LAS bf16x8*)(KT + (n * 16 + fr) * 72 + kk * 32 + fq * 8);
#pragma unroll
        for (int m = 0; m < 2; ++m)
#pragma unroll
            for (int n = 0; n < 4; ++n) acc[m][n] = __builtin_amdgcn_mfma_f32_16x16x32_bf16(kf[n], vf[m], acc[m][n], 0, 0, 0);
    }
#pragma unroll
    for (int m = 0; m < 2; ++m)
#pragma unroll
        for (int n = 0; n < 4; ++n) *(f32x4*)(DS + (size_t)(wid * 32 + m * 16 + fr) * 64 + n * 16 + fq * 4) = acc[m][n];
    __syncthreads();
}

__device__ void gla_sample_unit(const Params& p, int layer, int unit, LAS unsigned char* lds) {
    const int h = unit & 3, s = unit >> 2; const int row0 = NPROMPT + s * 8;
    const bf16_t* Q = (const bf16_t*)(p.ws + OFF_Q); const bf16_t* Kb = (const bf16_t*)(p.ws + OFF_K); const bf16_t* V = (const bf16_t*)(p.ws + OFF_V);
    const bf16_t* ZG = (const bf16_t*)(p.ws + OFF_ZG); const float* LR = (const float*)(p.ws + OFF_LR); bf16_t* MIX = (bf16_t*)(p.ws + OFF_BUFA);
    const float* S0 = p.state_gla + (((size_t)layer * DEC_B + s) * 4 + h) * 8192;
    float* SN = p.out + OUT_SGS + (((size_t)layer * DEC_B + s) * 4 + h) * 8192;
    LAS float* G = (LAS float*)lds;
    LAS float* QT = G + 512;
    LAS float* KT = QT + 512;
    LAS float* KD = KT + 512;
    LAS float* DCY = KD + 512;
    LAS float* ATT = DCY + 64;
    LAS float* VV = ATT + 64;
    LAS float* OP = VV + 1024;
    LAS float* RED = OP + 2048;
    compute_bcum<8>(p, layer, h, LR, row0, G, (LAS float*)(lds + 32768));
    const int tid = tid_();
#pragma unroll
    for (int i = 0; i < 2; ++i) { const int e = tid + i * 256, t = e >> 6, d = e & 63;
        const float bc = G[t * 64 + d], bl = G[7 * 64 + d];
        const float q = bf2f(Q[(size_t)(row0 + t) * 256 + h * 64 + d]), k = bf2f(Kb[(size_t)(row0 + t) * 256 + h * 64 + d]);
        QT[e] = q * __expf(bc); KT[e] = k * __expf(-bc); KD[e] = k * __expf(bl - bc);
        if (t == 7) DCY[d] = __expf(bl); }
#pragma unroll
    for (int i = 0; i < 4; ++i) { const int e = tid + i * 256, t = e >> 7, v = e & 127; VV[e] = bf2f(V[(size_t)(row0 + t) * 512 + h * 128 + v]); }
    __syncthreads();
    if (tid < 64) { const int t = tid >> 3, s2 = tid & 7; float a = 0.f;
        if (s2 <= t) { for (int d = 0; d < 64; ++d) a += QT[t * 64 + d] * KT[s2 * 64 + d]; }
        ATT[tid] = a; }
    __syncthreads();
    const int vcol = tid & 127, dh = tid >> 7;
    float o[8], v8[8];
#pragma unroll
    for (int t = 0; t < 8; ++t) { o[t] = 0.f; v8[t] = VV[t * 128 + vcol]; }
    float s0r[32];
#pragma unroll
    for (int dd = 0; dd < 32; ++dd) s0r[dd] = S0[(dh * 32 + dd) * 128 + vcol];
#pragma unroll
    for (int dd = 0; dd < 32; ++dd) { const int d = dh * 32 + dd; const float s0 = s0r[dd];
        float sn = s0 * DCY[d];
#pragma unroll
        for (int t = 0; t < 8; ++t) { o[t] = fmaf(QT[t * 64 + d], s0, o[t]); sn = fmaf(KD[t * 64 + d], v8[t], sn); }
        SN[d * 128 + vcol] = sn; }
    if (dh == 0) {
#pragma unroll
        for (int t = 0; t < 8; ++t)
#pragma unroll
            for (int s2 = 0; s2 < 8; ++s2) o[t] = fmaf(ATT[t * 8 + s2], v8[s2], o[t]);
    }
#pragma unroll
    for (int t = 0; t < 8; ++t) OP[(dh * 8 + t) * 128 + vcol] = o[t];
    __syncthreads();
    float val[4];
#pragma unroll
    for (int i = 0; i < 4; ++i) { const int t = dh * 4 + i; val[i] = OP[t * 128 + vcol] + OP[(8 + t) * 128 + vcol];
        const float ps = wave_sum(val[i] * val[i]); if ((tid & 63) == 0) RED[t * 4 + ((tid >> 6) & 1)] = ps; }
    __syncthreads();
    const float gg = p.gla_g[layer * 128 + vcol];
#pragma unroll
    for (int i = 0; i < 4; ++i) { const int t = dh * 4 + i; const float ms = (RED[t * 4] + RED[t * 4 + 1]) * (1.0f / 128.0f);
        const float zg = bf2f(ZG[(size_t)(row0 + t) * 512 + h * 128 + vcol]);
        const float r = val[i] * rsqrtf(ms + EPS) * gg * zg;
        MIX[(size_t)(row0 + t) * 1024 + 512 + h * 128 + vcol] = (bf16_t)(pk2(r, 0.f) & 0xffffu); }
    __syncthreads();
}

__device__ void scan_unit(const Params& p, int layer, int unit) {
    typedef float f32x2 __attribute__((ext_vector_type(2)));
    const int part = unit & 15, h = (unit >> 4) & 3, b = unit >> 6;
    const float* DS = (const float*)(p.ws + OFF_DS); const float* DEC = (const float*)(p.ws + OFF_DEC); bf16_t* SB = (bf16_t*)(p.ws + OFF_SB);
    const int e = part * 512 + tid_() * 2; const int dk = e & 63, dv = e >> 6;
    f32x2 S = (f32x2){0.f, 0.f};
#pragma unroll
    for (int i0 = 0; i0 < 32; i0 += 16) {
        f32x2 cur[16], dc[16];
#pragma unroll
        for (int i = 0; i < 16; ++i) { const size_t ug = (size_t)((b * 32 + i0 + i) * 4 + h);
            cur[i] = *(const f32x2*)(DS + ug * 8192 + e); dc[i] = *(const f32x2*)(DEC + ug * 64 + dk); }
#pragma unroll
        for (int i = 0; i < 16; ++i) { const size_t ug = (size_t)((b * 32 + i0 + i) * 4 + h);
            *(unsigned*)(SB + ug * 8192 + e) = pk2(S[0], S[1]);
            S = S * dc[i] + cur[i]; }
    }
    float* o = p.out + OUT_SGP + (((size_t)layer * BATCH + b) * 4 + h) * 8192;
    o[dk * 128 + dv] = S[0]; o[(dk + 1) * 128 + dv] = S[1];
}

__device__ void gla_out_unit(const Params& p, int layer, int unit, LAS unsigned char* lds) {
    const int h = unit & 3, bc = unit >> 2; const int row0 = bc * 64;
    const bf16_t* Q = (const bf16_t*)(p.ws + OFF_Q); const bf16_t* Kb = (const bf16_t*)(p.ws + OFF_K); const bf16_t* V = (const bf16_t*)(p.ws + OFF_V);
    const bf16_t* ZG = (const bf16_t*)(p.ws + OFF_ZG); const float* LR = (const float*)(p.ws + OFF_LR); bf16_t* MIX = (bf16_t*)(p.ws + OFF_BUFA);
    const bf16_t* SB = (const bf16_t*)(p.ws + OFF_SB) + (size_t)unit * 8192;
    LAS float* G = (LAS float*)lds;
    LAS bf16_t* QT = (LAS bf16_t*)(lds + 16384);
    LAS bf16_t* KT = (LAS bf16_t*)(lds + 16384 + 9216);
    LAS bf16_t* VT = (LAS bf16_t*)(lds + 16384 + 18432);
    LAS bf16_t* PP = (LAS bf16_t*)(lds + 16384 + 18432 + 18432);
    const int tid = tid_();
    const int t = tid >> 2, qd = tid & 3;
    const u32x4* qs = (const u32x4*)(Q + (size_t)(row0 + t) * 256 + h * 64 + qd * 16);
    const u32x4* ks = (const u32x4*)(Kb + (size_t)(row0 + t) * 256 + h * 64 + qd * 16);
    const u32x4* vs = (const u32x4*)(V + (size_t)(row0 + t) * 512 + h * 128 + qd * 32);
    const u32x4 qa = qs[0], qb = qs[1], ka = ks[0], kb = ks[1]; u32x4 vreg[4], sreg[4];
#pragma unroll
    for (int c = 0; c < 4; ++c) vreg[c] = vs[c];
#pragma unroll
    for (int c = 0; c < 4; ++c) sreg[c] = *(const u32x4*)(SB + (size_t)(tid + c * 256) * 8);
    compute_bcum<64>(p, layer, h, LR, row0, G, (LAS float*)PP);
    {
        const unsigned qw[8] = {qa.x, qa.y, qa.z, qa.w, qb.x, qb.y, qb.z, qb.w}; const unsigned kw[8] = {ka.x, ka.y, ka.z, ka.w, kb.x, kb.y, kb.z, kb.w};
        unsigned qo[8], ko[8];
#pragma unroll
        for (int e = 0; e < 8; ++e) { const int d0 = qd * 16 + 2 * e; const float g0 = G[t * 64 + d0], g1 = G[t * 64 + d0 + 1];
            const float e0 = __expf(g0), e1 = __expf(g1);
            qo[e] = pk2(bflo(qw[e]) * e0, bfhi(qw[e]) * e1);
            ko[e] = pk2(bflo(kw[e]) * __builtin_amdgcn_rcpf(e0), bfhi(kw[e]) * __builtin_amdgcn_rcpf(e1)); }
        *(LAS u32x4*)(QT + t * 72 + qd * 16) = (u32x4){qo[0], qo[1], qo[2], qo[3]}; *(LAS u32x4*)(QT + t * 72 + qd * 16 + 8) = (u32x4){qo[4], qo[5], qo[6], qo[7]};
        *(LAS u32x4*)(KT + t * 72 + qd * 16) = (u32x4){ko[0], ko[1], ko[2], ko[3]}; *(LAS u32x4*)(KT + t * 72 + qd * 16 + 8) = (u32x4){ko[4], ko[5], ko[6], ko[7]};
#pragma unroll
        for (int c = 0; c < 4; ++c) { const u32x4 a2 = vreg[c]; const unsigned w2[4] = {a2.x, a2.y, a2.z, a2.w};
#pragma unroll
            for (int e = 0; e < 4; ++e) { const int dv = qd * 32 + c * 8 + 2 * e;
                VT[dv * 72 + t] = (bf16_t)(w2[e] & 0xffffu); VT[(dv + 1) * 72 + t] = (bf16_t)(w2[e] >> 16); } }
    }
    __syncthreads();
    {
#pragma unroll
        for (int c = 0; c < 4; ++c) { const int ci = tid + c * 256, r = ci >> 3, ch = ci & 7;
            *(LAS u32x4*)(lds + r * 128 + ((ch ^ (r & 7)) * 16)) = sreg[c]; }
    }
    __syncthreads();
    const int wid = tid >> 6, lane = tid & 63, fr = lane & 15, fq = lane >> 4;
    LAS bf16_t* PW = PP + wid * 16 * 72;
    {
        bf16x8 qf[2];
#pragma unroll
        for (int kk = 0; kk < 2; ++kk) qf[kk] = *(LAS bf16x8*)(QT + (wid * 16 + fr) * 72 + kk * 32 + fq * 8);
#pragma unroll
        for (int n = 0; n < 4; ++n) {
            f32x4 a = (f32x4){0.f, 0.f, 0.f, 0.f};
#pragma unroll
            for (int kk = 0; kk < 2; ++kk) { const bf16x8 kf = *(LAS bf16x8*)(KT + (n * 16 + fr) * 72 + kk * 32 + fq * 8);
                a = __builtin_amdgcn_mfma_f32_16x16x32_bf16(kf, qf[kk], a, 0, 0, 0); }
            const int tg = wid * 16 + fr, sg = n * 16 + fq * 4;
            u32x2 w; w.x = pk2(sg <= tg ? a[0] : 0.f, sg + 1 <= tg ? a[1] : 0.f); w.y = pk2(sg + 2 <= tg ? a[2] : 0.f, sg + 3 <= tg ? a[3] : 0.f);
            *(LAS u32x2*)(PW + fr * 72 + n * 16 + fq * 4) = w;
        }
    }
    __builtin_amdgcn_s_waitcnt(0xc07f);
    __builtin_amdgcn_wave_barrier();
    f32x4 acc[8];
#pragma unroll
    for (int n = 0; n < 8; ++n) acc[n] = (f32x4){0.f, 0.f, 0.f, 0.f};
#pragma unroll
    for (int kk = 0; kk < 2; ++kk) {
        const bf16x8 qf = *(LAS bf16x8*)(QT + (wid * 16 + fr) * 72 + kk * 32 + fq * 8);
        const bf16x8 pf = *(LAS bf16x8*)(PW + fr * 72 + kk * 32 + fq * 8);
#pragma unroll
        for (int n = 0; n < 8; ++n) {
            const bf16x8 sf = *(LAS bf16x8*)(lds + (n * 16 + fr) * 128 + (((kk * 4 + fq) ^ (fr & 7)) * 16));
            const bf16x8 vf = *(LAS bf16x8*)(VT + (n * 16 + fr) * 72 + kk * 32 + fq * 8);
            acc[n] = __builtin_amdgcn_mfma_f32_16x16x32_bf16(sf, qf, acc[n], 0, 0, 0);
            acc[n] = __builtin_amdgcn_mfma_f32_16x16x32_bf16(vf, pf, acc[n], 0, 0, 0);
        }
    }
    float ss = 0.f;
#pragma unroll
    for (int n = 0; n < 8; ++n) ss += (acc[n][0] * acc[n][0] + acc[n][1] * acc[n][1]) + (acc[n][2] * acc[n][2] + acc[n][3] * acc[n][3]);
    ss += __shfl_xor(ss, 16); ss += __shfl_xor(ss, 32);
    const float rinv = rsqrtf(ss * (1.0f / 128.0f) + EPS);
    const size_t row = (size_t)(row0 + wid * 16 + fr);
#pragma unroll
    for (int n = 0; n < 8; ++n) { const int dv = n * 16 + fq * 4; const f32x4 gg = *(const f32x4*)(p.gla_g + layer * 128 + dv);
        const u32x2 z = *(const u32x2*)(ZG + row * 512 + h * 128 + dv); u32x2 w;
        w.x = pk2(acc[n][0] * rinv * gg[0] * bflo(z.x), acc[n][1] * rinv * gg[1] * bfhi(z.x));
        w.y = pk2(acc[n][2] * rinv * gg[2] * bflo(z.y), acc[n][3] * rinv * gg[3] * bfhi(z.y));
        *(u32x2*)(MIX + row * 1024 + 512 + h * 128 + dv) = w; }
    __syncthreads();
}


#define XB_TMO      128
#define XB_XCNT(j)  (256  + 64 * (j))
#define XB_XSUB(j)  (1280 + 64 * (j))
#define XB_XGEN(j)  (2304 + 64 * (j))
#define XB_TOP      3328
#define XB_TOPGEN   3392
#define XCD_BAR_WORDS 3456
#define XB_SPIN_CAP (1u << 22)
__device__ __forceinline__ unsigned xb_ld(unsigned* p)              { return __hip_atomic_load(p, __ATOMIC_RELAXED, __HIP_MEMORY_SCOPE_AGENT); }
__device__ __forceinline__ unsigned xb_add(unsigned* p, unsigned v) { return __hip_atomic_fetch_add(p, v, __ATOMIC_RELAXED, __HIP_MEMORY_SCOPE_AGENT); }
__device__ __forceinline__ unsigned xb_xcc_id() { return (unsigned)__builtin_amdgcn_s_getreg((3 << 11) | 20) & 0xFu; }
#define XB_SPIN(cond, bar) do { unsigned _sp = 0; while (cond) { __builtin_amdgcn_s_sleep(1); \
    if ((++_sp & 255u) == 0u) { if (xb_ld(&(bar)[XB_TMO])) break; if (_sp > XB_SPIN_CAP) { atomicAdd(&(bar)[XB_TMO], 1u); break; } } } } while (0)
struct XcdBarrier { unsigned* bar; unsigned x; volatile LAS unsigned* st; };
__device__ __forceinline__ XcdBarrier xcd_barrier_post(unsigned* bar, volatile LAS unsigned* st) {
    XcdBarrier b; b.bar = bar; b.x = xb_xcc_id(); b.st = st;
    if (threadIdx.x == 0) (void)xb_add(&bar[XB_XCNT(b.x)], 1u);
    return b;
}
__device__ __forceinline__ void xcd_barrier_complete(unsigned* bar, unsigned x, unsigned& nloc, unsigned& nx) {
    const unsigned G = gridDim.x * gridDim.y * gridDim.z;
    unsigned sum, cnt, mine, sp = 0u;
    for (;;) {
        sum = 0u; cnt = 0u; mine = 0u;
#pragma unroll
        for (unsigned j = 0; j < 16; ++j) { const unsigned c = xb_ld(&bar[XB_XCNT(j)]); sum += c; cnt += (c > 0u) ? 1u : 0u; mine = (j == x) ? c : mine; }
        if (sum == G) break;
        __builtin_amdgcn_s_sleep(1);
        if ((++sp & 255u) == 0u) { if (xb_ld(&bar[XB_TMO])) break; if (sp > XB_SPIN_CAP) { atomicAdd(&bar[XB_TMO], 1u); break; } }
    }
    nloc = mine > 0u ? mine : 1u; nx = cnt > 0u ? cnt : 1u;
}
__device__ __forceinline__ void xcd_barrier(const XcdBarrier& b) {
    asm volatile("s_waitcnt vmcnt(0)" ::: "memory");
    __syncthreads();
    if (threadIdx.x == 0) {
        unsigned* bar = b.bar;
        __builtin_amdgcn_s_waitcnt(0);
        unsigned nloc = b.st[0], nx = b.st[1];
        if (nloc == 0u) { xcd_barrier_complete(bar, b.x, nloc, nx); b.st[0] = nloc; b.st[1] = nx; }
        const unsigned old = xb_add(&bar[XB_XSUB(b.x)], 1u);
        const unsigned gen = old / nloc;
        if (old + 1u == (gen + 1u) * nloc) {
            __builtin_amdgcn_fence(__ATOMIC_RELEASE, "agent");
            asm volatile("s_waitcnt vmcnt(0)" ::: "memory");
            const unsigned og = xb_add(&bar[XB_TOP], 1u);
            const unsigned tg = og / nx;
            if (og + 1u == (tg + 1u) * nx) xb_add(&bar[XB_TOPGEN], 1u);
            else XB_SPIN(xb_add(&bar[XB_TOPGEN], 0u) == tg, bar);
            __builtin_amdgcn_fence(__ATOMIC_ACQUIRE, "agent");
            xb_add(&bar[XB_XGEN(b.x)], 1u);
            asm volatile("s_waitcnt vmcnt(0)" ::: "memory");
        } else {
            XB_SPIN(xb_ld(&bar[XB_XGEN(b.x)]) == gen, bar);
            __builtin_amdgcn_fence(__ATOMIC_ACQUIRE, "agent");
            asm volatile("s_waitcnt vmcnt(0)" ::: "memory");
        }
    }
    __syncthreads();
}

#ifndef REP_PREP
#define REP_PREP 1
#endif
#ifndef REP_IN
#define REP_IN 1
#endif
#ifndef REP_P2
#define REP_P2 1
#endif
#ifndef REP_P3
#define REP_P3 1
#endif
#ifndef REP_P4
#define REP_P4 1
#endif
#ifndef REP_OUT
#define REP_OUT 1
#endif
#ifndef REP_SYNC
#define REP_SYNC 1
#endif
#ifndef PROBE_MASK
#define PROBE_MASK 0
#endif
#define PROBE_MULT 4
#define TSTAMP() do { if (PROBE_MASK) { if (blockIdx.x == 0 && threadIdx.x == 0) { tsl[tsi] = __builtin_amdgcn_s_memrealtime(); } ++tsi; } } while (0)
#define GSYNC() do { for (int _r = 0; _r < REP_SYNC; ++_r) xcd_barrier(xb); TSTAMP(); } while (0)
__global__ void __launch_bounds__(256, 2) hymba_mega(Params p) {
    __shared__ __attribute__((aligned(16))) unsigned char smem[66560];
    LAS unsigned char* lds = (LAS unsigned char*)smem;
    cg::grid_group grid = cg::this_grid();
    const int nb = gridDim.x, bid = blockIdx.x;
    if (p.ws == nullptr) grid.sync();
    volatile LAS unsigned* xst = (volatile LAS unsigned*)(lds + 66048);
    if (threadIdx.x == 0) { xst[0] = 0u; xst[1] = 0u; }
    __syncthreads();
    XcdBarrier xb = xcd_barrier_post((unsigned*)(p.ws + OFF_BAR), xst);
    volatile LAS unsigned long long* tsl = (volatile LAS unsigned long long*)(lds + 66064); int tsi = 0;
    TSTAMP();
    float* SSQ = (float*)(p.ws + OFF_SSQ);
    bf16_t* BUFA = (bf16_t*)(p.ws + OFF_BUFA); bf16_t* BUFB = (bf16_t*)(p.ws + OFF_BUFB);

    for (int rep = 0; rep < REP_PREP; ++rep) phase_prep(p, lds);
    GSYNC();
#pragma unroll 1
    for (int layer = 0; layer < 2; ++layer) {
        {
            EpiIn e; e.ssq = SSQ; e.U = (bf16_t*)(p.ws + OFF_U); e.ZC = (bf16_t*)(p.ws + OFF_ZC); e.Q = (bf16_t*)(p.ws + OFF_Q); e.Kb = (bf16_t*)(p.ws + OFF_K);
            e.V = (bf16_t*)(p.ws + OFF_V); e.ZG = (bf16_t*)(p.ws + OFF_ZG); e.LR = (float*)(p.ws + OFF_LR);
            const bf16_t* A = layer == 0 ? BUFA : BUFB; const bf16_t* Bt = (const bf16_t*)(p.ws + OFF_WIN) + (size_t)layer * NIN * 1024;
            int pm, pn;
            for (int rep = 0; rep < REP_IN; ++rep)
            for (int it = 0; gemm_next(it, 25, pm, pn); ++it) gemm_unit(A, 1024, Bt, 1024, 1024, pm * 128, pn * 128, lds, e, pn);
        }
        GSYNC();
        for (int rep = 0; rep < REP_P2; ++rep)
        for (int u = bid; u < 2816; u += nb) {
            if (u < 1024) gla_ds_unit(p, layer, u, lds);
            else if (u < 2048) { const int v = u - 1024; conv_unit(p, layer, false, v >> 7, (v >> 2) & 31, v & 3, lds); }
            else if (u < 2304) { const int v = u - 2048; conv_unit(p, layer, true, v >> 2, 0, v & 3, lds); }
            else gla_sample_unit(p, layer, u - 2304, lds);
        }
        if (layer == 0) { for (int u = 416 + bid; u < 1152; u += nb) prep_w_unit(p, u, lds); if (bid == nb - 1) prep_w_unit(p, 1153, lds); }
        GSYNC();
        {
            for (int rep = 0; rep < REP_P3; ++rep) {
            for (int u = bid; u < 512; u += nb) scan_unit(p, layer, u);
            EpiPw e; e.bias = p.b_pw + layer * 512; e.ZC = (const bf16_t*)(p.ws + OFF_ZC); e.MIX = BUFA;
            const bf16_t* A = (const bf16_t*)(p.ws + OFF_CVG); const bf16_t* Bt = (const bf16_t*)(p.ws + OFF_WPW) + (size_t)layer * 512 * 512;
            int pm, pn;
            for (int it = 0; gemm_next(it, 4, pm, pn); ++it) gemm_unit(A, 512, Bt, 512, 512, pm * 128, pn * 128, lds, e, pn); }
        }
        GSYNC();
        for (int rep = 0; rep < REP_P4; ++rep)
        for (int u = bid; u < 1024; u += nb) gla_out_unit(p, layer, u, lds);
        GSYNC();
        {
            EpiOut e; e.p = &p; e.layer = layer; e.XO = p.out + OUT_Y; e.XB = BUFB; e.ssq = SSQ;
            const bf16_t* Bt = (const bf16_t*)(p.ws + OFF_WOUT) + (size_t)layer * 1024 * 1024;
            int pm, pn;
            for (int rep = 0; rep < (layer == 0 ? REP_OUT : 1); ++rep)
            for (int it = 0; gemm_next(it, 8, pm, pn); ++it) gemm_unit(BUFA, 1024, Bt, 1024, 1024, pm * 128, pn * 128, lds, e, pn);
        }
        GSYNC();
    }
    {
        const int tid0 = tid_(); const int wid = tid0 >> 6, lane = tid0 & 63;
        for (int row = bid * 4 + wid; row < NTOK; row += nb * 4) {
            float s = lane < 16 ? SSQ[(size_t)row * 16 + lane] : 0.f; s = wave_sum(s);
            const float r = rsqrtf(s * (1.0f / 1024.0f) + EPS);
            float* xr = p.out + OUT_Y + (size_t)row * 1024;
#pragma unroll
            for (int i = 0; i < 4; ++i) { const int col = i * 256 + lane * 4; f32x4 a = *(const f32x4*)(xr + col); const f32x4 g = *(const f32x4*)(p.final_g + col);
                a = a * r * g; *(f32x4*)(xr + col) = a; }
        }
    }
    if (PROBE_MASK) {
        if (blockIdx.x == 0 && threadIdx.x == 0) {
            const unsigned long long tend = __builtin_amdgcn_s_memrealtime(); tsl[12] = tend;
            unsigned long long d = 0;
            for (int i = 0; i < 12; ++i) if ((PROBE_MASK >> i) & 1) d += tsl[i + 1] - tsl[i];
            while (__builtin_amdgcn_s_memrealtime() - tend < (unsigned long long)PROBE_MULT * d) __builtin_amdgcn_s_sleep(8);
        }
    }
}

extern "C" void kernel_launch(void* const* d_in, const int* in_sizes, int n_in, void* d_out, int out_size, void* d_ws, size_t ws_size, hipStream_t stream) {
    static int grid_blocks = 0;
    if (!grid_blocks) {
        int dev = 0, cus = 0, per_cu = 0;
        (void)hipGetDevice(&dev);
        (void)hipDeviceGetAttribute(&cus, hipDeviceAttributeMultiprocessorCount, dev);
        (void)hipOccupancyMaxActiveBlocksPerMultiprocessor(&per_cu, hymba_mega, 256, 0);
        if (per_cu > 2) per_cu = 2;
        if (per_cu < 1) per_cu = 1;
        grid_blocks = cus * per_cu;
    }
    if (ws_size < WS_NEED) fprintf(stderr, "workspace too small: %zu < %zu\n", ws_size, (size_t)WS_NEED);
    Params p{};
    p.x_prompt = (const float*)d_in[0]; p.x_sample = (const float*)d_in[1]; p.cache_conv = (const float*)d_in[2]; p.state_gla = (const float*)d_in[3];
    p.norm_g = (const float*)d_in[4]; p.w_in = (const float*)d_in[5]; p.w_alpha = (const float*)d_in[6]; p.b_alpha = (const float*)d_in[7];
    p.conv_w = (const float*)d_in[8]; p.conv_b = (const float*)d_in[9]; p.cn_g = (const float*)d_in[10]; p.cn_b = (const float*)d_in[11];
    p.w_pw = (const float*)d_in[12]; p.b_pw = (const float*)d_in[13]; p.gla_g = (const float*)d_in[14]; p.w_out = (const float*)d_in[15]; p.final_g = (const float*)d_in[16];
    p.out = (float*)d_out; p.ws = (unsigned char*)d_ws;
    (void)hipMemsetAsync((unsigned char*)d_ws + OFF_BAR, 0, 16384, stream);
    void* args[] = {&p};
    hipError_t e = hipLaunchCooperativeKernel((void*)hymba_mega, dim3(grid_blocks), dim3(256), args, 0, stream);
    if (e != hipSuccess) fprintf(stderr, "cooperative launch failed: %s (grid %d)\n", hipGetErrorString(e), grid_blocks);
}
```

```cpp
#include <hip/hip_runtime.h>
#include <hip/hip_cooperative_groups.h>
#include <cstdint>
#include <cstdio>
namespace cg = cooperative_groups;

#define LAS __attribute__((address_space(3)))
typedef unsigned short bf16_t;
typedef short bf16x8 __attribute__((ext_vector_type(8)));
typedef float f32x4 __attribute__((ext_vector_type(4)));
typedef unsigned u32x2 __attribute__((ext_vector_type(2)));
typedef unsigned u32x4 __attribute__((ext_vector_type(4)));

constexpr int NTOK = 17408, NPROMPT = 16384;
constexpr int SEQ = 2048, BATCH = 8, DEC_B = 128, DEC_T = 8;
constexpr int NIN = 3200;
constexpr float EPS = 1e-6f;

constexpr size_t OFF_WIN  = 0;
constexpr size_t OFF_WPW  = OFF_WIN  + (size_t)2 * NIN * 1024 * 2;
constexpr size_t OFF_WOUT = OFF_WPW  + (size_t)2 * 512 * 512 * 2;
constexpr size_t OFF_BUFA = OFF_WOUT + (size_t)2 * 1024 * 1024 * 2;
constexpr size_t OFF_BUFB = OFF_BUFA + (size_t)NTOK * 1024 * 2;
constexpr size_t OFF_U    = OFF_BUFB + (size_t)NTOK * 1024 * 2;
constexpr size_t OFF_ZC   = OFF_U    + (size_t)NTOK * 512 * 2;
constexpr size_t OFF_Q    = OFF_ZC   + (size_t)NTOK * 512 * 2;
constexpr size_t OFF_K    = OFF_Q    + (size_t)NTOK * 256 * 2;
constexpr size_t OFF_V    = OFF_K    + (size_t)NTOK * 256 * 2;
constexpr size_t OFF_ZG   = OFF_V    + (size_t)NTOK * 512 * 2;
constexpr size_t OFF_LR   = OFF_ZG   + (size_t)NTOK * 512 * 2;
constexpr size_t OFF_CVG  = OFF_LR   + (size_t)NTOK * 16 * 4;
constexpr size_t OFF_DS   = OFF_CVG  + (size_t)NTOK * 512 * 2;
constexpr size_t OFF_SB   = OFF_DS   + (size_t)1024 * 8192 * 4;
constexpr size_t OFF_DEC  = OFF_SB   + (size_t)1024 * 8192 * 2;
constexpr size_t OFF_SSQ  = OFF_DEC  + (size_t)1024 * 64 * 4;
constexpr size_t OFF_BAR  = OFF_SSQ  + (size_t)NTOK * 16 * 4;
constexpr size_t WS_NEED  = OFF_BAR  + 16384;

constexpr size_t OUT_Y    = 0;
constexpr size_t OUT_CCP  = (size_t)NTOK * 1024;
constexpr size_t OUT_SGP  = OUT_CCP + (size_t)2 * 8 * 30 * 512;
constexpr size_t OUT_CCS  = OUT_SGP + (size_t)2 * 8 * 4 * 64 * 128;
constexpr size_t OUT_SGS  = OUT_CCS + (size_t)2 * 128 * 30 * 512;

struct Params {
    const float *x_prompt, *x_sample, *cache_conv, *state_gla, *norm_g, *w_in, *w_alpha, *b_alpha, *conv_w, *conv_b,
                *cn_g, *cn_b, *w_pw, *b_pw, *gla_g, *w_out, *final_g;
    float* out;
    unsigned char* ws;
};

__device__ __forceinline__ unsigned pk2(float lo, float hi) { unsigned r; asm("v_cvt_pk_bf16_f32 %0, %1, %2" : "=v"(r) : "v"(lo), "v"(hi)); return r; }
__device__ __forceinline__ float bf2f(bf16_t h) { return __uint_as_float(((unsigned)h) << 16); }
__device__ __forceinline__ float bflo(unsigned w) { return __uint_as_float(w << 16); }
__device__ __forceinline__ float bfhi(unsigned w) { return __uint_as_float(w & 0xffff0000u); }
__device__ __forceinline__ float sigmoidf_(float x) { return __builtin_amdgcn_rcpf(1.0f + __expf(-x)); }
__device__ __forceinline__ float siluf_(float x) { return x * sigmoidf_(x); }
__device__ __forceinline__ float wave_sum(float v) {
#pragma unroll
    for (int o = 32; o >= 1; o >>= 1) v += __shfl_xor(v, o);
    return v;
}
__device__ __forceinline__ int tid_() { int t = threadIdx.x; asm volatile("" : "+v"(t)); return t; }
__device__ __forceinline__ const float* xrow_in(const Params& p, int row) {
    return row < NPROMPT ? p.x_prompt + (size_t)row * 1024 : p.x_sample + (size_t)(row - NPROMPT) * 1024;
}

template <class Epi>
__device__ __forceinline__ void gemm_unit(const bf16_t* __restrict__ A, int lda, const bf16_t* __restrict__ Bt, int ldb, int K,
                                          int row0, int brow0, LAS unsigned char* lds, const Epi& epi, int pn) {
    const int tid = tid_(), wid = tid >> 6, lane = tid & 63, wr = wid >> 1, wc = wid & 1, fr = lane & 15, fq = lane >> 4;
    f32x4 acc[4][4];
#pragma unroll
    for (int m = 0; m < 4; ++m)
#pragma unroll
        for (int n = 0; n < 4; ++n) acc[m][n] = (f32x4){0.f, 0.f, 0.f, 0.f};
    const int srow = wid * 32 + (lane >> 3), schunk = (lane & 7) ^ (lane >> 3);
    const bf16_t* ga = A + (size_t)(row0 + srow) * lda + schunk * 8;
    const bf16_t* gb = Bt + (size_t)(brow0 + srow) * ldb + schunk * 8;
    const size_t astep = (size_t)8 * lda, bstep = (size_t)8 * ldb;
    const unsigned sdst = (unsigned)(wid * 4096 + lane * 16);
    const int nt = K >> 6;
    epi.pre(row0, lds);
#define GEMM_STAGE(t, buf) do { _Pragma("unroll") for (int i = 0; i < 4; ++i) { \
        __builtin_amdgcn_global_load_lds((const unsigned*)(ga + i * astep + (t) * 64), (LAS unsigned*)(lds + (buf) * 32768 + sdst + i * 1024), 16, 0, 0); \
        __builtin_amdgcn_global_load_lds((const unsigned*)(gb + i * bstep + (t) * 64), (LAS unsigned*)(lds + (buf) * 32768 + 16384 + sdst + i * 1024), 16, 0, 0); } } while (0)
    const unsigned sw0 = (unsigned)((fq ^ (fr & 7)) * 16), sw1 = (unsigned)(((4 + fq) ^ (fr & 7)) * 16);
    const unsigned arow = (unsigned)((wr * 64 + fr) * 128), brow = (unsigned)(16384 + (wc * 64 + fr) * 128);
    GEMM_STAGE(0, 0);
#pragma unroll 2
    for (int t = 0; t < nt; ++t) {
        asm volatile("s_waitcnt vmcnt(0)" ::: "memory");
        __syncthreads();
        if (t + 1 < nt) GEMM_STAGE(t + 1, (t + 1) & 1);
        LAS unsigned char* sb = lds + (t & 1) * 32768;
#pragma unroll
        for (int kk = 0; kk < 2; ++kk) {
            const unsigned sw = kk ? sw1 : sw0;
            bf16x8 af[4], bfr[4];
#pragma unroll
            for (int m = 0; m < 4; ++m) af[m] = *(LAS bf16x8*)(sb + arow + sw + m * 2048);
#pragma unroll
            for (int n = 0; n < 4; ++n) bfr[n] = *(LAS bf16x8*)(sb + brow + sw + n * 2048);
            __builtin_amdgcn_s_setprio(1);
#pragma unroll
            for (int m = 0; m < 4; ++m)
#pragma unroll
                for (int n = 0; n < 4; ++n) acc[m][n] = __builtin_amdgcn_mfma_f32_16x16x32_bf16(bfr[n], af[m], acc[m][n], 0, 0, 0);
            __builtin_amdgcn_s_setprio(0);
        }
    }
#undef GEMM_STAGE
    epi(acc, row0, pn, wr, wc, fr, fq, lds);
    __syncthreads();
}

__device__ __forceinline__ bool gemm_next(int it, int nN, int& pm, int& pn, int first_unit_offset = 0) {
    const int nb = gridDim.x, bid = blockIdx.x;
    if ((nb & 7) == 0) {
        const int xcd = bid & 7, j = bid >> 3, nj = nb >> 3; const int u = j + it * nj;
        if (u >= 17 * nN) return false;
        pm = xcd + 8 * (u / nN); pn = u % nN; return true;
    } else {
        const int u = bid + it * nb; if (u >= 136 * nN) return false; pm = u / nN; pn = u % nN; return true;
    }
}

struct EpiIn {
    const float* ssq; bf16_t *U, *ZC, *Q, *Kb, *V, *ZG; float* LR;
    __device__ __forceinline__ void pre(int row0, LAS unsigned char* lds) const {
        LAS float* rs = (LAS float*)(lds + 65536);
        const int tid = tid_();
        if (tid < 128) { const f32x4* s = (const f32x4*)(ssq + (size_t)(row0 + tid) * 16); f32x4 a = s[0], b = s[1], c = s[2], d = s[3];
            float t = (a[0] + a[1] + a[2] + a[3]) + (b[0] + b[1] + b[2] + b[3]) + (c[0] + c[1] + c[2] + c[3]) + (d[0] + d[1] + d[2] + d[3]);
            rs[tid] = rsqrtf(t * (1.0f / 1024.0f) + EPS); }
    }
    __device__ __forceinline__ void operator()(f32x4 (&acc)[4][4], int row0, int pn, int wr, int wc, int fr, int fq, LAS unsigned char* lds) const {
        const LAS float* rs = (const LAS float*)(lds + 65536);
#pragma unroll
        for (int m = 0; m < 4; ++m) {
            const int rl = wr * 64 + m * 16 + fr; const size_t row = (size_t)(row0 + rl); const float r = rs[rl];
            if (pn < 8) {
#pragma unroll
                for (int n = 0; n < 2; ++n) { f32x4 a = acc[m][n] * r, g = acc[m][n + 2] * r; u32x2 w;
                    w.x = pk2(a[0] * sigmoidf_(g[0]), a[1] * sigmoidf_(g[1])); w.y = pk2(a[2] * sigmoidf_(g[2]), a[3] * sigmoidf_(g[3]));
                    *(u32x2*)(U + row * 512 + pn * 64 + wc * 32 + n * 16 + fq * 4) = w; }
            } else if (pn < 12) {
#pragma unroll
                for (int n = 0; n < 4; ++n) { f32x4 a = acc[m][n] * r; u32x2 w; w.x = pk2(siluf_(a[0]), siluf_(a[1])); w.y = pk2(siluf_(a[2]), siluf_(a[3]));
                    *(u32x2*)(ZC + row * 512 + (pn - 8) * 128 + wc * 64 + n * 16 + fq * 4) = w; }
            } else if (pn < 14) {
#pragma unroll
                for (int n = 0; n < 4; ++n) { f32x4 a = acc[m][n] * (r * 0.125f); u32x2 w; w.x = pk2(a[0], a[1]); w.y = pk2(a[2], a[3]);
                    *(u32x2*)(Q + row * 256 + (pn - 12) * 128 + wc * 64 + n * 16 + fq * 4) = w; }
            } else if (pn < 16) {
#pragma unroll
                for (int n = 0; n < 4; ++n) { f32x4 a = acc[m][n] * r; u32x2 w; w.x = pk2(a[0], a[1]); w.y = pk2(a[2], a[3]);
                    *(u32x2*)(Kb + row * 256 + (pn - 14) * 128 + wc * 64 + n * 16 + fq * 4) = w; }
            } else if (pn < 20) {
#pragma unroll
                for (int n = 0; n < 4; ++n) { f32x4 a = acc[m][n] * r; u32x2 w; w.x = pk2(a[0], a[1]); w.y = pk2(a[2], a[3]);
                    *(u32x2*)(V + row * 512 + (pn - 16) * 128 + wc * 64 + n * 16 + fq * 4) = w; }
            } else if (pn < 24) {
#pragma unroll
                for (int n = 0; n < 4; ++n) { f32x4 a = acc[m][n] * r; u32x2 w; w.x = pk2(siluf_(a[0]), siluf_(a[1])); w.y = pk2(siluf_(a[2]), siluf_(a[3]));
                    *(u32x2*)(ZG + row * 512 + (pn - 20) * 128 + wc * 64 + n * 16 + fq * 4) = w; }
            } else {
                if (wc == 0) { f32x4 a = acc[m][0] * r; *(f32x4*)(LR + row * 16 + fq * 4) = a; }
            }
        }
    }
};

struct EpiPw {
    const float* bias; const bf16_t* ZC; bf16_t* MIX;
    __device__ __forceinline__ void pre(int, LAS unsigned char*) const {}
    __device__ __forceinline__ void operator()(f32x4 (&acc)[4][4], int row0, int pn, int wr, int wc, int fr, int fq, LAS unsigned char*) const {
#pragma unroll
        for (int n = 0; n < 4; ++n) {
            const int col = pn * 128 + wc * 64 + n * 16 + fq * 4; const f32x4 b = *(const f32x4*)(bias + col);
#pragma unroll
            for (int m = 0; m < 4; ++m) { const size_t row = (size_t)(row0 + wr * 64 + m * 16 + fr);
                const u32x2 z = *(const u32x2*)(ZC + row * 512 + col); f32x4 a = acc[m][n] + b; u32x2 w;
                w.x = pk2(a[0] * bflo(z.x), a[1] * bfhi(z.x)); w.y = pk2(a[2] * bflo(z.y), a[3] * bfhi(z.y));
                *(u32x2*)(MIX + row * 1024 + col) = w; }
        }
    }
};

struct EpiOut {
    const Params* p; int layer; float* XO; bf16_t* XB; float* ssq;
    __device__ __forceinline__ void pre(int, LAS unsigned char*) const {}
    __device__ __forceinline__ void operator()(f32x4 (&acc)[4][4], int row0, int pn, int wr, int wc, int fr, int fq, LAS unsigned char*) const {
#pragma unroll
        for (int m = 0; m < 4; ++m) {
            const int row = row0 + wr * 64 + m * 16 + fr;
            float s = 0.f;
            if (layer == 0) {
                const float* xr = xrow_in(*p, row);
#pragma unroll
                for (int n = 0; n < 4; ++n) { const int col = pn * 128 + wc * 64 + n * 16 + fq * 4;
                    const f32x4 a = acc[m][n] + *(const f32x4*)(xr + col);
                    u32x2 w; w.x = pk2(a[0], a[1]); w.y = pk2(a[2], a[3]); *(u32x2*)(XB + (size_t)row * 1024 + col) = w;
                    const float b0 = bflo(w.x), b1 = bfhi(w.x), b2 = bflo(w.y), b3 = bfhi(w.y);
                    s += (b0 * b0 + b1 * b1) + (b2 * b2 + b3 * b3); }
            } else {
#pragma unroll
                for (int n = 0; n < 4; ++n) { const int col = pn * 128 + wc * 64 + n * 16 + fq * 4;
                    const u32x2 xr = *(const u32x2*)(XB + (size_t)row * 1024 + col);
                    f32x4 a = acc[m][n]; a[0] += bflo(xr.x); a[1] += bfhi(xr.x); a[2] += bflo(xr.y); a[3] += bfhi(xr.y);
                    *(f32x4*)(XO + (size_t)row * 1024 + col) = a;
                    s += (a[0] * a[0] + a[1] * a[1]) + (a[2] * a[2] + a[3] * a[3]); }
            }
            s += __shfl_xor(s, 16); s += __shfl_xor(s, 32);
            if (fq == 0) ssq[(size_t)row * 16 + pn * 2 + wc] = s;
        }
    }
};

__device__ __forceinline__ int inproj_dst_row(int n) {
    if (n < 1024) { const int gl = n >= 512, ch = n & 511; const int T = ch >> 6, wc = (ch >> 5) & 1, f1 = (ch >> 4) & 1, i = ch & 15;
        return T * 128 + wc * 64 + (f1 + 2 * gl) * 16 + i; }
    return n;
}
__device__ void prep_w_tile(const float* W, int ldw, int ncols, const float* g, bf16_t* Wt, int K, int k0, int n0, bool permute, LAS unsigned char* lds) {
    LAS bf16_t* tile = (LAS bf16_t*)lds;
    const int tid = tid_(), c = tid & 63, kq = tid >> 6;
    const int n = n0 + c * 4;
    f32x4 v[8];
#pragma unroll
    for (int i = 0; i < 8; ++i) v[i] = n < ncols ? *(const f32x4*)(W + (size_t)(k0 + kq + 4 * i) * ldw + n) : (f32x4){0.f, 0.f, 0.f, 0.f};
    if (g) {
#pragma unroll
        for (int i = 0; i < 8; ++i) v[i] = v[i] * g[k0 + kq + 4 * i];
    }
#pragma unroll
    for (int i = 0; i < 8; ++i) { u32x2 w; w.x = pk2(v[i][0], v[i][1]); w.y = pk2(v[i][2], v[i][3]); *(LAS u32x2*)(tile + (kq + 4 * i) * 264 + c * 4) = w; }
    __syncthreads();
#pragma unroll
    for (int j = 0; j < 4; ++j) { const int item = tid + j * 256, col = item & 255, ch = item >> 8; const int ns = n0 + col;
        if (ns < ncols) { const int r = permute ? inproj_dst_row(ns) : ns;
            unsigned short e[8];
#pragma unroll
            for (int q = 0; q < 8; ++q) e[q] = tile[(ch * 8 + q) * 264 + col];
            u32x4 w; w.x = e[0] | ((unsigned)e[1] << 16); w.y = e[2] | ((unsigned)e[3] << 16); w.z = e[4] | ((unsigned)e[5] << 16); w.w = e[6] | ((unsigned)e[7] << 16);
            *(u32x4*)(Wt + (size_t)r * K + k0 + ch * 8) = w; } }
    __syncthreads();
}
__device__ __forceinline__ void prep_w_unit(const Params& p, int u, LAS unsigned char* lds) {
    bf16_t* WIN = (bf16_t*)(p.ws + OFF_WIN); bf16_t* WPW = (bf16_t*)(p.ws + OFF_WPW); bf16_t* WOUT = (bf16_t*)(p.ws + OFF_WOUT);
    if (u < 832) { const int l = u / 416, v = u % 416, kt = v / 13, nt = v % 13;
        prep_w_tile(p.w_in + (size_t)l * 1024 * 3088, 3088, 3088, p.norm_g + l * 1024, WIN + (size_t)l * NIN * 1024, 1024, kt * 32, nt * 256, true, lds);
    } else if (u < 896) { const int w = u - 832, l = w / 32, v = w % 32, kt = v / 2, nt = v % 2;
        prep_w_tile(p.w_pw + (size_t)l * 512 * 512, 512, 512, nullptr, WPW + (size_t)l * 512 * 512, 512, kt * 32, nt * 256, false, lds);
    } else if (u < 1152) { const int w = u - 896, l = w / 128, v = w % 128, kt = v / 4, nt = v % 4;
        prep_w_tile(p.w_out + (size_t)l * 1024 * 1024, 1024, 1024, nullptr, WOUT + (size_t)l * 1024 * 1024, 1024, kt * 32, nt * 256, false, lds);
    } else { const int l = u - 1152; u32x4* z = (u32x4*)(WIN + (size_t)l * NIN * 1024 + (size_t)3088 * 1024);
        for (int i = tid_(); i < 112 * 1024 / 8; i += 256) z[i] = (u32x4){0u, 0u, 0u, 0u}; }
}
__device__ void phase_prep(const Params& p, LAS unsigned char* lds) {
    bf16_t* XB = (bf16_t*)(p.ws + OFF_BUFA); float* SSQ = (float*)(p.ws + OFF_SSQ);
    const int nb = gridDim.x, bid = blockIdx.x;
    const int tid0 = tid_(); const int wid = tid0 >> 6, lane = tid0 & 63;
    for (int row = (bid * 4 + wid) * 2; row < NTOK; row += nb * 8) {
        const float* xr0 = xrow_in(p, row); const float* xr1 = xrow_in(p, row + 1);
        f32x4 a[2][4];
#pragma unroll
        for (int i = 0; i < 4; ++i) { a[0][i] = *(const f32x4*)(xr0 + i * 256 + lane * 4); a[1][i] = *(const f32x4*)(xr1 + i * 256 + lane * 4); }
#pragma unroll
        for (int q = 0; q < 2; ++q) { float s = 0.f;
#pragma unroll
            for (int i = 0; i < 4; ++i) { const f32x4 v = a[q][i]; s += (v[0] * v[0] + v[1] * v[1]) + (v[2] * v[2] + v[3] * v[3]);
                u32x2 w; w.x = pk2(v[0], v[1]); w.y = pk2(v[2], v[3]); *(u32x2*)(XB + (size_t)(row + q) * 1024 + i * 256 + lane * 4) = w; }
            s = wave_sum(s);
            if (lane < 16) SSQ[(size_t)(row + q) * 16 + lane] = lane == 0 ? s : 0.f; }
    }
    for (int u = bid; u < 416; u += nb) prep_w_unit(p, u, lds);
    if (bid == nb - 1) prep_w_unit(p, 1152, lds);
}

template <int NT>
__device__ __forceinline__ void compute_bcum(const Params& p, int layer, int h, const float* LR, int row0, LAS float* G, LAS float* LRS) {
    const int tid = tid_(), d = tid & 63, tq = tid >> 6;
    if (tid < NT * 4) *(LAS f32x4*)(LRS + tid * 4) = *(const f32x4*)(LR + (size_t)row0 * 16 + tid * 4);
    float wa[16];
#pragma unroll
    for (int r = 0; r < 16; ++r) wa[r] = p.w_alpha[(size_t)layer * 16 * 256 + r * 256 + h * 64 + d];
    const float ba = p.b_alpha[layer * 256 + h * 64 + d];
    __syncthreads();
    constexpr int PER = NT / 4;
#pragma unroll 4
    for (int i = 0; i < PER; ++i) { const int t = tq * PER + i;
        const LAS f32x4* lp = (const LAS f32x4*)(LRS + t * 16);
        float z = ba;
#pragma unroll
        for (int r4 = 0; r4 < 4; ++r4) { const f32x4 v = lp[r4]; z += v[0] * wa[r4 * 4] + v[1] * wa[r4 * 4 + 1] + v[2] * wa[r4 * 4 + 2] + v[3] * wa[r4 * 4 + 3]; }
        const float ls = fminf(z, 0.f) - __logf(1.0f + __expf(-fabsf(z)));
        G[t * 64 + d] = ls * (1.0f / 16.0f);
    }
    __syncthreads();
    if (tid < 64) { float run = 0.f;
#pragma unroll 8
        for (int t = 0; t < NT; ++t) { run += G[t * 64 + d]; G[t * 64 + d] = run; } }
    __syncthreads();
}

__device__ void conv_unit(const Params& p, int layer, bool sample, int b_or_pair, int tile, int cs, LAS unsigned char* lds) {
    const bf16_t* U = (const bf16_t*)(p.ws + OFF_U); bf16_t* CVG = (bf16_t*)(p.ws + OFF_CVG);
    LAS bf16_t* ub = (LAS bf16_t*)lds;
    const int tid = tid_(), wid = tid >> 6, lane = tid & 63;
    const int t0 = tile * 64;
    if (!sample) {
        for (int c = tid; c < 94 * 16; c += 256) { const int i = c >> 4, cc = c & 15; const int time = t0 - 30 + i;
            u32x4 v = (u32x4){0u, 0u, 0u, 0u};
            if (time >= 0) v = *(const u32x4*)(U + (size_t)(b_or_pair * SEQ + time) * 512 + cs * 128 + cc * 8);
            *(LAS u32x4*)(ub + i * 128 + cc * 8) = v; }
    } else {
        for (int c = tid; c < 76 * 16; c += 256) { const int i = c >> 4, cc = c & 15; const int sq = i >= 38, ii = i - sq * 38; const int s = b_or_pair * 2 + sq;
            u32x4 v;
            if (ii < 30) { const float* src = p.cache_conv + (((size_t)layer * DEC_B + s) * 30 + ii) * 512 + cs * 128 + cc * 8;
                const f32x4 a = *(const f32x4*)src, bb = *(const f32x4*)(src + 4);
                v.x = pk2(a[0], a[1]); v.y = pk2(a[2], a[3]); v.z = pk2(bb[0], bb[1]); v.w = pk2(bb[2], bb[3]);
                if (ii >= 8) { float* dst = p.out + OUT_CCS + (((size_t)layer * DEC_B + s) * 30 + (ii - 8)) * 512 + cs * 128 + cc * 8;
                    *(f32x4*)dst = a; *(f32x4*)(dst + 4) = bb; }
            } else v = *(const u32x4*)(U + (size_t)(NPROMPT + s * 8 + (ii - 30)) * 512 + cs * 128 + cc * 8);
            *(LAS u32x4*)(ub + i * 128 + cc * 8) = v; }
    }
    __syncthreads();
    const int gi = wid & 1, half = wid >> 1; const int chl = gi * 64 + lane, ch = cs * 128 + chl;
    float w[31];
#pragma unroll
    for (int j = 0; j < 31; ++j) w[j] = p.conv_w[((size_t)layer * 31 + j) * 512 + ch];
    const float cb = p.conv_b[layer * 512 + ch], lg = p.cn_g[layer * 512 + ch], lb = p.cn_b[layer * 512 + ch];
    const int rb = sample ? half * 38 : half * 32;
    const int nsteps = sample ? 2 : 8;
    const size_t grow0 = sample ? (size_t)(NPROMPT + (b_or_pair * 2 + half) * 8) : (size_t)(b_or_pair * SEQ + t0 + half * 32);
    for (int st = 0; st < nsteps; ++st) {
        float vals[34];
#pragma unroll
        for (int i = 0; i < 34; ++i) vals[i] = bf2f(ub[(rb + st * 4 + i) * 128 + chl]);
#pragma unroll
        for (int q = 0; q < 4; ++q) {
            float x = cb;
#pragma unroll
            for (int j = 0; j < 31; ++j) x = fmaf(w[j], vals[q + j], x);
            const float mu = wave_sum(x) * (1.0f / 64.0f); const float dlt = x - mu;
            const float var = wave_sum(dlt * dlt) * (1.0f / 64.0f);
            const float y = dlt * rsqrtf(var + EPS) * lg + lb;
            const float sv = siluf_(y);
            CVG[(grow0 + st * 4 + q) * 512 + ch] = (bf16_t)(pk2(sv, 0.f) & 0xffffu);
        }
    }
    if (!sample) {
        if (tile == 31) { for (int c = tid; c < 30 * 128; c += 256) { const int j = c >> 7, cc = c & 127;
            p.out[OUT_CCP + (((size_t)layer * BATCH + b_or_pair) * 30 + j) * 512 + cs * 128 + cc] = bf2f(ub[(64 + j) * 128 + cc]); } }
    } else {
        for (int c = tid; c < 2 * 8 * 128; c += 256) { const int sq = c >> 10, j = (c >> 7) & 7, cc = c & 127; const int s = b_or_pair * 2 + sq;
            p.out[OUT_CCS + (((size_t)layer * DEC_B + s) * 30 + 22 + j) * 512 + cs * 128 + cc] = bf2f(ub[(sq * 38 + 30 + j) * 128 + cc]); }
    }
    __syncthreads();
}

__device__ void gla_ds_unit(const Params& p, int layer, int unit, LAS unsigned char* lds) {
    const int h = unit & 3, bc = unit >> 2; const int row0 = bc * 64;
    const bf16_t* Kb = (const bf16_t*)(p.ws + OFF_K); const bf16_t* V = (const bf16_t*)(p.ws + OFF_V); const float* LR = (const float*)(p.ws + OFF_LR);
    float* DS = (float*)(p.ws + OFF_DS) + (size_t)unit * 8192; float* DEC = (float*)(p.ws + OFF_DEC) + (size_t)unit * 64;
    LAS float* G = (LAS float*)lds;
    LAS bf16_t* KT = (LAS bf16_t*)(lds + 16384);
    LAS bf16_t* VT = (LAS bf16_t*)(lds + 16384 + 9216);
    const int tid = tid_(), t = tid >> 2, qd = tid & 3;
    const u32x4* src = (const u32x4*)(Kb + (size_t)(row0 + t) * 256 + h * 64 + qd * 16);
    const u32x4* vs = (const u32x4*)(V + (size_t)(row0 + t) * 512 + h * 128 + qd * 32);
    const u32x4 a = src[0], b = src[1]; u32x4 vreg[4];
#pragma unroll
    for (int c = 0; c < 4; ++c) vreg[c] = vs[c];
    compute_bcum<64>(p, layer, h, LR, row0, G, (LAS float*)(lds + 16384 + 9216 + 18432));
    {
        const unsigned wv[8] = {a.x, a.y, a.z, a.w, b.x, b.y, b.z, b.w};
#pragma unroll
        for (int e = 0; e < 8; ++e) { const int d0 = qd * 16 + 2 * e;
            const float f0 = bflo(wv[e]) * __expf(G[63 * 64 + d0] - G[t * 64 + d0]);
            const float f1 = bfhi(wv[e]) * __expf(G[63 * 64 + d0 + 1] - G[t * 64 + d0 + 1]);
            const unsigned pk = pk2(f0, f1);
            KT[d0 * 72 + t] = (bf16_t)(pk & 0xffffu); KT[(d0 + 1) * 72 + t] = (bf16_t)(pk >> 16); }
#pragma unroll
        for (int c = 0; c < 4; ++c) { const u32x4 a2 = vreg[c]; const unsigned w2[4] = {a2.x, a2.y, a2.z, a2.w};
#pragma unroll
            for (int e = 0; e < 4; ++e) { const int dv = qd * 32 + c * 8 + 2 * e;
                VT[dv * 72 + t] = (bf16_t)(w2[e] & 0xffffu); VT[(dv + 1) * 72 + t] = (bf16_t)(w2[e] >> 16); } }
        if (tid < 64) DEC[tid] = __expf(G[63 * 64 + tid]);
    }
    __syncthreads();
    const int wid = tid >> 6, lane = tid & 63, fr = lane & 15, fq = lane >> 4;
    f32x4 acc[2][4];
#pragma unroll
    for (int m = 0; m < 2; ++m)
#pragma unroll
        for (int n = 0; n < 4; ++n) acc[m][n] = (f32x4){0.f, 0.f, 0.f, 0.f};
#pragma unroll
    for (int kk = 0; kk < 2; ++kk) {
        bf16x8 vf[2], kf[4];
#pragma unroll
        for (int m = 0; m < 2; ++m) vf[m] = *(LAS bf16x8*)(VT + (wid * 32 + m * 16 + fr) * 72 + kk * 32 + fq * 8);
#pragma unroll
        for (int n = 0; n < 4; ++n) kf[n] = *(LAS bf16x8*)(KT + (n * 16 + fr) * 72 + kk * 32 + fq * 8);
#pragma unroll
        for (int m = 0; m < 2; ++m)
#pragma unroll
            for (int n = 0; n < 4; ++n) acc[m][n] = __builtin_amdgcn_mfma_f32_16x16x32_bf16(kf[n], vf[m], acc[m][n], 0, 0, 0);
    }
#pragma unroll
    for (int m = 0; m < 2; ++m)
#pragma unroll
        for (int n = 0; n < 4; ++n) *(f32x4*)(DS + (size_t)(wid * 32 + m * 16 + fr) * 64 + n * 16 + fq * 4) = acc[m][n];
    __syncthreads();
}

__device__ void gla_sample_unit(const Params& p, int layer, int unit, LAS unsigned char* lds) {
    const int h = unit & 3, s = unit >> 2; const int row0 = NPROMPT + s * 8;
    const bf16_t* Q = (const bf16_t*)(p.ws + OFF_Q); const bf16_t* Kb = (const bf16_t*)(p.ws + OFF_K); const bf16_t* V = (const bf16_t*)(p.ws + OFF_V);
    const bf16_t* ZG = (const bf16_t*)(p.ws + OFF_ZG); const float* LR = (const float*)(p.ws + OFF_LR); bf16_t* MIX = (bf16_t*)(p.ws + OFF_BUFA);
    const float* S0 = p.state_gla + (((size_t)layer * DEC_B + s) * 4 + h) * 8192;
    float* SN = p.out + OUT_SGS + (((size_t)layer * DEC_B + s) * 4 + h) * 8192;
    LAS float* G = (LAS float*)lds;
    LAS float* QT = G + 512;
    LAS float* KT = QT + 512;
    LAS float* KD = KT + 512;
    LAS float* DCY = KD + 512;
    LAS float* ATT = DCY + 64;
    LAS float* VV = ATT + 64;
    LAS float* OP = VV + 1024;
    LAS float* RED = OP + 2048;
    compute_bcum<8>(p, layer, h, LR, row0, G, (LAS float*)(lds + 32768));
    const int tid = tid_();
#pragma unroll
    for (int i = 0; i < 2; ++i) { const int e = tid + i * 256, t = e >> 6, d = e & 63;
        const float bc = G[t * 64 + d], bl = G[7 * 64 + d];
        const float q = bf2f(Q[(size_t)(row0 + t) * 256 + h * 64 + d]), k = bf2f(Kb[(size_t)(row0 + t) * 256 + h * 64 + d]);
        QT[e] = q * __expf(bc); KT[e] = k * __expf(-bc); KD[e] = k * __expf(bl - bc);
        if (t == 7) DCY[d] = __expf(bl); }
#pragma unroll
    for (int i = 0; i < 4; ++i) { const int e = tid + i * 256, t = e >> 7, v = e & 127; VV[e] = bf2f(V[(size_t)(row0 + t) * 512 + h * 128 + v]); }
    __syncthreads();
    if (tid < 64) { const int t = tid >> 3, s2 = tid & 7; float a = 0.f;
        if (s2 <= t) { for (int d = 0; d < 64; ++d) a += QT[t * 64 + d] * KT[s2 * 64 + d]; }
        ATT[tid] = a; }
    __syncthreads();
    const int vcol = tid & 127, dh = tid >> 7;
    float o[8], v8[8];
#pragma unroll
    for (int t = 0; t < 8; ++t) { o[t] = 0.f; v8[t] = VV[t * 128 + vcol]; }
    float s0r[32];
#pragma unroll
    for (int dd = 0; dd < 32; ++dd) s0r[dd] = __builtin_nontemporal_load(S0 + (dh * 32 + dd) * 128 + vcol);
#pragma unroll
    for (int dd = 0; dd < 32; ++dd) { const int d = dh * 32 + dd; const float s0 = s0r[dd];
        float sn = s0 * DCY[d];
#pragma unroll
        for (int t = 0; t < 8; ++t) { o[t] = fmaf(QT[t * 64 + d], s0, o[t]); sn = fmaf(KD[t * 64 + d], v8[t], sn); }
        __builtin_nontemporal_store(sn, SN + d * 128 + vcol); }
    if (dh == 0) {
#pragma unroll
        for (int t = 0; t < 8; ++t)
#pragma unroll
            for (int s2 = 0; s2 < 8; ++s2) o[t] = fmaf(ATT[t * 8 + s2], v8[s2], o[t]);
    }
#pragma unroll
    for (int t = 0; t < 8; ++t) OP[(dh * 8 + t) * 128 + vcol] = o[t];
    __syncthreads();
    float val[4];
#pragma unroll
    for (int i = 0; i < 4; ++i) { const int t = dh * 4 + i; val[i] = OP[t * 128 + vcol] + OP[(8 + t) * 128 + vcol];
        const float ps = wave_sum(val[i] * val[i]); if ((tid & 63) == 0) RED[t * 4 + ((tid >> 6) & 1)] = ps; }
    __syncthreads();
    const float gg = p.gla_g[layer * 128 + vcol];
#pragma unroll
    for (int i = 0; i < 4; ++i) { const int t = dh * 4 + i; const float ms = (RED[t * 4] + RED[t * 4 + 1]) * (1.0f / 128.0f);
        const float zg = bf2f(ZG[(size_t)(row0 + t) * 512 + h * 128 + vcol]);
        const float r = val[i] * rsqrtf(ms + EPS) * gg * zg;
        MIX[(size_t)(row0 + t) * 1024 + 512 + h * 128 + vcol] = (bf16_t)(pk2(r, 0.f) & 0xffffu); }
    __syncthreads();
}

__device__ void scan_unit(const Params& p, int layer, int unit) {
    typedef float f32x2 __attribute__((ext_vector_type(2)));
    const int part = unit & 15, h = (unit >> 4) & 3, b = unit >> 6;
    const float* DS = (const float*)(p.ws + OFF_DS); const float* DEC = (const float*)(p.ws + OFF_DEC); bf16_t* SB = (bf16_t*)(p.ws + OFF_SB);
    const int e = part * 512 + tid_() * 2; const int dk = e & 63, dv = e >> 6;
    f32x2 S = (f32x2){0.f, 0.f};
#pragma unroll
    for (int i0 = 0; i0 < 32; i0 += 16) {
        f32x2 cur[16], dc[16];
#pragma unroll
        for (int i = 0; i < 16; ++i) { const size_t ug = (size_t)((b * 32 + i0 + i) * 4 + h);
            cur[i] = *(const f32x2*)(DS + ug * 8192 + e); dc[i] = *(const f32x2*)(DEC + ug * 64 + dk); }
#pragma unroll
        for (int i = 0; i < 16; ++i) { const size_t ug = (size_t)((b * 32 + i0 + i) * 4 + h);
            *(unsigned*)(SB + ug * 8192 + e) = pk2(S[0], S[1]);
            S = S * dc[i] + cur[i]; }
    }
    float* o = p.out + OUT_SGP + (((size_t)layer * BATCH + b) * 4 + h) * 8192;
    o[dk * 128 + dv] = S[0]; o[(dk + 1) * 128 + dv] = S[1];
}

__device__ void gla_out_unit(const Params& p, int layer, int unit, LAS unsigned char* lds) {
    const int h = unit & 3, bc = unit >> 2; const int row0 = bc * 64;
    const bf16_t* Q = (const bf16_t*)(p.ws + OFF_Q); const bf16_t* Kb = (const bf16_t*)(p.ws + OFF_K); const bf16_t* V = (const bf16_t*)(p.ws + OFF_V);
    const bf16_t* ZG = (const bf16_t*)(p.ws + OFF_ZG); const float* LR = (const float*)(p.ws + OFF_LR); bf16_t* MIX = (bf16_t*)(p.ws + OFF_BUFA);
    const bf16_t* SB = (const bf16_t*)(p.ws + OFF_SB) + (size_t)unit * 8192;
    LAS float* G = (LAS float*)lds;
    LAS bf16_t* QT = (LAS bf16_t*)(lds + 16384);
    LAS bf16_t* KT = (LAS bf16_t*)(lds + 16384 + 9216);
    LAS bf16_t* VT = (LAS bf16_t*)(lds + 16384 + 18432);
    LAS bf16_t* PP = (LAS bf16_t*)(lds + 16384 + 18432 + 18432);
    const int tid = tid_();
    const int t = tid >> 2, qd = tid & 3;
    const u32x4* qs = (const u32x4*)(Q + (size_t)(row0 + t) * 256 + h * 64 + qd * 16);
    const u32x4* ks = (const u32x4*)(Kb + (size_t)(row0 + t) * 256 + h * 64 + qd * 16);
    const u32x4* vs = (const u32x4*)(V + (size_t)(row0 + t) * 512 + h * 128 + qd * 32);
    const u32x4 qa = qs[0], qb = qs[1], ka = ks[0], kb = ks[1]; u32x4 vreg[4], sreg[4];
#pragma unroll
    for (int c = 0; c < 4; ++c) vreg[c] = vs[c];
#pragma unroll
    for (int c = 0; c < 4; ++c) sreg[c] = *(const u32x4*)(SB + (size_t)(tid + c * 256) * 8);
    compute_bcum<64>(p, layer, h, LR, row0, G, (LAS float*)PP);
    {
        const unsigned qw[8] = {qa.x, qa.y, qa.z, qa.w, qb.x, qb.y, qb.z, qb.w}; const unsigned kw[8] = {ka.x, ka.y, ka.z, ka.w, kb.x, kb.y, kb.z, kb.w};
        unsigned qo[8], ko[8];
#pragma unroll
        for (int e = 0; e < 8; ++e) { const int d0 = qd * 16 + 2 * e; const float g0 = G[t * 64 + d0], g1 = G[t * 64 + d0 + 1];
            const float e0 = __expf(g0), e1 = __expf(g1);
            qo[e] = pk2(bflo(qw[e]) * e0, bfhi(qw[e]) * e1);
            ko[e] = pk2(bflo(kw[e]) * __builtin_amdgcn_rcpf(e0), bfhi(kw[e]) * __builtin_amdgcn_rcpf(e1)); }
        *(LAS u32x4*)(QT + t * 72 + qd * 16) = (u32x4){qo[0], qo[1], qo[2], qo[3]}; *(LAS u32x4*)(QT + t * 72 + qd * 16 + 8) = (u32x4){qo[4], qo[5], qo[6], qo[7]};
        *(LAS u32x4*)(KT + t * 72 + qd * 16) = (u32x4){ko[0], ko[1], ko[2], ko[3]}; *(LAS u32x4*)(KT + t * 72 + qd * 16 + 8) = (u32x4){ko[4], ko[5], ko[6], ko[7]};
#pragma unroll
        for (int c = 0; c < 4; ++c) { const u32x4 a2 = vreg[c]; const unsigned w2[4] = {a2.x, a2.y, a2.z, a2.w};
#pragma unroll
            for (int e = 0; e < 4; ++e) { const int dv = qd * 32 + c * 8 + 2 * e;
                VT[dv * 72 + t] = (bf16_t)(w2[e] & 0xffffu); VT[(dv + 1) * 72 + t] = (bf16_t)(w2[e] >> 16); } }
    }
    __syncthreads();
    {
#pragma unroll
        for (int c = 0; c < 4; ++c) { const int ci = tid + c * 256, r = ci >> 3, ch = ci & 7;
            *(LAS u32x4*)(lds + r * 128 + ((ch ^ (r & 7)) * 16)) = sreg[c]; }
    }
    __syncthreads();
    const int wid = tid >> 6, lane = tid & 63, fr = lane & 15, fq = lane >> 4;
    LAS bf16_t* PW = PP + wid * 16 * 72;
    {
        bf16x8 qf[2];
#pragma unroll
        for (int kk = 0; kk < 2; ++kk) qf[kk] = *(LAS bf16x8*)(QT + (wid * 16 + fr) * 72 + kk * 32 + fq * 8);
#pragma unroll
        for (int n = 0; n < 4; ++n) {
            f32x4 a = (f32x4){0.f, 0.f, 0.f, 0.f};
#pragma unroll
            for (int kk = 0; kk < 2; ++kk) { const bf16x8 kf = *(LAS bf16x8*)(KT + (n * 16 + fr) * 72 + kk * 32 + fq * 8);
                a = __builtin_amdgcn_mfma_f32_16x16x32_bf16(kf, qf[kk], a, 0, 0, 0); }
            const int tg = wid * 16 + fr, sg = n * 16 + fq * 4;
            u32x2 w; w.x = pk2(sg <= tg ? a[0] : 0.f, sg + 1 <= tg ? a[1] : 0.f); w.y = pk2(sg + 2 <= tg ? a[2] : 0.f, sg + 3 <= tg ? a[3] : 0.f);
            *(LAS u32x2*)(PW + fr * 72 + n * 16 + fq * 4) = w;
        }
    }
    __builtin_amdgcn_s_waitcnt(0xc07f);
    __builtin_amdgcn_wave_barrier();
    f32x4 acc[8];
#pragma unroll
    for (int n = 0; n < 8; ++n) acc[n] = (f32x4){0.f, 0.f, 0.f, 0.f};
#pragma unroll
    for (int kk = 0; kk < 2; ++kk) {
        const bf16x8 qf = *(LAS bf16x8*)(QT + (wid * 16 + fr) * 72 + kk * 32 + fq * 8);
        const bf16x8 pf = *(LAS bf16x8*)(PW + fr * 72 + kk * 32 + fq * 8);
#pragma unroll
        for (int n = 0; n < 8; ++n) {
            const bf16x8 sf = *(LAS bf16x8*)(lds + (n * 16 + fr) * 128 + (((kk * 4 + fq) ^ (fr & 7)) * 16));
            const bf16x8 vf = *(LAS bf16x8*)(VT + (n * 16 + fr) * 72 + kk * 32 + fq * 8);
            acc[n] = __builtin_amdgcn_mfma_f32_16x16x32_bf16(sf, qf, acc[n], 0, 0, 0);
            acc[n] = __builtin_amdgcn_mfma_f32_16x16x32_bf16(vf, pf, acc[n], 0, 0, 0);
        }
    }
    float ss = 0.f;
#pragma unroll
    for (int n = 0; n < 8; ++n) ss += (acc[n][0] * acc[n][0] + acc[n][1] * acc[n][1]) + (acc[n][2] * acc[n][2] + acc[n][3] * acc[n][3]);
    ss += __shfl_xor(ss, 16); ss += __shfl_xor(ss, 32);
    const float rinv = rsqrtf(ss * (1.0f / 128.0f) + EPS);
    const size_t row = (size_t)(row0 + wid * 16 + fr);
#pragma unroll
    for (int n = 0; n < 8; ++n) { const int dv = n * 16 + fq * 4; const f32x4 gg = *(const f32x4*)(p.gla_g + layer * 128 + dv);
        const u32x2 z = *(const u32x2*)(ZG + row * 512 + h * 128 + dv); u32x2 w;
        w.x = pk2(acc[n][0] * rinv * gg[0] * bflo(z.x), acc[n][1] * rinv * gg[1] * bfhi(z.x));
        w.y = pk2(acc[n][2] * rinv * gg[2] * bflo(z.y), acc[n][3] * rinv * gg[3] * bfhi(z.y));
        *(u32x2*)(MIX + row * 1024 + 512 + h * 128 + dv) = w; }
    __syncthreads();
}


#define XB_TMO      128
#define XB_XCNT(j)  (256  + 64 * (j))
#define XB_XSUB(j)  (1280 + 64 * (j))
#define XB_XGEN(j)  (2304 + 64 * (j))
#define XB_TOP      3328
#define XB_TOPGEN   3392
#define XCD_BAR_WORDS 3456
#define XB_SPIN_CAP (1u << 22)
__device__ __forceinline__ unsigned xb_ld(unsigned* p)              { return __hip_atomic_load(p, __ATOMIC_RELAXED, __HIP_MEMORY_SCOPE_AGENT); }
__device__ __forceinline__ unsigned xb_add(unsigned* p, unsigned v) { return __hip_atomic_fetch_add(p, v, __ATOMIC_RELAXED, __HIP_MEMORY_SCOPE_AGENT); }
__device__ __forceinline__ unsigned xb_xcc_id() { return (unsigned)__builtin_amdgcn_s_getreg((3 << 11) | 20) & 0xFu; }
#define XB_SPIN(cond, bar) do { unsigned _sp = 0; while (cond) { __builtin_amdgcn_s_sleep(1); \
    if ((++_sp & 255u) == 0u) { if (xb_ld(&(bar)[XB_TMO])) break; if (_sp > XB_SPIN_CAP) { atomicAdd(&(bar)[XB_TMO], 1u); break; } } } } while (0)
struct XcdBarrier { unsigned* bar; unsigned x; volatile LAS unsigned* st; };
__device__ __forceinline__ XcdBarrier xcd_barrier_post(unsigned* bar, volatile LAS unsigned* st) {
    XcdBarrier b; b.bar = bar; b.x = xb_xcc_id(); b.st = st;
    if (threadIdx.x == 0) (void)xb_add(&bar[XB_XCNT(b.x)], 1u);
    return b;
}
__device__ __forceinline__ void xcd_barrier_complete(unsigned* bar, unsigned x, unsigned& nloc, unsigned& nx) {
    const unsigned G = gridDim.x * gridDim.y * gridDim.z;
    unsigned sum, cnt, mine, sp = 0u;
    for (;;) {
        sum = 0u; cnt = 0u; mine = 0u;
#pragma unroll
        for (unsigned j = 0; j < 16; ++j) { const unsigned c = xb_ld(&bar[XB_XCNT(j)]); sum += c; cnt += (c > 0u) ? 1u : 0u; mine = (j == x) ? c : mine; }
        if (sum == G) break;
        __builtin_amdgcn_s_sleep(1);
        if ((++sp & 255u) == 0u) { if (xb_ld(&bar[XB_TMO])) break; if (sp > XB_SPIN_CAP) { atomicAdd(&bar[XB_TMO], 1u); break; } }
    }
    nloc = mine > 0u ? mine : 1u; nx = cnt > 0u ? cnt : 1u;
}
__device__ __forceinline__ void xcd_barrier(const XcdBarrier& b) {
    asm volatile("s_waitcnt vmcnt(0)" ::: "memory");
    __syncthreads();
    if (threadIdx.x == 0) {
        unsigned* bar = b.bar;
        __builtin_amdgcn_s_waitcnt(0);
        unsigned nloc = b.st[0], nx = b.st[1];
        if (nloc == 0u) { xcd_barrier_complete(bar, b.x, nloc, nx); b.st[0] = nloc; b.st[1] = nx; }
        const unsigned old = xb_add(&bar[XB_XSUB(b.x)], 1u);
        const unsigned gen = old / nloc;
        if (old + 1u == (gen + 1u) * nloc) {
            __builtin_amdgcn_fence(__ATOMIC_RELEASE, "agent");
            asm volatile("s_waitcnt vmcnt(0)" ::: "memory");
            const unsigned og = xb_add(&bar[XB_TOP], 1u);
            const unsigned tg = og / nx;
            if (og + 1u == (tg + 1u) * nx) xb_add(&bar[XB_TOPGEN], 1u);
            else XB_SPIN(xb_add(&bar[XB_TOPGEN], 0u) == tg, bar);
            __builtin_amdgcn_fence(__ATOMIC_ACQUIRE, "agent");
            xb_add(&bar[XB_XGEN(b.x)], 1u);
            asm volatile("s_waitcnt vmcnt(0)" ::: "memory");
        } else {
            XB_SPIN(xb_ld(&bar[XB_XGEN(b.x)]) == gen, bar);
            __builtin_amdgcn_fence(__ATOMIC_ACQUIRE, "agent");
            asm volatile("s_waitcnt vmcnt(0)" ::: "memory");
        }
    }
    __syncthreads();
}

#ifndef REP_PREP
#define REP_PREP 1
#endif
#ifndef REP_IN
#define REP_IN 1
#endif
#ifndef REP_P2
#define REP_P2 1
#endif
#ifndef REP_P3
#define REP_P3 1
#endif
#ifndef REP_P4
#define REP_P4 1
#endif
#ifndef REP_OUT
#define REP_OUT 1
#endif
#ifndef REP_SYNC
#define REP_SYNC 1
#endif
#ifndef PROBE_MASK
#define PROBE_MASK 0
#endif
#define PROBE_MULT 4
#define TSTAMP() do { if (PROBE_MASK) { if (blockIdx.x == 0 && threadIdx.x == 0) { tsl[tsi] = __builtin_amdgcn_s_memrealtime(); } ++tsi; } } while (0)
#define GSYNC() do { for (int _r = 0; _r < REP_SYNC; ++_r) xcd_barrier(xb); TSTAMP(); } while (0)
__global__ void __launch_bounds__(256, 2) hymba_mega(Params p) {
    __shared__ __attribute__((aligned(16))) unsigned char smem[66560];
    LAS unsigned char* lds = (LAS unsigned char*)smem;
    cg::grid_group grid = cg::this_grid();
    const int nb = gridDim.x, bid = blockIdx.x;
    if (p.ws == nullptr) grid.sync();
    volatile LAS unsigned* xst = (volatile LAS unsigned*)(lds + 66048);
    if (threadIdx.x == 0) { xst[0] = 0u; xst[1] = 0u; }
    __syncthreads();
    XcdBarrier xb = xcd_barrier_post((unsigned*)(p.ws + OFF_BAR), xst);
    volatile LAS unsigned long long* tsl = (volatile LAS unsigned long long*)(lds + 66064); int tsi = 0;
    TSTAMP();
    float* SSQ = (float*)(p.ws + OFF_SSQ);
    bf16_t* BUFA = (bf16_t*)(p.ws + OFF_BUFA); bf16_t* BUFB = (bf16_t*)(p.ws + OFF_BUFB);

    for (int rep = 0; rep < REP_PREP; ++rep) phase_prep(p, lds);
    GSYNC();
#pragma unroll 1
    for (int layer = 0; layer < 2; ++layer) {
        {
            EpiIn e; e.ssq = SSQ; e.U = (bf16_t*)(p.ws + OFF_U); e.ZC = (bf16_t*)(p.ws + OFF_ZC); e.Q = (bf16_t*)(p.ws + OFF_Q); e.Kb = (bf16_t*)(p.ws + OFF_K);
            e.V = (bf16_t*)(p.ws + OFF_V); e.ZG = (bf16_t*)(p.ws + OFF_ZG); e.LR = (float*)(p.ws + OFF_LR);
            const bf16_t* A = layer == 0 ? BUFA : BUFB; const bf16_t* Bt = (const bf16_t*)(p.ws + OFF_WIN) + (size_t)layer * NIN * 1024;
            int pm, pn;
            for (int rep = 0; rep < REP_IN; ++rep)
            for (int it = 0; gemm_next(it, 25, pm, pn); ++it) gemm_unit(A, 1024, Bt, 1024, 1024, pm * 128, pn * 128, lds, e, pn);
        }
        GSYNC();
        for (int rep = 0; rep < REP_P2; ++rep)
        for (int u = bid; u < 2816; u += nb) {
            if (u < 1024) gla_ds_unit(p, layer, u, lds);
            else if (u < 2048) { const int v = u - 1024; conv_unit(p, layer, false, v >> 7, (v >> 2) & 31, v & 3, lds); }
            else if (u < 2304) { const int v = u - 2048; conv_unit(p, layer, true, v >> 2, 0, v & 3, lds); }
            else gla_sample_unit(p, layer, u - 2304, lds);
        }
        if (layer == 0) { for (int u = 416 + bid; u < 1152; u += nb) prep_w_unit(p, u, lds); if (bid == nb - 1) prep_w_unit(p, 1153, lds); }
        GSYNC();
        {
            for (int rep = 0; rep < REP_P3; ++rep) {
            for (int u = bid; u < 512; u += nb) scan_unit(p, layer, u);
            EpiPw e; e.bias = p.b_pw + layer * 512; e.ZC = (const bf16_t*)(p.ws + OFF_ZC); e.MIX = BUFA;
            const bf16_t* A = (const bf16_t*)(p.ws + OFF_CVG); const bf16_t* Bt = (const bf16_t*)(p.ws + OFF_WPW) + (size_t)layer * 512 * 512;
            int pm, pn;
            for (int it = 0; gemm_next(it, 4, pm, pn); ++it) gemm_unit(A, 512, Bt, 512, 512, pm * 128, pn * 128, lds, e, pn); }
        }
        GSYNC();
        for (int rep = 0; rep < REP_P4; ++rep)
        for (int u = bid; u < 1024; u += nb) gla_out_unit(p, layer, u, lds);
        GSYNC();
        {
            EpiOut e; e.p = &p; e.layer = layer; e.XO = p.out + OUT_Y; e.XB = BUFB; e.ssq = SSQ;
            const bf16_t* Bt = (const bf16_t*)(p.ws + OFF_WOUT) + (size_t)layer * 1024 * 1024;
            int pm, pn;
            for (int rep = 0; rep < (layer == 0 ? REP_OUT : 1); ++rep)
            for (int it = 0; gemm_next(it, 8, pm, pn); ++it) gemm_unit(BUFA, 1024, Bt, 1024, 1024, pm * 128, pn * 128, lds, e, pn);
        }
        GSYNC();
    }
    {
        const int tid0 = tid_(); const int wid = tid0 >> 6, lane = tid0 & 63;
        for (int row = bid * 4 + wid; row < NTOK; row += nb * 4) {
            float s = lane < 16 ? SSQ[(size_t)row * 16 + lane] : 0.f; s = wave_sum(s);
            const float r = rsqrtf(s * (1.0f / 1024.0f) + EPS);
            float* xr = p.out + OUT_Y + (size_t)row * 1024;
#pragma unroll
            for (int i = 0; i < 4; ++i) { const int col = i * 256 + lane * 4; f32x4 a = *(const f32x4*)(xr + col); const f32x4 g = *(const f32x4*)(p.final_g + col);
                a = a * r * g; __builtin_nontemporal_store(a, (f32x4*)(xr + col)); }
        }
    }
    if (PROBE_MASK) {
        if (blockIdx.x == 0 && threadIdx.x == 0) {
            const unsigned long long tend = __builtin_amdgcn_s_memrealtime(); tsl[12] = tend;
            unsigned long long d = 0;
            for (int i = 0; i < 12; ++i) if ((PROBE_MASK >> i) & 1) d += tsl[i + 1] - tsl[i];
            while (__builtin_amdgcn_s_memrealtime() - tend < (unsigned long long)PROBE_MULT * d) __builtin_amdgcn_s_sleep(8);
        }
    }
}

extern "C" void kernel_launch(void* const* d_in, const int* in_sizes, int n_in, void* d_out, int out_size, void* d_ws, size_t ws_size, hipStream_t stream) {
    static int grid_blocks = 0;
    if (!grid_blocks) {
        int dev = 0, cus = 0, per_cu = 0;
        (void)hipGetDevice(&dev);
        (void)hipDeviceGetAttribute(&cus, hipDeviceAttributeMultiprocessorCount, dev);
        (void)hipOccupancyMaxActiveBlocksPerMultiprocessor(&per_cu, hymba_mega, 256, 0);
        if (per_cu > 2) per_cu = 2;
        if (per_cu < 1) per_cu = 1;
        grid_blocks = cus * per_cu;
    }
    if (ws_size < WS_NEED) fprintf(stderr, "workspace too small: %zu < %zu\n", ws_size, (size_t)WS_NEED);
    Params p{};
    p.x_prompt = (const float*)d_in[0]; p.x_sample = (const float*)d_in[1]; p.cache_conv = (const float*)d_in[2]; p.state_gla = (const float*)d_in[3];
    p.norm_g = (const float*)d_in[4]; p.w_in = (const float*)d_in[5]; p.w_alpha = (const float*)d_in[6]; p.b_alpha = (const float*)d_in[7];
    p.conv_w = (const float*)d_in[8]; p.conv_b = (const float*)d_in[9]; p.cn_g = (const float*)d_in[10]; p.cn_b = (const float*)d_in[11];
    p.w_pw = (const float*)d_in[12]; p.b_pw = (const float*)d_in[13]; p.gla_g = (const float*)d_in[14]; p.w_out = (const float*)d_in[15]; p.final_g = (const float*)d_in[16];
    p.out = (float*)d_out; p.ws = (unsigned char*)d_ws;
    (void)hipMemsetAsync((unsigned char*)d_ws + OFF_BAR, 0, 16384, stream);
    void* args[] = {&p};
    hipError_t e = hipLaunchCooperativeKernel((void*)hymba_mega, dim3(grid_blocks), dim3(256), args, 0, stream);
    if (e != hipSuccess) fprintf(stderr, "cooperative launch failed: %s (grid %d)\n", hipGetErrorString(e), grid_blocks);
}
```

```cpp
#include <hip/hip_runtime.h>
#include <hip/hip_cooperative_groups.h>
#include <cstdint>
#include <cstdio>
namespace cg = cooperative_groups;

#define LAS __attribute__((address_space(3)))
typedef unsigned short bf16_t;
typedef short bf16x8 __attribute__((ext_vector_type(8)));
typedef float f32x4 __attribute__((ext_vector_type(4)));
typedef unsigned u32x2 __attribute__((ext_vector_type(2)));
typedef unsigned u32x4 __attribute__((ext_vector_type(4)));

constexpr int NTOK = 17408, NPROMPT = 16384;
constexpr int SEQ = 2048, BATCH = 8, DEC_B = 128, DEC_T = 8;
constexpr int NIN = 3200;
constexpr float EPS = 1e-6f;

constexpr size_t OFF_WIN  = 0;
constexpr size_t OFF_WPW  = OFF_WIN  + (size_t)2 * NIN * 1024 * 2;
constexpr size_t OFF_WOUT = OFF_WPW  + (size_t)2 * 512 * 512 * 2;
constexpr size_t OFF_BUFA = OFF_WOUT + (size_t)2 * 1024 * 1024 * 2;
constexpr size_t OFF_BUFB = OFF_BUFA + (size_t)NTOK * 1024 * 2;
constexpr size_t OFF_U    = OFF_BUFB + (size_t)NTOK * 1024 * 2;
constexpr size_t OFF_ZC   = OFF_U    + (size_t)NTOK * 512 * 2;
constexpr size_t OFF_Q    = OFF_ZC   + (size_t)NTOK * 512 * 2;
constexpr size_t OFF_K    = OFF_Q    + (size_t)NTOK * 256 * 2;
constexpr size_t OFF_V    = OFF_K    + (size_t)NTOK * 256 * 2;
constexpr size_t OFF_ZG   = OFF_V    + (size_t)NTOK * 512 * 2;
constexpr size_t OFF_LR   = OFF_ZG   + (size_t)NTOK * 512 * 2;
constexpr size_t OFF_CVG  = OFF_LR   + (size_t)NTOK * 16 * 4;
constexpr size_t OFF_DS   = OFF_CVG  + (size_t)NTOK * 512 * 2;
constexpr size_t OFF_SB   = OFF_DS   + (size_t)1024 * 8192 * 4;
constexpr size_t OFF_DEC  = OFF_SB   + (size_t)1024 * 8192 * 2;
constexpr size_t OFF_SSQ  = OFF_DEC  + (size_t)1024 * 64 * 4;
constexpr size_t OFF_BAR  = OFF_SSQ  + (size_t)NTOK * 16 * 4;
constexpr size_t WS_NEED  = OFF_BAR  + 16384;

constexpr size_t OUT_Y    = 0;
constexpr size_t OUT_CCP  = (size_t)NTOK * 1024;
constexpr size_t OUT_SGP  = OUT_CCP + (size_t)2 * 8 * 30 * 512;
constexpr size_t OUT_CCS  = OUT_SGP + (size_t)2 * 8 * 4 * 64 * 128;
constexpr size_t OUT_SGS  = OUT_CCS + (size_t)2 * 128 * 30 * 512;

struct Params {
    const float *x_prompt, *x_sample, *cache_conv, *state_gla, *norm_g, *w_in, *w_alpha, *b_alpha, *conv_w, *conv_b,
                *cn_g, *cn_b, *w_pw, *b_pw, *gla_g, *w_out, *final_g;
    float* out;
    unsigned char* ws;
};

__device__ __forceinline__ unsigned pk2(float lo, float hi) { unsigned r; asm("v_cvt_pk_bf16_f32 %0, %1, %2" : "=v"(r) : "v"(lo), "v"(hi)); return r; }
__device__ __forceinline__ float bf2f(bf16_t h) { return __uint_as_float(((unsigned)h) << 16); }
__device__ __forceinline__ float bflo(unsigned w) { return __uint_as_float(w << 16); }
__device__ __forceinline__ float bfhi(unsigned w) { return __uint_as_float(w & 0xffff0000u); }
__device__ __forceinline__ float sigmoidf_(float x) { return __builtin_amdgcn_rcpf(1.0f + __expf(-x)); }
__device__ __forceinline__ float siluf_(float x) { return x * sigmoidf_(x); }
__device__ __forceinline__ float wave_sum(float v) {
#pragma unroll
    for (int o = 32; o >= 1; o >>= 1) v += __shfl_xor(v, o);
    return v;
}
__device__ __forceinline__ int tid_() { int t = threadIdx.x; asm volatile("" : "+v"(t)); return t; }
__device__ __forceinline__ const float* xrow_in(const Params& p, int row) {
    return row < NPROMPT ? p.x_prompt + (size_t)row * 1024 : p.x_sample + (size_t)(row - NPROMPT) * 1024;
}

template <class Epi>
__device__ __forceinline__ void gemm_unit(const bf16_t* __restrict__ A, int lda, const bf16_t* __restrict__ Bt, int ldb, int K,
                                          int row0, int brow0, LAS unsigned char* lds, const Epi& epi, int pn) {
    const int tid = tid_(), wid = tid >> 6, lane = tid & 63, wr = wid >> 1, wc = wid & 1, fr = lane & 15, fq = lane >> 4;
    f32x4 acc[4][4];
#pragma unroll
    for (int m = 0; m < 4; ++m)
#pragma unroll
        for (int n = 0; n < 4; ++n) acc[m][n] = (f32x4){0.f, 0.f, 0.f, 0.f};
    const int srow = wid * 32 + (lane >> 3), schunk = (lane & 7) ^ (lane >> 3);
    const bf16_t* ga = A + (size_t)(row0 + srow) * lda + schunk * 8;
    const bf16_t* gb = Bt + (size_t)(brow0 + srow) * ldb + schunk * 8;
    const size_t astep = (size_t)8 * lda, bstep = (size_t)8 * ldb;
    const unsigned sdst = (unsigned)(wid * 4096 + lane * 16);
    const int nt = K >> 6;
    epi.pre(row0, lds);
#define GEMM_STAGE(t, buf) do { _Pragma("unroll") for (int i = 0; i < 4; ++i) { \
        __builtin_amdgcn_global_load_lds((const unsigned*)(ga + i * astep + (t) * 64), (LAS unsigned*)(lds + (buf) * 32768 + sdst + i * 1024), 16, 0, 0); \
        __builtin_amdgcn_global_load_lds((const unsigned*)(gb + i * bstep + (t) * 64), (LAS unsigned*)(lds + (buf) * 32768 + 16384 + sdst + i * 1024), 16, 0, 0); } } while (0)
    const unsigned sw0 = (unsigned)((fq ^ (fr & 7)) * 16), sw1 = (unsigned)(((4 + fq) ^ (fr & 7)) * 16);
    const unsigned arow = (unsigned)((wr * 64 + fr) * 128), brow = (unsigned)(16384 + (wc * 64 + fr) * 128);
    GEMM_STAGE(0, 0);
#pragma unroll 2
    for (int t = 0; t < nt; ++t) {
        asm volatile("s_waitcnt vmcnt(0)" ::: "memory");
        __syncthreads();
        if (t + 1 < nt) GEMM_STAGE(t + 1, (t + 1) & 1);
        LAS unsigned char* sb = lds + (t & 1) * 32768;
#pragma unroll
        for (int kk = 0; kk < 2; ++kk) {
            const unsigned sw = kk ? sw1 : sw0;
            bf16x8 af[4], bfr[4];
#pragma unroll
            for (int m = 0; m < 4; ++m) af[m] = *(LAS bf16x8*)(sb + arow + sw + m * 2048);
#pragma unroll
            for (int n = 0; n < 4; ++n) bfr[n] = *(LAS bf16x8*)(sb + brow + sw + n * 2048);
            __builtin_amdgcn_s_setprio(1);
#pragma unroll
            for (int m = 0; m < 4; ++m)
#pragma unroll
                for (int n = 0; n < 4; ++n) acc[m][n] = __builtin_amdgcn_mfma_f32_16x16x32_bf16(bfr[n], af[m], acc[m][n], 0, 0, 0);
            __builtin_amdgcn_s_setprio(0);
        }
    }
#undef GEMM_STAGE
    epi(acc, row0, pn, wr, wc, fr, fq, lds);
    __syncthreads();
}

__device__ __forceinline__ bool gemm_next(int it, int nN, int& pm, int& pn, int first_unit_offset = 0) {
    const int nb = gridDim.x, bid = blockIdx.x;
    if ((nb & 7) == 0) {
        const int xcd = bid & 7, j = bid >> 3, nj = nb >> 3; const int u = j + it * nj;
        if (u >= 17 * nN) return false;
        pm = xcd + 8 * (u / nN); pn = u % nN; return true;
    } else {
        const int u = bid + it * nb; if (u >= 136 * nN) return false; pm = u / nN; pn = u % nN; return true;
    }
}

struct EpiIn {
    const float* ssq; bf16_t *U, *ZC, *Q, *Kb, *V, *ZG; float* LR;
    __device__ __forceinline__ void pre(int row0, LAS unsigned char* lds) const {
        LAS float* rs = (LAS float*)(lds + 65536);
        const int tid = tid_();
        if (tid < 128) { const f32x4* s = (const f32x4*)(ssq + (size_t)(row0 + tid) * 16); f32x4 a = s[0], b = s[1], c = s[2], d = s[3];
            float t = (a[0] + a[1] + a[2] + a[3]) + (b[0] + b[1] + b[2] + b[3]) + (c[0] + c[1] + c[2] + c[3]) + (d[0] + d[1] + d[2] + d[3]);
            rs[tid] = rsqrtf(t * (1.0f / 1024.0f) + EPS); }
    }
    __device__ __forceinline__ void operator()(f32x4 (&acc)[4][4], int row0, int pn, int wr, int wc, int fr, int fq, LAS unsigned char* lds) const {
        const LAS float* rs = (const LAS float*)(lds + 65536);
#pragma unroll
        for (int m = 0; m < 4; ++m) {
            const int rl = wr * 64 + m * 16 + fr; const size_t row = (size_t)(row0 + rl); const float r = rs[rl];
            if (pn < 8) {
#pragma unroll
                for (int n = 0; n < 2; ++n) { f32x4 a = acc[m][n] * r, g = acc[m][n + 2] * r; u32x2 w;
                    w.x = pk2(a[0] * sigmoidf_(g[0]), a[1] * sigmoidf_(g[1])); w.y = pk2(a[2] * sigmoidf_(g[2]), a[3] * sigmoidf_(g[3]));
                    *(u32x2*)(U + row * 512 + pn * 64 + wc * 32 + n * 16 + fq * 4) = w; }
            } else if (pn < 12) {
#pragma unroll
                for (int n = 0; n < 4; ++n) { f32x4 a = acc[m][n] * r; u32x2 w; w.x = pk2(siluf_(a[0]), siluf_(a[1])); w.y = pk2(siluf_(a[2]), siluf_(a[3]));
                    *(u32x2*)(ZC + row * 512 + (pn - 8) * 128 + wc * 64 + n * 16 + fq * 4) = w; }
            } else if (pn < 14) {
#pragma unroll
                for (int n = 0; n < 4; ++n) { f32x4 a = acc[m][n] * (r * 0.125f); u32x2 w; w.x = pk2(a[0], a[1]); w.y = pk2(a[2], a[3]);
                    *(u32x2*)(Q + row * 256 + (pn - 12) * 128 + wc * 64 + n * 16 + fq * 4) = w; }
            } else if (pn < 16) {
#pragma unroll
                for (int n = 0; n < 4; ++n) { f32x4 a = acc[m][n] * r; u32x2 w; w.x = pk2(a[0], a[1]); w.y = pk2(a[2], a[3]);
                    *(u32x2*)(Kb + row * 256 + (pn - 14) * 128 + wc * 64 + n * 16 + fq * 4) = w; }
            } else if (pn < 20) {
#pragma unroll
                for (int n = 0; n < 4; ++n) { f32x4 a = acc[m][n] * r; u32x2 w; w.x = pk2(a[0], a[1]); w.y = pk2(a[2], a[3]);
                    *(u32x2*)(V + row * 512 + (pn - 16) * 128 + wc * 64 + n * 16 + fq * 4) = w; }
            } else if (pn < 24) {
#pragma unroll
                for (int n = 0; n < 4; ++n) { f32x4 a = acc[m][n] * r; u32x2 w; w.x = pk2(siluf_(a[0]), siluf_(a[1])); w.y = pk2(siluf_(a[2]), siluf_(a[3]));
                    *(u32x2*)(ZG + row * 512 + (pn - 20) * 128 + wc * 64 + n * 16 + fq * 4) = w; }
            } else {
                if (wc == 0) { f32x4 a = acc[m][0] * r; *(f32x4*)(LR + row * 16 + fq * 4) = a; }
            }
        }
    }
};

struct EpiPw {
    const float* bias; const bf16_t* ZC; bf16_t* MIX;
    __device__ __forceinline__ void pre(int, LAS unsigned char*) const {}
    __device__ __forceinline__ void operator()(f32x4 (&acc)[4][4], int row0, int pn, int wr, int wc, int fr, int fq, LAS unsigned char*) const {
#pragma unroll
        for (int n = 0; n < 4; ++n) {
            const int col = pn * 128 + wc * 64 + n * 16 + fq * 4; const f32x4 b = *(const f32x4*)(bias + col);
#pragma unroll
            for (int m = 0; m < 4; ++m) { const size_t row = (size_t)(row0 + wr * 64 + m * 16 + fr);
                const u32x2 z = *(const u32x2*)(ZC + row * 512 + col); f32x4 a = acc[m][n] + b; u32x2 w;
                w.x = pk2(a[0] * bflo(z.x), a[1] * bfhi(z.x)); w.y = pk2(a[2] * bflo(z.y), a[3] * bfhi(z.y));
                *(u32x2*)(MIX + row * 1024 + col) = w; }
        }
    }
};

struct EpiOut {
    const Params* p; int layer; float* XO; bf16_t* XB; float* ssq;
    __device__ __forceinline__ void pre(int, LAS unsigned char*) const {}
    __device__ __forceinline__ void operator()(f32x4 (&acc)[4][4], int row0, int pn, int wr, int wc, int fr, int fq, LAS unsigned char*) const {
#pragma unroll
        for (int m = 0; m < 4; ++m) {
            const int row = row0 + wr * 64 + m * 16 + fr;
            float s = 0.f;
            if (layer == 0) {
                const float* xr = xrow_in(*p, row);
#pragma unroll
                for (int n = 0; n < 4; ++n) { const int col = pn * 128 + wc * 64 + n * 16 + fq * 4;
                    const f32x4 a = acc[m][n] + *(const f32x4*)(xr + col);
                    u32x2 w; w.x = pk2(a[0], a[1]); w.y = pk2(a[2], a[3]); *(u32x2*)(XB + (size_t)row * 1024 + col) = w;
                    const float b0 = bflo(w.x), b1 = bfhi(w.x), b2 = bflo(w.y), b3 = bfhi(w.y);
                    s += (b0 * b0 + b1 * b1) + (b2 * b2 + b3 * b3); }
            } else {
#pragma unroll
                for (int n = 0; n < 4; ++n) { const int col = pn * 128 + wc * 64 + n * 16 + fq * 4;
                    const u32x2 xr = *(const u32x2*)(XB + (size_t)row * 1024 + col);
                    f32x4 a = acc[m][n]; a[0] += bflo(xr.x); a[1] += bfhi(xr.x); a[2] += bflo(xr.y); a[3] += bfhi(xr.y);
                    *(f32x4*)(XO + (size_t)row * 1024 + col) = a;
                    s += (a[0] * a[0] + a[1] * a[1]) + (a[2] * a[2] + a[3] * a[3]); }
            }
            s += __shfl_xor(s, 16); s += __shfl_xor(s, 32);
            if (fq == 0) ssq[(size_t)row * 16 + pn * 2 + wc] = s;
        }
    }
};

__device__ __forceinline__ int inproj_dst_row(int n) {
    if (n < 1024) { const int gl = n >= 512, ch = n & 511; const int T = ch >> 6, wc = (ch >> 5) & 1, f1 = (ch >> 4) & 1, i = ch & 15;
        return T * 128 + wc * 64 + (f1 + 2 * gl) * 16 + i; }
    return n;
}
__device__ void prep_w_tile(const float* W, int ldw, int ncols, const float* g, bf16_t* Wt, int K, int k0, int n0, bool permute, LAS unsigned char* lds) {
    LAS bf16_t* tile = (LAS bf16_t*)lds;
    const int tid = tid_(), c = tid & 63, kq = tid >> 6;
    const int n = n0 + c * 4;
    f32x4 v[8];
#pragma unroll
    for (int i = 0; i < 8; ++i) v[i] = n < ncols ? *(const f32x4*)(W + (size_t)(k0 + kq + 4 * i) * ldw + n) : (f32x4){0.f, 0.f, 0.f, 0.f};
    if (g) {
#pragma unroll
        for (int i = 0; i < 8; ++i) v[i] = v[i] * g[k0 + kq + 4 * i];
    }
#pragma unroll
    for (int i = 0; i < 8; ++i) { u32x2 w; w.x = pk2(v[i][0], v[i][1]); w.y = pk2(v[i][2], v[i][3]); *(LAS u32x2*)(tile + (kq + 4 * i) * 264 + c * 4) = w; }
    __syncthreads();
#pragma unroll
    for (int j = 0; j < 4; ++j) { const int item = tid + j * 256, col = item & 255, ch = item >> 8; const int ns = n0 + col;
        if (ns < ncols) { const int r = permute ? inproj_dst_row(ns) : ns;
            unsigned short e[8];
#pragma unroll
            for (int q = 0; q < 8; ++q) e[q] = tile[(ch * 8 + q) * 264 + col];
            u32x4 w; w.x = e[0] | ((unsigned)e[1] << 16); w.y = e[2] | ((unsigned)e[3] << 16); w.z = e[4] | ((unsigned)e[5] << 16); w.w = e[6] | ((unsigned)e[7] << 16);
            *(u32x4*)(Wt + (size_t)r * K + k0 + ch * 8) = w; } }
    __syncthreads();
}
__device__ __forceinline__ void prep_w_unit(const Params& p, int u, LAS unsigned char* lds) {
    bf16_t* WIN = (bf16_t*)(p.ws + OFF_WIN); bf16_t* WPW = (bf16_t*)(p.ws + OFF_WPW); bf16_t* WOUT = (bf16_t*)(p.ws + OFF_WOUT);
    if (u < 832) { const int l = u / 416, v = u % 416, kt = v / 13, nt = v % 13;
        prep_w_tile(p.w_in + (size_t)l * 1024 * 3088, 3088, 3088, p.norm_g + l * 1024, WIN + (size_t)l * NIN * 1024, 1024, kt * 32, nt * 256, true, lds);
    } else if (u < 896) { const int w = u - 832, l = w / 32, v = w % 32, kt = v / 2, nt = v % 2;
        prep_w_tile(p.w_pw + (size_t)l * 512 * 512, 512, 512, nullptr, WPW + (size_t)l * 512 * 512, 512, kt * 32, nt * 256, false, lds);
    } else if (u < 1152) { const int w = u - 896, l = w / 128, v = w % 128, kt = v / 4, nt = v % 4;
        prep_w_tile(p.w_out + (size_t)l * 1024 * 1024, 1024, 1024, nullptr, WOUT + (size_t)l * 1024 * 1024, 1024, kt * 32, nt * 256, false, lds);
    } else { const int l = u - 1152; u32x4* z = (u32x4*)(WIN + (size_t)l * NIN * 1024 + (size_t)3088 * 1024);
        for (int i = tid_(); i < 112 * 1024 / 8; i += 256) z[i] = (u32x4){0u, 0u, 0u, 0u}; }
}
__device__ void phase_prep(const Params& p, LAS unsigned char* lds) {
    bf16_t* XB = (bf16_t*)(p.ws + OFF_BUFA); float* SSQ = (float*)(p.ws + OFF_SSQ);
    const int nb = gridDim.x, bid = blockIdx.x;
    const int tid0 = tid_(); const int wid = tid0 >> 6, lane = tid0 & 63;
    for (int row = (bid * 4 + wid) * 2; row < NTOK; row += nb * 8) {
        const float* xr0 = xrow_in(p, row); const float* xr1 = xrow_in(p, row + 1);
        f32x4 a[2][4];
#pragma unroll
        for (int i = 0; i < 4; ++i) { a[0][i] = *(const f32x4*)(xr0 + i * 256 + lane * 4); a[1][i] = *(const f32x4*)(xr1 + i * 256 + lane * 4); }
#pragma unroll
        for (int q = 0; q < 2; ++q) { float s = 0.f;
#pragma unroll
            for (int i = 0; i < 4; ++i) { const f32x4 v = a[q][i]; s += (v[0] * v[0] + v[1] * v[1]) + (v[2] * v[2] + v[3] * v[3]);
                u32x2 w; w.x = pk2(v[0], v[1]); w.y = pk2(v[2], v[3]); *(u32x2*)(XB + (size_t)(row + q) * 1024 + i * 256 + lane * 4) = w; }
            s = wave_sum(s);
            if (lane < 16) SSQ[(size_t)(row + q) * 16 + lane] = lane == 0 ? s : 0.f; }
    }
    for (int u = bid; u < 416; u += nb) prep_w_unit(p, u, lds);
    if (bid == nb - 1) prep_w_unit(p, 1152, lds);
}

template <int NT>
__device__ __forceinline__ void compute_bcum(const Params& p, int layer, int h, const float* LR, int row0, LAS float* G, LAS float* LRS) {
    const int tid = tid_(), d = tid & 63, tq = tid >> 6;
    if (tid < NT * 4) *(LAS f32x4*)(LRS + tid * 4) = *(const f32x4*)(LR + (size_t)row0 * 16 + tid * 4);
    float wa[16];
#pragma unroll
    for (int r = 0; r < 16; ++r) wa[r] = p.w_alpha[(size_t)layer * 16 * 256 + r * 256 + h * 64 + d];
    const float ba = p.b_alpha[layer * 256 + h * 64 + d];
    __syncthreads();
    constexpr int PER = NT / 4;
#pragma unroll 4
    for (int i = 0; i < PER; ++i) { const int t = tq * PER + i;
        const LAS f32x4* lp = (const LAS f32x4*)(LRS + t * 16);
        float z = ba;
#pragma unroll
        for (int r4 = 0; r4 < 4; ++r4) { const f32x4 v = lp[r4]; z += v[0] * wa[r4 * 4] + v[1] * wa[r4 * 4 + 1] + v[2] * wa[r4 * 4 + 2] + v[3] * wa[r4 * 4 + 3]; }
        const float ls = fminf(z, 0.f) - __logf(1.0f + __expf(-fabsf(z)));
        G[t * 64 + d] = ls * (1.0f / 16.0f);
    }
    __syncthreads();
    if (tid < 64) { float run = 0.f;
#pragma unroll 8
        for (int t = 0; t < NT; ++t) { run += G[t * 64 + d]; G[t * 64 + d] = run; } }
    __syncthreads();
}

__device__ void conv_unit(const Params& p, int layer, bool sample, int b_or_pair, int tile, int cs, LAS unsigned char* lds) {
    const bf16_t* U = (const bf16_t*)(p.ws + OFF_U); bf16_t* CVG = (bf16_t*)(p.ws + OFF_CVG);
    LAS bf16_t* ub = (LAS bf16_t*)lds;
    const int tid = tid_(), wid = tid >> 6, lane = tid & 63;
    const int t0 = tile * 64;
    if (!sample) {
        for (int c = tid; c < 94 * 16; c += 256) { const int i = c >> 4, cc = c & 15; const int time = t0 - 30 + i;
            u32x4 v = (u32x4){0u, 0u, 0u, 0u};
            if (time >= 0) v = *(const u32x4*)(U + (size_t)(b_or_pair * SEQ + time) * 512 + cs * 128 + cc * 8);
            *(LAS u32x4*)(ub + i * 128 + cc * 8) = v; }
    } else {
        for (int c = tid; c < 76 * 16; c += 256) { const int i = c >> 4, cc = c & 15; const int sq = i >= 38, ii = i - sq * 38; const int s = b_or_pair * 2 + sq;
            u32x4 v;
            if (ii < 30) { const float* src = p.cache_conv + (((size_t)layer * DEC_B + s) * 30 + ii) * 512 + cs * 128 + cc * 8;
                const f32x4 a = __builtin_nontemporal_load((const f32x4*)src), bb = __builtin_nontemporal_load((const f32x4*)(src + 4));
                v.x = pk2(a[0], a[1]); v.y = pk2(a[2], a[3]); v.z = pk2(bb[0], bb[1]); v.w = pk2(bb[2], bb[3]);
                if (ii >= 8) { float* dst = p.out + OUT_CCS + (((size_t)layer * DEC_B + s) * 30 + (ii - 8)) * 512 + cs * 128 + cc * 8;
                    __builtin_nontemporal_store(a, (f32x4*)dst); __builtin_nontemporal_store(bb, (f32x4*)(dst + 4)); }
            } else v = *(const u32x4*)(U + (size_t)(NPROMPT + s * 8 + (ii - 30)) * 512 + cs * 128 + cc * 8);
            *(LAS u32x4*)(ub + i * 128 + cc * 8) = v; }
    }
    __syncthreads();
    const int gi = wid & 1, half = wid >> 1; const int chl = gi * 64 + lane, ch = cs * 128 + chl;
    float w[31];
#pragma unroll
    for (int j = 0; j < 31; ++j) w[j] = p.conv_w[((size_t)layer * 31 + j) * 512 + ch];
    const float cb = p.conv_b[layer * 512 + ch], lg = p.cn_g[layer * 512 + ch], lb = p.cn_b[layer * 512 + ch];
    const int rb = sample ? half * 38 : half * 32;
    const int nsteps = sample ? 2 : 8;
    const size_t grow0 = sample ? (size_t)(NPROMPT + (b_or_pair * 2 + half) * 8) : (size_t)(b_or_pair * SEQ + t0 + half * 32);
    for (int st = 0; st < nsteps; ++st) {
        float vals[34];
#pragma unroll
        for (int i = 0; i < 34; ++i) vals[i] = bf2f(ub[(rb + st * 4 + i) * 128 + chl]);
#pragma unroll
        for (int q = 0; q < 4; ++q) {
            float x = cb;
#pragma unroll
            for (int j = 0; j < 31; ++j) x = fmaf(w[j], vals[q + j], x);
            const float mu = wave_sum(x) * (1.0f / 64.0f); const float dlt = x - mu;
            const float var = wave_sum(dlt * dlt) * (1.0f / 64.0f);
            const float y = dlt * rsqrtf(var + EPS) * lg + lb;
            const float sv = siluf_(y);
            CVG[(grow0 + st * 4 + q) * 512 + ch] = (bf16_t)(pk2(sv, 0.f) & 0xffffu);
        }
    }
    if (!sample) {
        if (tile == 31) { for (int c = tid; c < 30 * 128; c += 256) { const int j = c >> 7, cc = c & 127;
            p.out[OUT_CCP + (((size_t)layer * BATCH + b_or_pair) * 30 + j) * 512 + cs * 128 + cc] = bf2f(ub[(64 + j) * 128 + cc]); } }
    } else {
        for (int c = tid; c < 2 * 8 * 128; c += 256) { const int sq = c >> 10, j = (c >> 7) & 7, cc = c & 127; const int s = b_or_pair * 2 + sq;
            p.out[OUT_CCS + (((size_t)layer * DEC_B + s) * 30 + 22 + j) * 512 + cs * 128 + cc] = bf2f(ub[(sq * 38 + 30 + j) * 128 + cc]); }
    }
    __syncthreads();
}

__device__ void gla_ds_unit(const Params& p, int layer, int unit, LAS unsigned char* lds) {
    const int h = unit & 3, bc = unit >> 2; const int row0 = bc * 64;
    const bf16_t* Kb = (const bf16_t*)(p.ws + OFF_K); const bf16_t* V = (const bf16_t*)(p.ws + OFF_V); const float* LR = (const float*)(p.ws + OFF_LR);
    float* DS = (float*)(p.ws + OFF_DS) + (size_t)unit * 8192; float* DEC = (float*)(p.ws + OFF_DEC) + (size_t)unit * 64;
    LAS float* G = (LAS float*)lds;
    LAS bf16_t* KT = (LAS bf16_t*)(lds + 16384);
    LAS bf16_t* VT = (LAS bf16_t*)(lds + 16384 + 9216);
    const int tid = tid_(), t = tid >> 2, qd = tid & 3;
    const u32x4* src = (const u32x4*)(Kb + (size_t)(row0 + t) * 256 + h * 64 + qd * 16);
    const u32x4* vs = (const u32x4*)(V + (size_t)(row0 + t) * 512 + h * 128 + qd * 32);
    const u32x4 a = src[0], b = src[1]; u32x4 vreg[4];
#pragma unroll
    for (int c = 0; c < 4; ++c) vreg[c] = vs[c];
    compute_bcum<64>(p, layer, h, LR, row0, G, (LAS float*)(lds + 16384 + 9216 + 18432));
    {
        const unsigned wv[8] = {a.x, a.y, a.z, a.w, b.x, b.y, b.z, b.w};
#pragma unroll
        for (int e = 0; e < 8; ++e) { const int d0 = qd * 16 + 2 * e;
            const float f0 = bflo(wv[e]) * __expf(G[63 * 64 + d0] - G[t * 64 + d0]);
            const float f1 = bfhi(wv[e]) * __expf(G[63 * 64 + d0 + 1] - G[t * 64 + d0 + 1]);
            const unsigned pk = pk2(f0, f1);
            KT[d0 * 72 + t] = (bf16_t)(pk & 0xffffu); KT[(d0 + 1) * 72 + t] = (bf16_t)(pk >> 16); }
#pragma unroll
        for (int c = 0; c < 4; ++c) { const u32x4 a2 = vreg[c]; const unsigned w2[4] = {a2.x, a2.y, a2.z, a2.w};
#pragma unroll
            for (int e = 0; e < 4; ++e) { const int dv = qd * 32 + c * 8 + 2 * e;
                VT[dv * 72 + t] = (bf16_t)(w2[e] & 0xffffu); VT[(dv + 1) * 72 + t] = (bf16_t)(w2[e] >> 16); } }
        if (tid < 64) DEC[tid] = __expf(G[63 * 64 + tid]);
    }
    __syncthreads();
    const int wid = tid >> 6, lane = tid & 63, fr = lane & 15, fq = lane >> 4;
    f32x4 acc[2][4];
#pragma unroll
    for (int m = 0; m < 2; ++m)
#pragma unroll
        for (int n = 0; n < 4; ++n) acc[m][n] = (f32x4){0.f, 0.f, 0.f, 0.f};
#pragma unroll
    for (int kk = 0; kk < 2; ++kk) {
        bf16x8 vf[2], kf[4];
#pragma unroll
        for (int m = 0; m < 2; ++m) vf[m] = *(LAS bf16x8*)(VT + (wid * 32 + m * 16 + fr) * 72 + kk * 32 + fq * 8);
#pragma unroll
        for (int n = 0; n < 4; ++n) kf[n] = *(LAS bf16x8*)(KT + (n * 16 + fr) * 72 + kk * 32 + fq * 8);
#pragma unroll
        for (int m = 0; m < 2; ++m)
#pragma unroll
            for (int n = 0; n < 4; ++n) acc[m][n] = __builtin_amdgcn_mfma_f32_16x16x32_bf16(kf[n], vf[m], acc[m][n], 0, 0, 0);
    }
#pragma unroll
    for (int m = 0; m < 2; ++m)
#pragma unroll
        for (int n = 0; n < 4; ++n) *(f32x4*)(DS + (size_t)(wid * 32 + m * 16 + fr) * 64 + n * 16 + fq * 4) = acc[m][n];
    __syncthreads();
}

__device__ void gla_sample_unit(const Params& p, int layer, int unit, LAS unsigned char* lds) {
    const int h = unit & 3, s = unit >> 2; const int row0 = NPROMPT + s * 8;
    const bf16_t* Q = (const bf16_t*)(p.ws + OFF_Q); const bf16_t* Kb = (const bf16_t*)(p.ws + OFF_K); const bf16_t* V = (const bf16_t*)(p.ws + OFF_V);
    const bf16_t* ZG = (const bf16_t*)(p.ws + OFF_ZG); const float* LR = (const float*)(p.ws + OFF_LR); bf16_t* MIX = (bf16_t*)(p.ws + OFF_BUFA);
    const float* S0 = p.state_gla + (((size_t)layer * DEC_B + s) * 4 + h) * 8192;
    float* SN = p.out + OUT_SGS + (((size_t)layer * DEC_B + s) * 4 + h) * 8192;
    LAS float* G = (LAS float*)lds;
    LAS float* QT = G + 512;
    LAS float* KT = QT + 512;
    LAS float* KD = KT + 512;
    LAS float* DCY = KD + 512;
    LAS float* ATT = DCY + 64;
    LAS float* VV = ATT + 64;
    LAS float* OP = VV + 1024;
    LAS float* RED = OP + 2048;
    compute_bcum<8>(p, layer, h, LR, row0, G, (LAS float*)(lds + 32768));
    const int tid = tid_();
#pragma unroll
    for (int i = 0; i < 2; ++i) { const int e = tid + i * 256, t = e >> 6, d = e & 63;
        const float bc = G[t * 64 + d], bl = G[7 * 64 + d];
        const float q = bf2f(Q[(size_t)(row0 + t) * 256 + h * 64 + d]), k = bf2f(Kb[(size_t)(row0 + t) * 256 + h * 64 + d]);
        QT[e] = q * __expf(bc); KT[e] = k * __expf(-bc); KD[e] = k * __expf(bl - bc);
        if (t == 7) DCY[d] = __expf(bl); }
#pragma unroll
    for (int i = 0; i < 4; ++i) { const int e = tid + i * 256, t = e >> 7, v = e & 127; VV[e] = bf2f(V[(size_t)(row0 + t) * 512 + h * 128 + v]); }
    __syncthreads();
    if (tid < 64) { const int t = tid >> 3, s2 = tid & 7; float a = 0.f;
        if (s2 <= t) { for (int d = 0; d < 64; ++d) a += QT[t * 64 + d] * KT[s2 * 64 + d]; }
        ATT[tid] = a; }
    __syncthreads();
    const int vcol = tid & 127, dh = tid >> 7;
    float o[8], v8[8];
#pragma unroll
    for (int t = 0; t < 8; ++t) { o[t] = 0.f; v8[t] = VV[t * 128 + vcol]; }
    float s0r[32];
#pragma unroll
    for (int dd = 0; dd < 32; ++dd) s0r[dd] = __builtin_nontemporal_load(S0 + (dh * 32 + dd) * 128 + vcol);
#pragma unroll
    for (int dd = 0; dd < 32; ++dd) { const int d = dh * 32 + dd; const float s0 = s0r[dd];
        float sn = s0 * DCY[d];
#pragma unroll
        for (int t = 0; t < 8; ++t) { o[t] = fmaf(QT[t * 64 + d], s0, o[t]); sn = fmaf(KD[t * 64 + d], v8[t], sn); }
        __builtin_nontemporal_store(sn, SN + d * 128 + vcol); }
    if (dh == 0) {
#pragma unroll
        for (int t = 0; t < 8; ++t)
#pragma unroll
            for (int s2 = 0; s2 < 8; ++s2) o[t] = fmaf(ATT[t * 8 + s2], v8[s2], o[t]);
    }
#pragma unroll
    for (int t = 0; t < 8; ++t) OP[(dh * 8 + t) * 128 + vcol] = o[t];
    __syncthreads();
    float val[4];
#pragma unroll
    for (int i = 0; i < 4; ++i) { const int t = dh * 4 + i; val[i] = OP[t * 128 + vcol] + OP[(8 + t) * 128 + vcol];
        const float ps = wave_sum(val[i] * val[i]); if ((tid & 63) == 0) RED[t * 4 + ((tid >> 6) & 1)] = ps; }
    __syncthreads();
    const float gg = p.gla_g[layer * 128 + vcol];
#pragma unroll
    for (int i = 0; i < 4; ++i) { const int t = dh * 4 + i; const float ms = (RED[t * 4] + RED[t * 4 + 1]) * (1.0f / 128.0f);
        const float zg = bf2f(ZG[(size_t)(row0 + t) * 512 + h * 128 + vcol]);
        const float r = val[i] * rsqrtf(ms + EPS) * gg * zg;
        MIX[(size_t)(row0 + t) * 1024 + 512 + h * 128 + vcol] = (bf16_t)(pk2(r, 0.f) & 0xffffu); }
    __syncthreads();
}

__device__ void scan_unit(const Params& p, int layer, int unit) {
    typedef float f32x2 __attribute__((ext_vector_type(2)));
    const int part = unit & 15, h = (unit >> 4) & 3, b = unit >> 6;
    const float* DS = (const float*)(p.ws + OFF_DS); const float* DEC = (const float*)(p.ws + OFF_DEC); bf16_t* SB = (bf16_t*)(p.ws + OFF_SB);
    const int e = part * 512 + tid_() * 2; const int dk = e & 63, dv = e >> 6;
    f32x2 S = (f32x2){0.f, 0.f};
#pragma unroll
    for (int i0 = 0; i0 < 32; i0 += 16) {
        f32x2 cur[16], dc[16];
#pragma unroll
        for (int i = 0; i < 16; ++i) { const size_t ug = (size_t)((b * 32 + i0 + i) * 4 + h);
            cur[i] = __builtin_nontemporal_load((const f32x2*)(DS + ug * 8192 + e)); dc[i] = *(const f32x2*)(DEC + ug * 64 + dk); }
#pragma unroll
        for (int i = 0; i < 16; ++i) { const size_t ug = (size_t)((b * 32 + i0 + i) * 4 + h);
            *(unsigned*)(SB + ug * 8192 + e) = pk2(S[0], S[1]);
            S = S * dc[i] + cur[i]; }
    }
    float* o = p.out + OUT_SGP + (((size_t)layer * BATCH + b) * 4 + h) * 8192;
    __builtin_nontemporal_store(S[0], o + dk * 128 + dv); __builtin_nontemporal_store(S[1], o + (dk + 1) * 128 + dv);
}

__device__ void gla_out_unit(const Params& p, int layer, int unit, LAS unsigned char* lds) {
    const int h = unit & 3, bc = unit >> 2; const int row0 = bc * 64;
    const bf16_t* Q = (const bf16_t*)(p.ws + OFF_Q); const bf16_t* Kb = (const bf16_t*)(p.ws + OFF_K); const bf16_t* V = (const bf16_t*)(p.ws + OFF_V);
    const bf16_t* ZG = (const bf16_t*)(p.ws + OFF_ZG); const float* LR = (const float*)(p.ws + OFF_LR); bf16_t* MIX = (bf16_t*)(p.ws + OFF_BUFA);
    const bf16_t* SB = (const bf16_t*)(p.ws + OFF_SB) + (size_t)unit * 8192;
    LAS float* G = (LAS float*)lds;
    LAS bf16_t* QT = (LAS bf16_t*)(lds + 16384);
    LAS bf16_t* KT = (LAS bf16_t*)(lds + 16384 + 9216);
    LAS bf16_t* VT = (LAS bf16_t*)(lds + 16384 + 18432);
    LAS bf16_t* PP = (LAS bf16_t*)(lds + 16384 + 18432 + 18432);
    const int tid = tid_();
    const int t = tid >> 2, qd = tid & 3;
    const u32x4* qs = (const u32x4*)(Q + (size_t)(row0 + t) * 256 + h * 64 + qd * 16);
    const u32x4* ks = (const u32x4*)(Kb + (size_t)(row0 + t) * 256 + h * 64 + qd * 16);
    const u32x4* vs = (const u32x4*)(V + (size_t)(row0 + t) * 512 + h * 128 + qd * 32);
    const u32x4 qa = qs[0], qb = qs[1], ka = ks[0], kb = ks[1]; u32x4 vreg[4], sreg[4];
#pragma unroll
    for (int c = 0; c < 4; ++c) vreg[c] = vs[c];
#pragma unroll
    for (int c = 0; c < 4; ++c) sreg[c] = *(const u32x4*)(SB + (size_t)(tid + c * 256) * 8);
    compute_bcum<64>(p, layer, h, LR, row0, G, (LAS float*)PP);
    {
        const unsigned qw[8] = {qa.x, qa.y, qa.z, qa.w, qb.x, qb.y, qb.z, qb.w}; const unsigned kw[8] = {ka.x, ka.y, ka.z, ka.w, kb.x, kb.y, kb.z, kb.w};
        unsigned qo[8], ko[8];
#pragma unroll
        for (int e = 0; e < 8; ++e) { const int d0 = qd * 16 + 2 * e; const float g0 = G[t * 64 + d0], g1 = G[t * 64 + d0 + 1];
            const float e0 = __expf(g0), e1 = __expf(g1);
            qo[e] = pk2(bflo(qw[e]) * e0, bfhi(qw[e]) * e1);
            ko[e] = pk2(bflo(kw[e]) * __builtin_amdgcn_rcpf(e0), bfhi(kw[e]) * __builtin_amdgcn_rcpf(e1)); }
        *(LAS u32x4*)(QT + t * 72 + qd * 16) = (u32x4){qo[0], qo[1], qo[2], qo[3]}; *(LAS u32x4*)(QT + t * 72 + qd * 16 + 8) = (u32x4){qo[4], qo[5], qo[6], qo[7]};
        *(LAS u32x4*)(KT + t * 72 + qd * 16) = (u32x4){ko[0], ko[1], ko[2], ko[3]}; *(LAS u32x4*)(KT + t * 72 + qd * 16 + 8) = (u32x4){ko[4], ko[5], ko[6], ko[7]};
#pragma unroll
        for (int c = 0; c < 4; ++c) { const u32x4 a2 = vreg[c]; const unsigned w2[4] = {a2.x, a2.y, a2.z, a2.w};
#pragma unroll
            for (int e = 0; e < 4; ++e) { const int dv = qd * 32 + c * 8 + 2 * e;
                VT[dv * 72 + t] = (bf16_t)(w2[e] & 0xffffu); VT[(dv + 1) * 72 + t] = (bf16_t)(w2[e] >> 16); } }
    }
    __syncthreads();
    {
#pragma unroll
        for (int c = 0; c < 4; ++c) { const int ci = tid + c * 256, r = ci >> 3, ch = ci & 7;
            *(LAS u32x4*)(lds + r * 128 + ((ch ^ (r & 7)) * 16)) = sreg[c]; }
    }
    __syncthreads();
    const int wid = tid >> 6, lane = tid & 63, fr = lane & 15, fq = lane >> 4;
    LAS bf16_t* PW = PP + wid * 16 * 72;
    {
        bf16x8 qf[2];
#pragma unroll
        for (int kk = 0; kk < 2; ++kk) qf[kk] = *(LAS bf16x8*)(QT + (wid * 16 + fr) * 72 + kk * 32 + fq * 8);
#pragma unroll
        for (int n = 0; n < 4; ++n) {
            f32x4 a = (f32x4){0.f, 0.f, 0.f, 0.f};
#pragma unroll
            for (int kk = 0; kk < 2; ++kk) { const bf16x8 kf = *(LAS bf16x8*)(KT + (n * 16 + fr) * 72 + kk * 32 + fq * 8);
                a = __builtin_amdgcn_mfma_f32_16x16x32_bf16(kf, qf[kk], a, 0, 0, 0); }
            const int tg = wid * 16 + fr, sg = n * 16 + fq * 4;
            u32x2 w; w.x = pk2(sg <= tg ? a[0] : 0.f, sg + 1 <= tg ? a[1] : 0.f); w.y = pk2(sg + 2 <= tg ? a[2] : 0.f, sg + 3 <= tg ? a[3] : 0.f);
            *(LAS u32x2*)(PW + fr * 72 + n * 16 + fq * 4) = w;
        }
    }
    __builtin_amdgcn_s_waitcnt(0xc07f);
    __builtin_amdgcn_wave_barrier();
    f32x4 acc[8];
#pragma unroll
    for (int n = 0; n < 8; ++n) acc[n] = (f32x4){0.f, 0.f, 0.f, 0.f};
#pragma unroll
    for (int kk = 0; kk < 2; ++kk) {
        const bf16x8 qf = *(LAS bf16x8*)(QT + (wid * 16 + fr) * 72 + kk * 32 + fq * 8);
        const bf16x8 pf = *(LAS bf16x8*)(PW + fr * 72 + kk * 32 + fq * 8);
#pragma unroll
        for (int n = 0; n < 8; ++n) {
            const bf16x8 sf = *(LAS bf16x8*)(lds + (n * 16 + fr) * 128 + (((kk * 4 + fq) ^ (fr & 7)) * 16));
            const bf16x8 vf = *(LAS bf16x8*)(VT + (n * 16 + fr) * 72 + kk * 32 + fq * 8);
            acc[n] = __builtin_amdgcn_mfma_f32_16x16x32_bf16(sf, qf, acc[n], 0, 0, 0);
            acc[n] = __builtin_amdgcn_mfma_f32_16x16x32_bf16(vf, pf, acc[n], 0, 0, 0);
        }
    }
    float ss = 0.f;
#pragma unroll
    for (int n = 0; n < 8; ++n) ss += (acc[n][0] * acc[n][0] + acc[n][1] * acc[n][1]) + (acc[n][2] * acc[n][2] + acc[n][3] * acc[n][3]);
    ss += __shfl_xor(ss, 16); ss += __shfl_xor(ss, 32);
    const float rinv = rsqrtf(ss * (1.0f / 128.0f) + EPS);
    const size_t row = (size_t)(row0 + wid * 16 + fr);
#pragma unroll
    for (int n = 0; n < 8; ++n) { const int dv = n * 16 + fq * 4; const f32x4 gg = *(const f32x4*)(p.gla_g + layer * 128 + dv);
        const u32x2 z = *(const u32x2*)(ZG + row * 512 + h * 128 + dv); u32x2 w;
        w.x = pk2(acc[n][0] * rinv * gg[0] * bflo(z.x), acc[n][1] * rinv * gg[1] * bfhi(z.x));
        w.y = pk2(acc[n][2] * rinv * gg[2] * bflo(z.y), acc[n][3] * rinv * gg[3] * bfhi(z.y));
        *(u32x2*)(MIX + row * 1024 + 512 + h * 128 + dv) = w; }
    __syncthreads();
}


#define XB_TMO      128
#define XB_XCNT(j)  (256  + 64 * (j))
#define XB_XSUB(j)  (1280 + 64 * (j))
#define XB_XGEN(j)  (2304 + 64 * (j))
#define XB_TOP      3328
#define XB_TOPGEN   3392
#define XCD_BAR_WORDS 3456
#define XB_SPIN_CAP (1u << 22)
__device__ __forceinline__ unsigned xb_ld(unsigned* p)              { return __hip_atomic_load(p, __ATOMIC_RELAXED, __HIP_MEMORY_SCOPE_AGENT); }
__device__ __forceinline__ unsigned xb_add(unsigned* p, unsigned v) { return __hip_atomic_fetch_add(p, v, __ATOMIC_RELAXED, __HIP_MEMORY_SCOPE_AGENT); }
__device__ __forceinline__ unsigned xb_xcc_id() { return (unsigned)__builtin_amdgcn_s_getreg((3 << 11) | 20) & 0xFu; }
#define XB_SPIN(cond, bar) do { unsigned _sp = 0; while (cond) { __builtin_amdgcn_s_sleep(1); \
    if ((++_sp & 255u) == 0u) { if (xb_ld(&(bar)[XB_TMO])) break; if (_sp > XB_SPIN_CAP) { atomicAdd(&(bar)[XB_TMO], 1u); break; } } } } while (0)
struct XcdBarrier { unsigned* bar; unsigned x; volatile LAS unsigned* st; };
__device__ __forceinline__ XcdBarrier xcd_barrier_post(unsigned* bar, volatile LAS unsigned* st) {
    XcdBarrier b; b.bar = bar; b.x = xb_xcc_id(); b.st = st;
    if (threadIdx.x == 0) (void)xb_add(&bar[XB_XCNT(b.x)], 1u);
    return b;
}
__device__ __forceinline__ void xcd_barrier_complete(unsigned* bar, unsigned x, unsigned& nloc, unsigned& nx) {
    const unsigned G = gridDim.x * gridDim.y * gridDim.z;
    unsigned sum, cnt, mine, sp = 0u;
    for (;;) {
        sum = 0u; cnt = 0u; mine = 0u;
#pragma unroll
        for (unsigned j = 0; j < 16; ++j) { const unsigned c = xb_ld(&bar[XB_XCNT(j)]); sum += c; cnt += (c > 0u) ? 1u : 0u; mine = (j == x) ? c : mine; }
        if (sum == G) break;
        __builtin_amdgcn_s_sleep(1);
        if ((++sp & 255u) == 0u) { if (xb_ld(&bar[XB_TMO])) break; if (sp > XB_SPIN_CAP) { atomicAdd(&bar[XB_TMO], 1u); break; } }
    }
    nloc = mine > 0u ? mine : 1u; nx = cnt > 0u ? cnt : 1u;
}
__device__ __forceinline__ void xcd_barrier(const XcdBarrier& b) {
    asm volatile("s_waitcnt vmcnt(0)" ::: "memory");
    __syncthreads();
    if (threadIdx.x == 0) {
        unsigned* bar = b.bar;
        __builtin_amdgcn_s_waitcnt(0);
        unsigned nloc = b.st[0], nx = b.st[1];
        if (nloc == 0u) { xcd_barrier_complete(bar, b.x, nloc, nx); b.st[0] = nloc; b.st[1] = nx; }
        const unsigned old = xb_add(&bar[XB_XSUB(b.x)], 1u);
        const unsigned gen = old / nloc;
        if (old + 1u == (gen + 1u) * nloc) {
            __builtin_amdgcn_fence(__ATOMIC_RELEASE, "agent");
            asm volatile("s_waitcnt vmcnt(0)" ::: "memory");
            const unsigned og = xb_add(&bar[XB_TOP], 1u);
            const unsigned tg = og / nx;
            if (og + 1u == (tg + 1u) * nx) xb_add(&bar[XB_TOPGEN], 1u);
            else XB_SPIN(xb_add(&bar[XB_TOPGEN], 0u) == tg, bar);
            __builtin_amdgcn_fence(__ATOMIC_ACQUIRE, "agent");
            xb_add(&bar[XB_XGEN(b.x)], 1u);
            asm volatile("s_waitcnt vmcnt(0)" ::: "memory");
        } else {
            XB_SPIN(xb_ld(&bar[XB_XGEN(b.x)]) == gen, bar);
            __builtin_amdgcn_fence(__ATOMIC_ACQUIRE, "agent");
            asm volatile("s_waitcnt vmcnt(0)" ::: "memory");
        }
    }
    __syncthreads();
}

#ifndef REP_PREP
#define REP_PREP 1
#endif
#ifndef REP_IN
#define REP_IN 1
#endif
#ifndef REP_P2
#define REP_P2 1
#endif
#ifndef REP_P3
#define REP_P3 1
#endif
#ifndef REP_P4
#define REP_P4 1
#endif
#ifndef REP_OUT
#define REP_OUT 1
#endif
#ifndef REP_SYNC
#define REP_SYNC 1
#endif
#ifndef PROBE_MASK
#define PROBE_MASK 0
#endif
#define PROBE_MULT 4
#define TSTAMP() do { if (PROBE_MASK) { if (blockIdx.x == 0 && threadIdx.x == 0) { tsl[tsi] = __builtin_amdgcn_s_memrealtime(); } ++tsi; } } while (0)
#define GSYNC() do { for (int _r = 0; _r < REP_SYNC; ++_r) xcd_barrier(xb); TSTAMP(); } while (0)
__global__ void __launch_bounds__(256, 2) hymba_mega(Params p) {
    __shared__ __attribute__((aligned(16))) unsigned char smem[66560];
    LAS unsigned char* lds = (LAS unsigned char*)smem;
    cg::grid_group grid = cg::this_grid();
    const int nb = gridDim.x, bid = blockIdx.x;
    if (p.ws == nullptr) grid.sync();
    volatile LAS unsigned* xst = (volatile LAS unsigned*)(lds + 66048);
    if (threadIdx.x == 0) { xst[0] = 0u; xst[1] = 0u; }
    __syncthreads();
    XcdBarrier xb = xcd_barrier_post((unsigned*)(p.ws + OFF_BAR), xst);
    volatile LAS unsigned long long* tsl = (volatile LAS unsigned long long*)(lds + 66064); int tsi = 0;
    TSTAMP();
    float* SSQ = (float*)(p.ws + OFF_SSQ);
    bf16_t* BUFA = (bf16_t*)(p.ws + OFF_BUFA); bf16_t* BUFB = (bf16_t*)(p.ws + OFF_BUFB);

    for (int rep = 0; rep < REP_PREP; ++rep) phase_prep(p, lds);
    GSYNC();
#pragma unroll 1
    for (int layer = 0; layer < 2; ++layer) {
        {
            EpiIn e; e.ssq = SSQ; e.U = (bf16_t*)(p.ws + OFF_U); e.ZC = (bf16_t*)(p.ws + OFF_ZC); e.Q = (bf16_t*)(p.ws + OFF_Q); e.Kb = (bf16_t*)(p.ws + OFF_K);
            e.V = (bf16_t*)(p.ws + OFF_V); e.ZG = (bf16_t*)(p.ws + OFF_ZG); e.LR = (float*)(p.ws + OFF_LR);
            const bf16_t* A = layer == 0 ? BUFA : BUFB; const bf16_t* Bt = (const bf16_t*)(p.ws + OFF_WIN) + (size_t)layer * NIN * 1024;
            int pm, pn;
            for (int rep = 0; rep < REP_IN; ++rep)
            for (int it = 0; gemm_next(it, 25, pm, pn); ++it) gemm_unit(A, 1024, Bt, 1024, 1024, pm * 128, pn * 128, lds, e, pn);
        }
        GSYNC();
        for (int rep = 0; rep < REP_P2; ++rep)
        for (int u = bid; u < 2816; u += nb) {
            if (u < 1024) gla_ds_unit(p, layer, u, lds);
            else if (u < 2048) { const int v = u - 1024; conv_unit(p, layer, false, v >> 7, (v >> 2) & 31, v & 3, lds); }
            else if (u < 2304) { const int v = u - 2048; conv_unit(p, layer, true, v >> 2, 0, v & 3, lds); }
            else gla_sample_unit(p, layer, u - 2304, lds);
        }
        if (layer == 0) { for (int u = 416 + bid; u < 1152; u += nb) prep_w_unit(p, u, lds); if (bid == nb - 1) prep_w_unit(p, 1153, lds); }
        GSYNC();
        {
            for (int rep = 0; rep < REP_P3; ++rep) {
            for (int u = bid; u < 512; u += nb) scan_unit(p, layer, u);
            EpiPw e; e.bias = p.b_pw + layer * 512; e.ZC = (const bf16_t*)(p.ws + OFF_ZC); e.MIX = BUFA;
            const bf16_t* A = (const bf16_t*)(p.ws + OFF_CVG); const bf16_t* Bt = (const bf16_t*)(p.ws + OFF_WPW) + (size_t)layer * 512 * 512;
            int pm, pn;
            for (int it = 0; gemm_next(it, 4, pm, pn); ++it) gemm_unit(A, 512, Bt, 512, 512, pm * 128, pn * 128, lds, e, pn); }
        }
        GSYNC();
        for (int rep = 0; rep < REP_P4; ++rep)
        for (int u = bid; u < 1024; u += nb) gla_out_unit(p, layer, u, lds);
        GSYNC();
        {
            EpiOut e; e.p = &p; e.layer = layer; e.XO = p.out + OUT_Y; e.XB = BUFB; e.ssq = SSQ;
            const bf16_t* Bt = (const bf16_t*)(p.ws + OFF_WOUT) + (size_t)layer * 1024 * 1024;
            int pm, pn;
            for (int rep = 0; rep < (layer == 0 ? REP_OUT : 1); ++rep)
            for (int it = 0; gemm_next(it, 8, pm, pn); ++it) gemm_unit(BUFA, 1024, Bt, 1024, 1024, pm * 128, pn * 128, lds, e, pn);
        }
        GSYNC();
    }
    {
        const int tid0 = tid_(); const int wid = tid0 >> 6, lane = tid0 & 63;
        for (int row = bid * 4 + wid; row < NTOK; row += nb * 4) {
            float s = lane < 16 ? SSQ[(size_t)row * 16 + lane] : 0.f; s = wave_sum(s);
            const float r = rsqrtf(s * (1.0f / 1024.0f) + EPS);
            float* xr = p.out + OUT_Y + (size_t)row * 1024;
#pragma unroll
            for (int i = 0; i < 4; ++i) { const int col = i * 256 + lane * 4; f32x4 a = *(const f32x4*)(xr + col); const f32x4 g = *(const f32x4*)(p.final_g + col);
                a = a * r * g; __builtin_nontemporal_store(a, (f32x4*)(xr + col)); }
        }
    }
    if (PROBE_MASK) {
        if (blockIdx.x == 0 && threadIdx.x == 0) {
            const unsigned long long tend = __builtin_amdgcn_s_memrealtime(); tsl[12] = tend;
            unsigned long long d = 0;
            for (int i = 0; i < 12; ++i) if ((PROBE_MASK >> i) & 1) d += tsl[i + 1] - tsl[i];
            while (__builtin_amdgcn_s_memrealtime() - tend < (unsigned long long)PROBE_MULT * d) __builtin_amdgcn_s_sleep(8);
        }
    }
}

extern "C" void kernel_launch(void* const* d_in, const int* in_sizes, int n_in, void* d_out, int out_size, void* d_ws, size_t ws_size, hipStream_t stream) {
    static int grid_blocks = 0;
    if (!grid_blocks) {
        int dev = 0, cus = 0, per_cu = 0;
        (void)hipGetDevice(&dev);
        (void)hipDeviceGetAttribute(&cus, hipDeviceAttributeMultiprocessorCount, dev);
        (void)hipOccupancyMaxActiveBlocksPerMultiprocessor(&per_cu, hymba_mega, 256, 0);
        if (per_cu > 2) per_cu = 2;
        if (per_cu < 1) per_cu = 1;
        grid_blocks = cus * per_cu;
    }
    if (ws_size < WS_NEED) fprintf(stderr, "workspace too small: %zu < %zu\n", ws_size, (size_t)WS_NEED);
    Params p{};
    p.x_prompt = (const float*)d_in[0]; p.x_sample = (const float*)d_in[1]; p.cache_conv = (const float*)d_in[2]; p.state_gla = (const float*)d_in[3];
    p.norm_g = (const float*)d_in[4]; p.w_in = (const float*)d_in[5]; p.w_alpha = (const float*)d_in[6]; p.b_alpha = (const float*)d_in[7];
    p.conv_w = (const float*)d_in[8]; p.conv_b = (const float*)d_in[9]; p.cn_g = (const float*)d_in[10]; p.cn_b = (const float*)d_in[11];
    p.w_pw = (const float*)d_in[12]; p.b_pw = (const float*)d_in[13]; p.gla_g = (const float*)d_in[14]; p.w_out = (const float*)d_in[15]; p.final_g = (const float*)d_in[16];
    p.out = (float*)d_out; p.ws = (unsigned char*)d_ws;
    (void)hipMemsetAsync((unsigned char*)d_ws + OFF_BAR, 0, 16384, stream);
    void* args[] = {&p};
    hipError_t e = hipLaunchCooperativeKernel((void*)hymba_mega, dim3(grid_blocks), dim3(256), args, 0, stream);
    if (e != hipSuccess) fprintf(stderr, "cooperative launch failed: %s (grid %d)\n", hipGetErrorString(e), grid_blocks);
}
```

```cpp
#include <hip/hip_runtime.h>
#include <hip/hip_cooperative_groups.h>
#include <cstdint>
#include <cstdio>
namespace cg = cooperative_groups;

#define LAS __attribute__((address_space(3)))
typedef unsigned short bf16_t;
typedef short bf16x8 __attribute__((ext_vector_type(8)));
typedef float f32x4 __attribute__((ext_vector_type(4)));
typedef unsigned u32x2 __attribute__((ext_vector_type(2)));
typedef unsigned u32x4 __attribute__((ext_vector_type(4)));

constexpr int NTOK = 17408, NPROMPT = 16384;
constexpr int SEQ = 2048, BATCH = 8, DEC_B = 128, DEC_T = 8;
constexpr int NIN = 3200;
constexpr float EPS = 1e-6f;

constexpr size_t OFF_WIN  = 0;
constexpr size_t OFF_WPW  = OFF_WIN  + (size_t)2 * NIN * 1024 * 2;
constexpr size_t OFF_WOUT = OFF_WPW  + (size_t)2 * 512 * 512 * 2;
constexpr size_t OFF_BUFA = OFF_WOUT + (size_t)2 * 1024 * 1024 * 2;
constexpr size_t OFF_BUFB = OFF_BUFA + (size_t)NTOK * 1024 * 2;
constexpr size_t OFF_U    = OFF_BUFB + (size_t)NTOK * 1024 * 2;
constexpr size_t OFF_ZC   = OFF_U    + (size_t)NTOK * 512 * 2;
constexpr size_t OFF_Q    = OFF_ZC   + (size_t)NTOK * 512 * 2;
constexpr size_t OFF_K    = OFF_Q    + (size_t)NTOK * 256 * 2;
constexpr size_t OFF_V    = OFF_K    + (size_t)NTOK * 256 * 2;
constexpr size_t OFF_ZG   = OFF_V    + (size_t)NTOK * 512 * 2;
constexpr size_t OFF_LR   = OFF_ZG   + (size_t)NTOK * 512 * 2;
constexpr size_t OFF_CVG  = OFF_LR   + (size_t)NTOK * 16 * 4;
constexpr size_t OFF_DS   = OFF_CVG  + (size_t)NTOK * 512 * 2;
constexpr size_t OFF_SB   = OFF_DS   + (size_t)1024 * 8192 * 4;
constexpr size_t OFF_DEC  = OFF_SB   + (size_t)1024 * 8192 * 2;
constexpr size_t OFF_SSQ  = OFF_DEC  + (size_t)1024 * 64 * 4;
constexpr size_t OFF_BAR  = OFF_SSQ  + (size_t)NTOK * 16 * 4;
constexpr size_t WS_NEED  = OFF_BAR  + 16384;

constexpr size_t OUT_Y    = 0;
constexpr size_t OUT_CCP  = (size_t)NTOK * 1024;
constexpr size_t OUT_SGP  = OUT_CCP + (size_t)2 * 8 * 30 * 512;
constexpr size_t OUT_CCS  = OUT_SGP + (size_t)2 * 8 * 4 * 64 * 128;
constexpr size_t OUT_SGS  = OUT_CCS + (size_t)2 * 128 * 30 * 512;

struct Params {
    const float *x_prompt, *x_sample, *cache_conv, *state_gla, *norm_g, *w_in, *w_alpha, *b_alpha, *conv_w, *conv_b,
                *cn_g, *cn_b, *w_pw, *b_pw, *gla_g, *w_out, *final_g;
    float* out;
    unsigned char* ws;
};

__device__ __forceinline__ unsigned pk2(float lo, float hi) { unsigned r; asm("v_cvt_pk_bf16_f32 %0, %1, %2" : "=v"(r) : "v"(lo), "v"(hi)); return r; }
__device__ __forceinline__ float bf2f(bf16_t h) { return __uint_as_float(((unsigned)h) << 16); }
__device__ __forceinline__ float bflo(unsigned w) { return __uint_as_float(w << 16); }
__device__ __forceinline__ float bfhi(unsigned w) { return __uint_as_float(w & 0xffff0000u); }
__device__ __forceinline__ float sigmoidf_(float x) { return __builtin_amdgcn_rcpf(1.0f + __expf(-x)); }
__device__ __forceinline__ float siluf_(float x) { return x * sigmoidf_(x); }
__device__ __forceinline__ float wave_sum(float v) {
#pragma unroll
    for (int o = 32; o >= 1; o >>= 1) v += __shfl_xor(v, o);
    return v;
}
__device__ __forceinline__ int tid_() { int t = threadIdx.x; asm volatile("" : "+v"(t)); return t; }
__device__ __forceinline__ const float* xrow_in(const Params& p, int row) {
    return row < NPROMPT ? p.x_prompt + (size_t)row * 1024 : p.x_sample + (size_t)(row - NPROMPT) * 1024;
}

template <class Epi>
__device__ __forceinline__ void gemm_unit(const bf16_t* __restrict__ A, int lda, const bf16_t* __restrict__ Bt, int ldb, int K,
                                          int row0, int brow0, LAS unsigned char* lds, const Epi& epi, int pn) {
    const int tid = tid_(), wid = tid >> 6, lane = tid & 63, wr = wid >> 1, wc = wid & 1, fr = lane & 15, fq = lane >> 4;
    f32x4 acc[4][4];
#pragma unroll
    for (int m = 0; m < 4; ++m)
#pragma unroll
        for (int n = 0; n < 4; ++n) acc[m][n] = (f32x4){0.f, 0.f, 0.f, 0.f};
    const int srow = wid * 32 + (lane >> 3), schunk = (lane & 7) ^ (lane >> 3);
    const bf16_t* ga = A + (size_t)(row0 + srow) * lda + schunk * 8;
    const bf16_t* gb = Bt + (size_t)(brow0 + srow) * ldb + schunk * 8;
    const size_t astep = (size_t)8 * lda, bstep = (size_t)8 * ldb;
    const unsigned sdst = (unsigned)(wid * 4096 + lane * 16);
    const int nt = K >> 6;
    epi.pre(row0, lds);
#define GEMM_STAGE(t, buf) do { _Pragma("unroll") for (int i = 0; i < 4; ++i) { \
        __builtin_amdgcn_global_load_lds((const unsigned*)(ga + i * astep + (t) * 64), (LAS unsigned*)(lds + (buf) * 32768 + sdst + i * 1024), 16, 0, 0); \
        __builtin_amdgcn_global_load_lds((const unsigned*)(gb + i * bstep + (t) * 64), (LAS unsigned*)(lds + (buf) * 32768 + 16384 + sdst + i * 1024), 16, 0, 0); } } while (0)
    const unsigned sw0 = (unsigned)((fq ^ (fr & 7)) * 16), sw1 = (unsigned)(((4 + fq) ^ (fr & 7)) * 16);
    const unsigned arow = (unsigned)((wr * 64 + fr) * 128), brow = (unsigned)(16384 + (wc * 64 + fr) * 128);
    GEMM_STAGE(0, 0);
#pragma unroll 2
    for (int t = 0; t < nt; ++t) {
        asm volatile("s_waitcnt vmcnt(0)" ::: "memory");
        __syncthreads();
        if (t + 1 < nt) GEMM_STAGE(t + 1, (t + 1) & 1);
        LAS unsigned char* sb = lds + (t & 1) * 32768;
#pragma unroll
        for (int kk = 0; kk < 2; ++kk) {
            const unsigned sw = kk ? sw1 : sw0;
            bf16x8 af[4], bfr[4];
#pragma unroll
            for (int m = 0; m < 4; ++m) af[m] = *(LAS bf16x8*)(sb + arow + sw + m * 2048);
#pragma unroll
            for (int n = 0; n < 4; ++n) bfr[n] = *(LAS bf16x8*)(sb + brow + sw + n * 2048);
            __builtin_amdgcn_s_setprio(1);
#pragma unroll
            for (int m = 0; m < 4; ++m)
#pragma unroll
                for (int n = 0; n < 4; ++n) acc[m][n] = __builtin_amdgcn_mfma_f32_16x16x32_bf16(bfr[n], af[m], acc[m][n], 0, 0, 0);
            __builtin_amdgcn_s_setprio(0);
        }
    }
#undef GEMM_STAGE
    epi(acc, row0, pn, wr, wc, fr, fq, lds);
    __syncthreads();
}

__device__ __forceinline__ bool gemm_next(int it, int nN, int& pm, int& pn, int first_unit_offset = 0) {
    const int nb = gridDim.x, bid = blockIdx.x;
    if ((nb & 7) == 0) {
        const int xcd = bid & 7, j = bid >> 3, nj = nb >> 3; const int u = j + it * nj;
        if (u >= 17 * nN) return false;
        pm = xcd + 8 * (u / nN); pn = u % nN; return true;
    } else {
        const int u = bid + it * nb; if (u >= 136 * nN) return false; pm = u / nN; pn = u % nN; return true;
    }
}

struct EpiIn {
    const float* ssq; bf16_t *U, *ZC, *Q, *Kb, *V, *ZG; float* LR;
    __device__ __forceinline__ void pre(int row0, LAS unsigned char* lds) const {
        LAS float* rs = (LAS float*)(lds + 65536);
        const int tid = tid_();
        if (tid < 128) { const f32x4* s = (const f32x4*)(ssq + (size_t)(row0 + tid) * 16); f32x4 a = s[0], b = s[1], c = s[2], d = s[3];
            float t = (a[0] + a[1] + a[2] + a[3]) + (b[0] + b[1] + b[2] + b[3]) + (c[0] + c[1] + c[2] + c[3]) + (d[0] + d[1] + d[2] + d[3]);
            rs[tid] = rsqrtf(t * (1.0f / 1024.0f) + EPS); }
    }
    __device__ __forceinline__ void operator()(f32x4 (&acc)[4][4], int row0, int pn, int wr, int wc, int fr, int fq, LAS unsigned char* lds) const {
        const LAS float* rs = (const LAS float*)(lds + 65536);
#pragma unroll
        for (int m = 0; m < 4; ++m) {
            const int rl = wr * 64 + m * 16 + fr; const size_t row = (size_t)(row0 + rl); const float r = rs[rl];
            if (pn < 8) {
#pragma unroll
                for (int n = 0; n < 2; ++n) { f32x4 a = acc[m][n] * r, g = acc[m][n + 2] * r; u32x2 w;
                    w.x = pk2(a[0] * sigmoidf_(g[0]), a[1] * sigmoidf_(g[1])); w.y = pk2(a[2] * sigmoidf_(g[2]), a[3] * sigmoidf_(g[3]));
                    *(u32x2*)(U + row * 512 + pn * 64 + wc * 32 + n * 16 + fq * 4) = w; }
            } else if (pn < 12) {
#pragma unroll
                for (int n = 0; n < 4; ++n) { f32x4 a = acc[m][n] * r; u32x2 w; w.x = pk2(siluf_(a[0]), siluf_(a[1])); w.y = pk2(siluf_(a[2]), siluf_(a[3]));
                    *(u32x2*)(ZC + row * 512 + (pn - 8) * 128 + wc * 64 + n * 16 + fq * 4) = w; }
            } else if (pn < 14) {
#pragma unroll
                for (int n = 0; n < 4; ++n) { f32x4 a = acc[m][n] * (r * 0.125f); u32x2 w; w.x = pk2(a[0], a[1]); w.y = pk2(a[2], a[3]);
                    *(u32x2*)(Q + row * 256 + (pn - 12) * 128 + wc * 64 + n * 16 + fq * 4) = w; }
            } else if (pn < 16) {
#pragma unroll
                for (int n = 0; n < 4; ++n) { f32x4 a = acc[m][n] * r; u32x2 w; w.x = pk2(a[0], a[1]); w.y = pk2(a[2], a[3]);
                    *(u32x2*)(Kb + row * 256 + (pn - 14) * 128 + wc * 64 + n * 16 + fq * 4) = w; }
            } else if (pn < 20) {
#pragma unroll
                for (int n = 0; n < 4; ++n) { f32x4 a = acc[m][n] * r; u32x2 w; w.x = pk2(a[0], a[1]); w.y = pk2(a[2], a[3]);
                    *(u32x2*)(V + row * 512 + (pn - 16) * 128 + wc * 64 + n * 16 + fq * 4) = w; }
            } else if (pn < 24) {
#pragma unroll
                for (int n = 0; n < 4; ++n) { f32x4 a = acc[m][n] * r; u32x2 w; w.x = pk2(siluf_(a[0]), siluf_(a[1])); w.y = pk2(siluf_(a[2]), siluf_(a[3]));
                    *(u32x2*)(ZG + row * 512 + (pn - 20) * 128 + wc * 64 + n * 16 + fq * 4) = w; }
            } else {
                if (wc == 0) { f32x4 a = acc[m][0] * r; *(f32x4*)(LR + row * 16 + fq * 4) = a; }
            }
        }
    }
};

struct EpiPw {
    const float* bias; const bf16_t* ZC; bf16_t* MIX;
    __device__ __forceinline__ void pre(int, LAS unsigned char*) const {}
    __device__ __forceinline__ void operator()(f32x4 (&acc)[4][4], int row0, int pn, int wr, int wc, int fr, int fq, LAS unsigned char*) const {
#pragma unroll
        for (int n = 0; n < 4; ++n) {
            const int col = pn * 128 + wc * 64 + n * 16 + fq * 4; const f32x4 b = *(const f32x4*)(bias + col);
#pragma unroll
            for (int m = 0; m < 4; ++m) { const size_t row = (size_t)(row0 + wr * 64 + m * 16 + fr);
                const u32x2 z = *(const u32x2*)(ZC + row * 512 + col); f32x4 a = acc[m][n] + b; u32x2 w;
                w.x = pk2(a[0] * bflo(z.x), a[1] * bfhi(z.x)); w.y = pk2(a[2] * bflo(z.y), a[3] * bfhi(z.y));
                *(u32x2*)(MIX + row * 1024 + col) = w; }
        }
    }
};

struct EpiOut {
    const Params* p; int layer; float* XO; bf16_t* XB; float* ssq;
    __device__ __forceinline__ void pre(int, LAS unsigned char*) const {}
    __device__ __forceinline__ void operator()(f32x4 (&acc)[4][4], int row0, int pn, int wr, int wc, int fr, int fq, LAS unsigned char*) const {
#pragma unroll
        for (int m = 0; m < 4; ++m) {
            const int row = row0 + wr * 64 + m * 16 + fr;
            float s = 0.f;
            if (layer == 0) {
                const float* xr = xrow_in(*p, row);
#pragma unroll
                for (int n = 0; n < 4; ++n) { const int col = pn * 128 + wc * 64 + n * 16 + fq * 4;
                    const f32x4 a = acc[m][n] + *(const f32x4*)(xr + col);
                    u32x2 w; w.x = pk2(a[0], a[1]); w.y = pk2(a[2], a[3]); *(u32x2*)(XB + (size_t)row * 1024 + col) = w;
                    const float b0 = bflo(w.x), b1 = bfhi(w.x), b2 = bflo(w.y), b3 = bfhi(w.y);
                    s += (b0 * b0 + b1 * b1) + (b2 * b2 + b3 * b3); }
            } else {
#pragma unroll
                for (int n = 0; n < 4; ++n) { const int col = pn * 128 + wc * 64 + n * 16 + fq * 4;
                    const u32x2 xr = *(const u32x2*)(XB + (size_t)row * 1024 + col);
                    f32x4 a = acc[m][n]; a[0] += bflo(xr.x); a[1] += bfhi(xr.x); a[2] += bflo(xr.y); a[3] += bfhi(xr.y);
                    *(f32x4*)(XO + (size_t)row * 1024 + col) = a;
                    s += (a[0] * a[0] + a[1] * a[1]) + (a[2] * a[2] + a[3] * a[3]); }
            }
            s += __shfl_xor(s, 16); s += __shfl_xor(s, 32);
            if (fq == 0) ssq[(size_t)row * 16 + pn * 2 + wc] = s;
        }
    }
};

__device__ __forceinline__ int inproj_dst_row(int n) {
    if (n < 1024) { const int gl = n >= 512, ch = n & 511; const int T = ch >> 6, wc = (ch >> 5) & 1, f1 = (ch >> 4) & 1, i = ch & 15;
        return T * 128 + wc * 64 + (f1 + 2 * gl) * 16 + i; }
    return n;
}
__device__ void prep_w_tile(const float* W, int ldw, int ncols, const float* g, bf16_t* Wt, int K, int k0, int n0, bool permute, LAS unsigned char* lds) {
    LAS bf16_t* tile = (LAS bf16_t*)lds;
    const int tid = tid_(), c = tid & 63, kq = tid >> 6;
    const int n = n0 + c * 4;
    f32x4 v[8];
#pragma unroll
    for (int i = 0; i < 8; ++i) v[i] = n < ncols ? *(const f32x4*)(W + (size_t)(k0 + kq + 4 * i) * ldw + n) : (f32x4){0.f, 0.f, 0.f, 0.f};
    if (g) {
#pragma unroll
        for (int i = 0; i < 8; ++i) v[i] = v[i] * g[k0 + kq + 4 * i];
    }
#pragma unroll
    for (int i = 0; i < 8; ++i) { u32x2 w; w.x = pk2(v[i][0], v[i][1]); w.y = pk2(v[i][2], v[i][3]); *(LAS u32x2*)(tile + (kq + 4 * i) * 264 + c * 4) = w; }
    __syncthreads();
#pragma unroll
    for (int j = 0; j < 4; ++j) { const int item = tid + j * 256, col = item & 255, ch = item >> 8; const int ns = n0 + col;
        if (ns < ncols) { const int r = permute ? inproj_dst_row(ns) : ns;
            unsigned short e[8];
#pragma unroll
            for (int q = 0; q < 8; ++q) e[q] = tile[(ch * 8 + q) * 264 + col];
            u32x4 w; w.x = e[0] | ((unsigned)e[1] << 16); w.y = e[2] | ((unsigned)e[3] << 16); w.z = e[4] | ((unsigned)e[5] << 16); w.w = e[6] | ((unsigned)e[7] << 16);
            *(u32x4*)(Wt + (size_t)r * K + k0 + ch * 8) = w; } }
    __syncthreads();
}
__device__ __forceinline__ void prep_w_unit(const Params& p, int u, LAS unsigned char* lds) {
    bf16_t* WIN = (bf16_t*)(p.ws + OFF_WIN); bf16_t* WPW = (bf16_t*)(p.ws + OFF_WPW); bf16_t* WOUT = (bf16_t*)(p.ws + OFF_WOUT);
    if (u < 832) { const int l = u / 416, v = u % 416, kt = v / 13, nt = v % 13;
        prep_w_tile(p.w_in + (size_t)l * 1024 * 3088, 3088, 3088, p.norm_g + l * 1024, WIN + (size_t)l * NIN * 1024, 1024, kt * 32, nt * 256, true, lds);
    } else if (u < 896) { const int w = u - 832, l = w / 32, v = w % 32, kt = v / 2, nt = v % 2;
        prep_w_tile(p.w_pw + (size_t)l * 512 * 512, 512, 512, nullptr, WPW + (size_t)l * 512 * 512, 512, kt * 32, nt * 256, false, lds);
    } else if (u < 1152) { const int w = u - 896, l = w / 128, v = w % 128, kt = v / 4, nt = v % 4;
        prep_w_tile(p.w_out + (size_t)l * 1024 * 1024, 1024, 1024, nullptr, WOUT + (size_t)l * 1024 * 1024, 1024, kt * 32, nt * 256, false, lds);
    } else { const int l = u - 1152; u32x4* z = (u32x4*)(WIN + (size_t)l * NIN * 1024 + (size_t)3088 * 1024);
        for (int i = tid_(); i < 112 * 1024 / 8; i += 256) z[i] = (u32x4){0u, 0u, 0u, 0u}; }
}
__device__ void phase_prep(const Params& p, LAS unsigned char* lds) {
    bf16_t* XB = (bf16_t*)(p.ws + OFF_BUFA); float* SSQ = (float*)(p.ws + OFF_SSQ);
    const int nb = gridDim.x, bid = blockIdx.x;
    const int tid0 = tid_(); const int wid = tid0 >> 6, lane = tid0 & 63;
    for (int row = (bid * 4 + wid) * 2; row < NTOK; row += nb * 8) {
        const float* xr0 = xrow_in(p, row); const float* xr1 = xrow_in(p, row + 1);
        f32x4 a[2][4];
#pragma unroll
        for (int i = 0; i < 4; ++i) { a[0][i] = *(const f32x4*)(xr0 + i * 256 + lane * 4); a[1][i] = *(const f32x4*)(xr1 + i * 256 + lane * 4); }
#pragma unroll
        for (int q = 0; q < 2; ++q) { float s = 0.f;
#pragma unroll
            for (int i = 0; i < 4; ++i) { const f32x4 v = a[q][i]; s += (v[0] * v[0] + v[1] * v[1]) + (v[2] * v[2] + v[3] * v[3]);
                u32x2 w; w.x = pk2(v[0], v[1]); w.y = pk2(v[2], v[3]); *(u32x2*)(XB + (size_t)(row + q) * 1024 + i * 256 + lane * 4) = w; }
            s = wave_sum(s);
            if (lane < 16) SSQ[(size_t)(row + q) * 16 + lane] = lane == 0 ? s : 0.f; }
    }
    for (int u = bid; u < 416; u += nb) prep_w_unit(p, u, lds);
    if (bid == nb - 1) prep_w_unit(p, 1152, lds);
}

template <int NT>
__device__ __forceinline__ void compute_bcum(const Params& p, int layer, int h, const float* LR, int row0, LAS float* G, LAS float* LRS) {
    const int tid = tid_(), d = tid & 63, tq = tid >> 6;
    if (tid < NT * 4) *(LAS f32x4*)(LRS + tid * 4) = *(const f32x4*)(LR + (size_t)row0 * 16 + tid * 4);
    float wa[16];
#pragma unroll
    for (int r = 0; r < 16; ++r) wa[r] = p.w_alpha[(size_t)layer * 16 * 256 + r * 256 + h * 64 + d];
    const float ba = p.b_alpha[layer * 256 + h * 64 + d];
    __syncthreads();
    constexpr int PER = NT / 4;
#pragma unroll 4
    for (int i = 0; i < PER; ++i) { const int t = tq * PER + i;
        const LAS f32x4* lp = (const LAS f32x4*)(LRS + t * 16);
        float z = ba;
#pragma unroll
        for (int r4 = 0; r4 < 4; ++r4) { const f32x4 v = lp[r4]; z += v[0] * wa[r4 * 4] + v[1] * wa[r4 * 4 + 1] + v[2] * wa[r4 * 4 + 2] + v[3] * wa[r4 * 4 + 3]; }
        const float ls = fminf(z, 0.f) - __logf(1.0f + __expf(-fabsf(z)));
        G[t * 64 + d] = ls * (1.0f / 16.0f);
    }
    __syncthreads();
    if (tid < 64) { float run = 0.f;
#pragma unroll 8
        for (int t = 0; t < NT; ++t) { run += G[t * 64 + d]; G[t * 64 + d] = run; } }
    __syncthreads();
}

__device__ void conv_unit(const Params& p, int layer, bool sample, int b_or_pair, int tile, int cs, LAS unsigned char* lds) {
    const bf16_t* U = (const bf16_t*)(p.ws + OFF_U); bf16_t* CVG = (bf16_t*)(p.ws + OFF_CVG);
    LAS bf16_t* ub = (LAS bf16_t*)lds;
    const int tid = tid_(), wid = tid >> 6, lane = tid & 63;
    const int t0 = tile * 64;
    if (!sample) {
        for (int c = tid; c < 94 * 16; c += 256) { const int i = c >> 4, cc = c & 15; const int time = t0 - 30 + i;
            u32x4 v = (u32x4){0u, 0u, 0u, 0u};
            if (time >= 0) v = *(const u32x4*)(U + (size_t)(b_or_pair * SEQ + time) * 512 + cs * 128 + cc * 8);
            *(LAS u32x4*)(ub + i * 128 + cc * 8) = v; }
    } else {
        for (int c = tid; c < 76 * 16; c += 256) { const int i = c >> 4, cc = c & 15; const int sq = i >= 38, ii = i - sq * 38; const int s = b_or_pair * 2 + sq;
            u32x4 v;
            if (ii < 30) { const float* src = p.cache_conv + (((size_t)layer * DEC_B + s) * 30 + ii) * 512 + cs * 128 + cc * 8;
                const f32x4 a = __builtin_nontemporal_load((const f32x4*)src), bb = __builtin_nontemporal_load((const f32x4*)(src + 4));
                v.x = pk2(a[0], a[1]); v.y = pk2(a[2], a[3]); v.z = pk2(bb[0], bb[1]); v.w = pk2(bb[2], bb[3]);
                if (ii >= 8) { float* dst = p.out + OUT_CCS + (((size_t)layer * DEC_B + s) * 30 + (ii - 8)) * 512 + cs * 128 + cc * 8;
                    __builtin_nontemporal_store(a, (f32x4*)dst); __builtin_nontemporal_store(bb, (f32x4*)(dst + 4)); }
            } else v = *(const u32x4*)(U + (size_t)(NPROMPT + s * 8 + (ii - 30)) * 512 + cs * 128 + cc * 8);
            *(LAS u32x4*)(ub + i * 128 + cc * 8) = v; }
    }
    __syncthreads();
    const int gi = wid & 1, half = wid >> 1; const int chl = gi * 64 + lane, ch = cs * 128 + chl;
    float w[31];
#pragma unroll
    for (int j = 0; j < 31; ++j) w[j] = p.conv_w[((size_t)layer * 31 + j) * 512 + ch];
    const float cb = p.conv_b[layer * 512 + ch], lg = p.cn_g[layer * 512 + ch], lb = p.cn_b[layer * 512 + ch];
    const int rb = sample ? half * 38 : half * 32;
    const int nsteps = sample ? 2 : 8;
    const size_t grow0 = sample ? (size_t)(NPROMPT + (b_or_pair * 2 + half) * 8) : (size_t)(b_or_pair * SEQ + t0 + half * 32);
    for (int st = 0; st < nsteps; ++st) {
        float vals[34];
#pragma unroll
        for (int i = 0; i < 34; ++i) vals[i] = bf2f(ub[(rb + st * 4 + i) * 128 + chl]);
#pragma unroll
        for (int q = 0; q < 4; ++q) {
            float x = cb;
#pragma unroll
            for (int j = 0; j < 31; ++j) x = fmaf(w[j], vals[q + j], x);
            const float mu = wave_sum(x) * (1.0f / 64.0f); const float dlt = x - mu;
            const float var = wave_sum(dlt * dlt) * (1.0f / 64.0f);
            const float y = dlt * rsqrtf(var + EPS) * lg + lb;
            const float sv = siluf_(y);
            CVG[(grow0 + st * 4 + q) * 512 + ch] = (bf16_t)(pk2(sv, 0.f) & 0xffffu);
        }
    }
    if (!sample) {
        if (tile == 31) { for (int c = tid; c < 30 * 128; c += 256) { const int j = c >> 7, cc = c & 127;
            p.out[OUT_CCP + (((size_t)layer * BATCH + b_or_pair) * 30 + j) * 512 + cs * 128 + cc] = bf2f(ub[(64 + j) * 128 + cc]); } }
    } else {
        for (int c = tid; c < 2 * 8 * 128; c += 256) { const int sq = c >> 10, j = (c >> 7) & 7, cc = c & 127; const int s = b_or_pair * 2 + sq;
            p.out[OUT_CCS + (((size_t)layer * DEC_B + s) * 30 + 22 + j) * 512 + cs * 128 + cc] = bf2f(ub[(sq * 38 + 30 + j) * 128 + cc]); }
    }
    __syncthreads();
}

__device__ void gla_ds_unit(const Params& p, int layer, int unit, LAS unsigned char* lds) {
    const int h = unit & 3, bc = unit >> 2; const int row0 = bc * 64;
    const bf16_t* Kb = (const bf16_t*)(p.ws + OFF_K); const bf16_t* V = (const bf16_t*)(p.ws + OFF_V); const float* LR = (const float*)(p.ws + OFF_LR);
    float* DS = (float*)(p.ws + OFF_DS) + (size_t)unit * 8192; float* DEC = (float*)(p.ws + OFF_DEC) + (size_t)unit * 64;
    LAS float* G = (LAS float*)lds;
    LAS bf16_t* KT = (LAS bf16_t*)(lds + 16384);
    LAS bf16_t* VT = (LAS bf16_t*)(lds + 16384 + 9216);
    const int tid = tid_(), t = tid >> 2, qd = tid & 3;
    const u32x4* src = (const u32x4*)(Kb + (size_t)(row0 + t) * 256 + h * 64 + qd * 16);
    const u32x4* vs = (const u32x4*)(V + (size_t)(row0 + t) * 512 + h * 128 + qd * 32);
    const u32x4 a = src[0], b = src[1]; u32x4 vreg[4];
#pragma unroll
    for (int c = 0; c < 4; ++c) vreg[c] = vs[c];
    compute_bcum<64>(p, layer, h, LR, row0, G, (LAS float*)(lds + 16384 + 9216 + 18432));
    {
        const unsigned wv[8] = {a.x, a.y, a.z, a.w, b.x, b.y, b.z, b.w};
#pragma unroll
        for (int e = 0; e < 8; ++e) { const int d0 = qd * 16 + 2 * e;
            const float f0 = bflo(wv[e]) * __expf(G[63 * 64 + d0] - G[t * 64 + d0]);
            const float f1 = bfhi(wv[e]) * __expf(G[63 * 64 + d0 + 1] - G[t * 64 + d0 + 1]);
            const unsigned pk = pk2(f0, f1);
            KT[d0 * 72 + t] = (bf16_t)(pk & 0xffffu); KT[(d0 + 1) * 72 + t] = (bf16_t)(pk >> 16); }
#pragma unroll
        for (int c = 0; c < 4; ++c) { const u32x4 a2 = vreg[c]; const unsigned w2[4] = {a2.x, a2.y, a2.z, a2.w};
#pragma unroll
            for (int e = 0; e < 4; ++e) { const int dv = qd * 32 + c * 8 + 2 * e;
                VT[dv * 72 + t] = (bf16_t)(w2[e] & 0xffffu); VT[(dv + 1) * 72 + t] = (bf16_t)(w2[e] >> 16); } }
        if (tid < 64) DEC[tid] = __expf(G[63 * 64 + tid]);
    }
    __syncthreads();
    const int wid = tid >> 6, lane = tid & 63, fr = lane & 15, fq = lane >> 4;
    f32x4 acc[2][4];
#pragma unroll
    for (int m = 0; m < 2; ++m)
#pragma unroll
        for (int n = 0; n < 4; ++n) acc[m][n] = (f32x4){0.f, 0.f, 0.f, 0.f};
#pragma unroll
    for (int kk = 0; kk < 2; ++kk) {
        bf16x8 vf[2], kf[4];
#pragma unroll
        for (int m = 0; m < 2; ++m) vf[m] = *(LAS bf16x8*)(VT + (wid * 32 + m * 16 + fr) * 72 + kk * 32 + fq * 8);
#pragma unroll
        for (int n = 0; n < 4; ++n) kf[n] = *(LAS bf16x8*)(KT + (n * 16 + fr) * 72 + kk * 32 + fq * 8);
#pragma unroll
        for (int m = 0; m < 2; ++m)
#pragma unroll
            for (int n = 0; n < 4; ++n) acc[m][n] = __builtin_amdgcn_mfma_f32_16x16x32_bf16(kf[n], vf[m], acc[m][n], 0, 0, 0);
    }
#pragma unroll
    for (int m = 0; m < 2; ++m)
#pragma unroll
        for (int n = 0; n < 4; ++n) *(f32x4*)(DS + (size_t)(wid * 32 + m * 16 + fr) * 64 + n * 16 + fq * 4) = acc[m][n];
    __syncthreads();
}

__device__ void gla_sample_unit(const Params& p, int layer, int unit, LAS unsigned char* lds) {
    const int h = unit & 3, s = unit >> 2; const int row0 = NPROMPT + s * 8;
    const bf16_t* Q = (const bf16_t*)(p.ws + OFF_Q); const bf16_t* Kb = (const bf16_t*)(p.ws + OFF_K); const bf16_t* V = (const bf16_t*)(p.ws + OFF_V);
    const bf16_t* ZG = (const bf16_t*)(p.ws + OFF_ZG); const float* LR = (const float*)(p.ws + OFF_LR); bf16_t* MIX = (bf16_t*)(p.ws + OFF_BUFA);
    const float* S0 = p.state_gla + (((size_t)layer * DEC_B + s) * 4 + h) * 8192;
    float* SN = p.out + OUT_SGS + (((size_t)layer * DEC_B + s) * 4 + h) * 8192;
    LAS float* G = (LAS float*)lds;
    LAS float* QT = G + 512;
    LAS float* KT = QT + 512;
    LAS float* KD = KT + 512;
    LAS float* DCY = KD + 512;
    LAS float* ATT = DCY + 64;
    LAS float* VV = ATT + 64;
    LAS float* OP = VV + 1024;
    LAS float* RED = OP + 2048;
    compute_bcum<8>(p, layer, h, LR, row0, G, (LAS float*)(lds + 32768));
    const int tid = tid_();
#pragma unroll
    for (int i = 0; i < 2; ++i) { const int e = tid + i * 256, t = e >> 6, d = e & 63;
        const float bc = G[t * 64 + d], bl = G[7 * 64 + d];
        const float q = bf2f(Q[(size_t)(row0 + t) * 256 + h * 64 + d]), k = bf2f(Kb[(size_t)(row0 + t) * 256 + h * 64 + d]);
        QT[e] = q * __expf(bc); KT[e] = k * __expf(-bc); KD[e] = k * __expf(bl - bc);
        if (t == 7) DCY[d] = __expf(bl); }
#pragma unroll
    for (int i = 0; i < 4; ++i) { const int e = tid + i * 256, t = e >> 7, v = e & 127; VV[e] = bf2f(V[(size_t)(row0 + t) * 512 + h * 128 + v]); }
    __syncthreads();
    if (tid < 64) { const int t = tid >> 3, s2 = tid & 7; float a = 0.f;
        if (s2 <= t) { for (int d = 0; d < 64; ++d) a += QT[t * 64 + d] * KT[s2 * 64 + d]; }
        ATT[tid] = a; }
    __syncthreads();
    const int vcol = tid & 127, dh = tid >> 7;
    float o[8], v8[8];
#pragma unroll
    for (int t = 0; t < 8; ++t) { o[t] = 0.f; v8[t] = VV[t * 128 + vcol]; }
    float s0r[32];
#pragma unroll
    for (int dd = 0; dd < 32; ++dd) s0r[dd] = __builtin_nontemporal_load(S0 + (dh * 32 + dd) * 128 + vcol);
#pragma unroll
    for (int dd = 0; dd < 32; ++dd) { const int d = dh * 32 + dd; const float s0 = s0r[dd];
        float sn = s0 * DCY[d];
#pragma unroll
        for (int t = 0; t < 8; ++t) { o[t] = fmaf(QT[t * 64 + d], s0, o[t]); sn = fmaf(KD[t * 64 + d], v8[t], sn); }
        __builtin_nontemporal_store(sn, SN + d * 128 + vcol); }
    if (dh == 0) {
#pragma unroll
        for (int t = 0; t < 8; ++t)
#pragma unroll
            for (int s2 = 0; s2 < 8; ++s2) o[t] = fmaf(ATT[t * 8 + s2], v8[s2], o[t]);
    }
#pragma unroll
    for (int t = 0; t < 8; ++t) OP[(dh * 8 + t) * 128 + vcol] = o[t];
    __syncthreads();
    float val[4];
#pragma unroll
    for (int i = 0; i < 4; ++i) { const int t = dh * 4 + i; val[i] = OP[t * 128 + vcol] + OP[(8 + t) * 128 + vcol];
        const float ps = wave_sum(val[i] * val[i]); if ((tid & 63) == 0) RED[t * 4 + ((tid >> 6) & 1)] = ps; }
    __syncthreads();
    const float gg = p.gla_g[layer * 128 + vcol];
#pragma unroll
    for (int i = 0; i < 4; ++i) { const int t = dh * 4 + i; const float ms = (RED[t * 4] + RED[t * 4 + 1]) * (1.0f / 128.0f);
        const float zg = bf2f(ZG[(size_t)(row0 + t) * 512 + h * 128 + vcol]);
        const float r = val[i] * rsqrtf(ms + EPS) * gg * zg;
        MIX[(size_t)(row0 + t) * 1024 + 512 + h * 128 + vcol] = (bf16_t)(pk2(r, 0.f) & 0xffffu); }
    __syncthreads();
}

__device__ void scan_unit(const Params& p, int layer, int unit) {
    typedef float f32x2 __attribute__((ext_vector_type(2)));
    const int part = unit & 15, h = (unit >> 4) & 3, b = unit >> 6;
    const float* DS = (const float*)(p.ws + OFF_DS); const float* DEC = (const float*)(p.ws + OFF_DEC); bf16_t* SB = (bf16_t*)(p.ws + OFF_SB);
    const int e = part * 512 + tid_() * 2; const int dk = e & 63, dv = e >> 6;
    f32x2 S = (f32x2){0.f, 0.f};
#pragma unroll
    for (int i0 = 0; i0 < 32; i0 += 16) {
        f32x2 cur[16], dc[16];
#pragma unroll
        for (int i = 0; i < 16; ++i) { const size_t ug = (size_t)((b * 32 + i0 + i) * 4 + h);
            cur[i] = __builtin_nontemporal_load((const f32x2*)(DS + ug * 8192 + e)); dc[i] = *(const f32x2*)(DEC + ug * 64 + dk); }
#pragma unroll
        for (int i = 0; i < 16; ++i) { const size_t ug = (size_t)((b * 32 + i0 + i) * 4 + h);
            *(unsigned*)(SB + ug * 8192 + e) = pk2(S[0], S[1]);
            S = S * dc[i] + cur[i]; }
    }
    float* o = p.out + OUT_SGP + (((size_t)layer * BATCH + b) * 4 + h) * 8192;
    __builtin_nontemporal_store(S[0], o + dk * 128 + dv); __builtin_nontemporal_store(S[1], o + (dk + 1) * 128 + dv);
}

__device__ void gla_out_unit(const Params& p, int layer, int unit, LAS unsigned char* lds) {
    const int h = unit & 3, bc = unit >> 2; const int row0 = bc * 64;
    const bf16_t* Q = (const bf16_t*)(p.ws + OFF_Q); const bf16_t* Kb = (const bf16_t*)(p.ws + OFF_K); const bf16_t* V = (const bf16_t*)(p.ws + OFF_V);
    const bf16_t* ZG = (const bf16_t*)(p.ws + OFF_ZG); const float* LR = (const float*)(p.ws + OFF_LR); bf16_t* MIX = (bf16_t*)(p.ws + OFF_BUFA);
    const bf16_t* SB = (const bf16_t*)(p.ws + OFF_SB) + (size_t)unit * 8192;
    LAS float* G = (LAS float*)lds;
    LAS bf16_t* QT = (LAS bf16_t*)(lds + 16384);
    LAS bf16_t* KT = (LAS bf16_t*)(lds + 16384 + 9216);
    LAS bf16_t* VT = (LAS bf16_t*)(lds + 16384 + 18432);
    LAS bf16_t* PP = (LAS bf16_t*)(lds + 16384 + 18432 + 18432);
    const int tid = tid_();
    const int t = tid >> 2, qd = tid & 3;
    const u32x4* qs = (const u32x4*)(Q + (size_t)(row0 + t) * 256 + h * 64 + qd * 16);
    const u32x4* ks = (const u32x4*)(Kb + (size_t)(row0 + t) * 256 + h * 64 + qd * 16);
    const u32x4* vs = (const u32x4*)(V + (size_t)(row0 + t) * 512 + h * 128 + qd * 32);
    const u32x4 qa = qs[0], qb = qs[1], ka = ks[0], kb = ks[1]; u32x4 vreg[4], sreg[4];
#pragma unroll
    for (int c = 0; c < 4; ++c) vreg[c] = vs[c];
#pragma unroll
    for (int c = 0; c < 4; ++c) sreg[c] = __builtin_nontemporal_load((const u32x4*)(SB + (size_t)(tid + c * 256) * 8));
    compute_bcum<64>(p, layer, h, LR, row0, G, (LAS float*)PP);
    {
        const unsigned qw[8] = {qa.x, qa.y, qa.z, qa.w, qb.x, qb.y, qb.z, qb.w}; const unsigned kw[8] = {ka.x, ka.y, ka.z, ka.w, kb.x, kb.y, kb.z, kb.w};
        unsigned qo[8], ko[8];
#pragma unroll
        for (int e = 0; e < 8; ++e) { const int d0 = qd * 16 + 2 * e; const float g0 = G[t * 64 + d0], g1 = G[t * 64 + d0 + 1];
            const float e0 = __expf(g0), e1 = __expf(g1);
            qo[e] = pk2(bflo(qw[e]) * e0, bfhi(qw[e]) * e1);
            ko[e] = pk2(bflo(kw[e]) * __builtin_amdgcn_rcpf(e0), bfhi(kw[e]) * __builtin_amdgcn_rcpf(e1)); }
        *(LAS u32x4*)(QT + t * 72 + qd * 16) = (u32x4){qo[0], qo[1], qo[2], qo[3]}; *(LAS u32x4*)(QT + t * 72 + qd * 16 + 8) = (u32x4){qo[4], qo[5], qo[6], qo[7]};
        *(LAS u32x4*)(KT + t * 72 + qd * 16) = (u32x4){ko[0], ko[1], ko[2], ko[3]}; *(LAS u32x4*)(KT + t * 72 + qd * 16 + 8) = (u32x4){ko[4], ko[5], ko[6], ko[7]};
#pragma unroll
        for (int c = 0; c < 4; ++c) { const u32x4 a2 = vreg[c]; const unsigned w2[4] = {a2.x, a2.y, a2.z, a2.w};
#pragma unroll
            for (int e = 0; e < 4; ++e) { const int dv = qd * 32 + c * 8 + 2 * e;
                VT[dv * 72 + t] = (bf16_t)(w2[e] & 0xffffu); VT[(dv + 1) * 72 + t] = (bf16_t)(w2[e] >> 16); } }
    }
    __syncthreads();
    {
#pragma unroll
        for (int c = 0; c < 4; ++c) { const int ci = tid + c * 256, r = ci >> 3, ch = ci & 7;
            *(LAS u32x4*)(lds + r * 128 + ((ch ^ (r & 7)) * 16)) = sreg[c]; }
    }
    __syncthreads();
    const int wid = tid >> 6, lane = tid & 63, fr = lane & 15, fq = lane >> 4;
    LAS bf16_t* PW = PP + wid * 16 * 72;
    {
        bf16x8 qf[2];
#pragma unroll
        for (int kk = 0; kk < 2; ++kk) qf[kk] = *(LAS bf16x8*)(QT + (wid * 16 + fr) * 72 + kk * 32 + fq * 8);
#pragma unroll
        for (int n = 0; n < 4; ++n) {
            f32x4 a = (f32x4){0.f, 0.f, 0.f, 0.f};
#pragma unroll
            for (int kk = 0; kk < 2; ++kk) { const bf16x8 kf = *(LAS bf16x8*)(KT + (n * 16 + fr) * 72 + kk * 32 + fq * 8);
                a = __builtin_amdgcn_mfma_f32_16x16x32_bf16(kf, qf[kk], a, 0, 0, 0); }
            const int tg = wid * 16 + fr, sg = n * 16 + fq * 4;
            u32x2 w; w.x = pk2(sg <= tg ? a[0] : 0.f, sg + 1 <= tg ? a[1] : 0.f); w.y = pk2(sg + 2 <= tg ? a[2] : 0.f, sg + 3 <= tg ? a[3] : 0.f);
            *(LAS u32x2*)(PW + fr * 72 + n * 16 + fq * 4) = w;
        }
    }
    __builtin_amdgcn_s_waitcnt(0xc07f);
    __builtin_amdgcn_wave_barrier();
    f32x4 acc[8];
#pragma unroll
    for (int n = 0; n < 8; ++n) acc[n] = (f32x4){0.f, 0.f, 0.f, 0.f};
#pragma unroll
    for (int kk = 0; kk < 2; ++kk) {
        const bf16x8 qf = *(LAS bf16x8*)(QT + (wid * 16 + fr) * 72 + kk * 32 + fq * 8);
        const bf16x8 pf = *(LAS bf16x8*)(PW + fr * 72 + kk * 32 + fq * 8);
#pragma unroll
        for (int n = 0; n < 8; ++n) {
            const bf16x8 sf = *(LAS bf16x8*)(lds + (n * 16 + fr) * 128 + (((kk * 4 + fq) ^ (fr & 7)) * 16));
            const bf16x8 vf = *(LAS bf16x8*)(VT + (n * 16 + fr) * 72 + kk * 32 + fq * 8);
            acc[n] = __builtin_amdgcn_mfma_f32_16x16x32_bf16(sf, qf, acc[n], 0, 0, 0);
            acc[n] = __builtin_amdgcn_mfma_f32_16x16x32_bf16(vf, pf, acc[n], 0, 0, 0);
        }
    }
    float ss = 0.f;
#pragma unroll
    for (int n = 0; n < 8; ++n) ss += (acc[n][0] * acc[n][0] + acc[n][1] * acc[n][1]) + (acc[n][2] * acc[n][2] + acc[n][3] * acc[n][3]);
    ss += __shfl_xor(ss, 16); ss += __shfl_xor(ss, 32);
    const float rinv = rsqrtf(ss * (1.0f / 128.0f) + EPS);
    const size_t row = (size_t)(row0 + wid * 16 + fr);
#pragma unroll
    for (int n = 0; n < 8; ++n) { const int dv = n * 16 + fq * 4; const f32x4 gg = *(const f32x4*)(p.gla_g + layer * 128 + dv);
        const u32x2 z = *(const u32x2*)(ZG + row * 512 + h * 128 + dv); u32x2 w;
        w.x = pk2(acc[n][0] * rinv * gg[0] * bflo(z.x), acc[n][1] * rinv * gg[1] * bfhi(z.x));
        w.y = pk2(acc[n][2] * rinv * gg[2] * bflo(z.y), acc[n][3] * rinv * gg[3] * bfhi(z.y));
        *(u32x2*)(MIX + row * 1024 + 512 + h * 128 + dv) = w; }
    __syncthreads();
}


#define XB_TMO      128
#define XB_XCNT(j)  (256  + 64 * (j))
#define XB_XSUB(j)  (1280 + 64 * (j))
#define XB_XGEN(j)  (2304 + 64 * (j))
#define XB_TOP      3328
#define XB_TOPGEN   3392
#define XCD_BAR_WORDS 3456
#define XB_SPIN_CAP (1u << 22)
__device__ __forceinline__ unsigned xb_ld(unsigned* p)              { return __hip_atomic_load(p, __ATOMIC_RELAXED, __HIP_MEMORY_SCOPE_AGENT); }
__device__ __forceinline__ unsigned xb_add(unsigned* p, unsigned v) { return __hip_atomic_fetch_add(p, v, __ATOMIC_RELAXED, __HIP_MEMORY_SCOPE_AGENT); }
__device__ __forceinline__ unsigned xb_xcc_id() { return (unsigned)__builtin_amdgcn_s_getreg((3 << 11) | 20) & 0xFu; }
#define XB_SPIN(cond, bar) do { unsigned _sp = 0; while (cond) { __builtin_amdgcn_s_sleep(1); \
    if ((++_sp & 255u) == 0u) { if (xb_ld(&(bar)[XB_TMO])) break; if (_sp > XB_SPIN_CAP) { atomicAdd(&(bar)[XB_TMO], 1u); break; } } } } while (0)
struct XcdBarrier { unsigned* bar; unsigned x; volatile LAS unsigned* st; };
__device__ __forceinline__ XcdBarrier xcd_barrier_post(unsigned* bar, volatile LAS unsigned* st) {
    XcdBarrier b; b.bar = bar; b.x = xb_xcc_id(); b.st = st;
    if (threadIdx.x == 0) (void)xb_add(&bar[XB_XCNT(b.x)], 1u);
    return b;
}
__device__ __forceinline__ void xcd_barrier_complete(unsigned* bar, unsigned x, unsigned& nloc, unsigned& nx) {
    const unsigned G = gridDim.x * gridDim.y * gridDim.z;
    unsigned sum, cnt, mine, sp = 0u;
    for (;;) {
        sum = 0u; cnt = 0u; mine = 0u;
#pragma unroll
        for (unsigned j = 0; j < 16; ++j) { const unsigned c = xb_ld(&bar[XB_XCNT(j)]); sum += c; cnt += (c > 0u) ? 1u : 0u; mine = (j == x) ? c : mine; }
        if (sum == G) break;
        __builtin_amdgcn_s_sleep(1);
        if ((++sp & 255u) == 0u) { if (xb_ld(&bar[XB_TMO])) break; if (sp > XB_SPIN_CAP) { atomicAdd(&bar[XB_TMO], 1u); break; } }
    }
    nloc = mine > 0u ? mine : 1u; nx = cnt > 0u ? cnt : 1u;
}
__device__ __forceinline__ void xcd_barrier(const XcdBarrier& b) {
    asm volatile("s_waitcnt vmcnt(0)" ::: "memory");
    __syncthreads();
    if (threadIdx.x == 0) {
        unsigned* bar = b.bar;
        __builtin_amdgcn_s_waitcnt(0);
        unsigned nloc = b.st[0], nx = b.st[1];
        if (nloc == 0u) { xcd_barrier_complete(bar, b.x, nloc, nx); b.st[0] = nloc; b.st[1] = nx; }
        const unsigned old = xb_add(&bar[XB_XSUB(b.x)], 1u);
        const unsigned gen = old / nloc;
        if (old + 1u == (gen + 1u) * nloc) {
            __builtin_amdgcn_fence(__ATOMIC_RELEASE, "agent");
            asm volatile("s_waitcnt vmcnt(0)" ::: "memory");
            const unsigned og = xb_add(&bar[XB_TOP], 1u);
            const unsigned tg = og / nx;
            if (og + 1u == (tg + 1u) * nx) xb_add(&bar[XB_TOPGEN], 1u);
            else XB_SPIN(xb_add(&bar[XB_TOPGEN], 0u) == tg, bar);
            __builtin_amdgcn_fence(__ATOMIC_ACQUIRE, "agent");
            xb_add(&bar[XB_XGEN(b.x)], 1u);
            asm volatile("s_waitcnt vmcnt(0)" ::: "memory");
        } else {
            XB_SPIN(xb_ld(&bar[XB_XGEN(b.x)]) == gen, bar);
            __builtin_amdgcn_fence(__ATOMIC_ACQUIRE, "agent");
            asm volatile("s_waitcnt vmcnt(0)" ::: "memory");
        }
    }
    __syncthreads();
}

#ifndef REP_PREP
#define REP_PREP 1
#endif
#ifndef REP_IN
#define REP_IN 1
#endif
#ifndef REP_P2
#define REP_P2 1
#endif
#ifndef REP_P3
#define REP_P3 1
#endif
#ifndef REP_P4
#define REP_P4 1
#endif
#ifndef REP_OUT
#define REP_OUT 1
#endif
#ifndef REP_SYNC
#define REP_SYNC 1
#endif
#ifndef PROBE_MASK
#define PROBE_MASK 0
#endif
#define PROBE_MULT 4
#define TSTAMP() do { if (PROBE_MASK) { if (blockIdx.x == 0 && threadIdx.x == 0) { tsl[tsi] = __builtin_amdgcn_s_memrealtime(); } ++tsi; } } while (0)
#define GSYNC() do { for (int _r = 0; _r < REP_SYNC; ++_r) xcd_barrier(xb); TSTAMP(); } while (0)
__global__ void __launch_bounds__(256, 2) hymba_mega(Params p) {
    __shared__ __attribute__((aligned(16))) unsigned char smem[66560];
    LAS unsigned char* lds = (LAS unsigned char*)smem;
    cg::grid_group grid = cg::this_grid();
    const int nb = gridDim.x, bid = blockIdx.x;
    if (p.ws == nullptr) grid.sync();
    volatile LAS unsigned* xst = (volatile LAS unsigned*)(lds + 66048);
    if (threadIdx.x == 0) { xst[0] = 0u; xst[1] = 0u; }
    __syncthreads();
    XcdBarrier xb = xcd_barrier_post((unsigned*)(p.ws + OFF_BAR), xst);
    volatile LAS unsigned long long* tsl = (volatile LAS unsigned long long*)(lds + 66064); int tsi = 0;
    TSTAMP();
    float* SSQ = (float*)(p.ws + OFF_SSQ);
    bf16_t* BUFA = (bf16_t*)(p.ws + OFF_BUFA); bf16_t* BUFB = (bf16_t*)(p.ws + OFF_BUFB);

    for (int rep = 0; rep < REP_PREP; ++rep) phase_prep(p, lds);
    GSYNC();
#pragma unroll 1
    for (int layer = 0; layer < 2; ++layer) {
        {
            EpiIn e; e.ssq = SSQ; e.U = (bf16_t*)(p.ws + OFF_U); e.ZC = (bf16_t*)(p.ws + OFF_ZC); e.Q = (bf16_t*)(p.ws + OFF_Q); e.Kb = (bf16_t*)(p.ws + OFF_K);
            e.V = (bf16_t*)(p.ws + OFF_V); e.ZG = (bf16_t*)(p.ws + OFF_ZG); e.LR = (float*)(p.ws + OFF_LR);
            const bf16_t* A = layer == 0 ? BUFA : BUFB; const bf16_t* Bt = (const bf16_t*)(p.ws + OFF_WIN) + (size_t)layer * NIN * 1024;
            int pm, pn;
            for (int rep = 0; rep < REP_IN; ++rep)
            for (int it = 0; gemm_next(it, 25, pm, pn); ++it) gemm_unit(A, 1024, Bt, 1024, 1024, pm * 128, pn * 128, lds, e, pn);
        }
        GSYNC();
        for (int rep = 0; rep < REP_P2; ++rep)
        for (int u = bid; u < 2816; u += nb) {
            if (u < 1024) gla_ds_unit(p, layer, u, lds);
            else if (u < 2048) { const int v = u - 1024; conv_unit(p, layer, false, v >> 7, (v >> 2) & 31, v & 3, lds); }
            else if (u < 2304) { const int v = u - 2048; conv_unit(p, layer, true, v >> 2, 0, v & 3, lds); }
            else gla_sample_unit(p, layer, u - 2304, lds);
        }
        if (layer == 0) { for (int u = 416 + bid; u < 1152; u += nb) prep_w_unit(p, u, lds); if (bid == nb - 1) prep_w_unit(p, 1153, lds); }
        GSYNC();
        {
            for (int rep = 0; rep < REP_P3; ++rep) {
            for (int u = bid; u < 512; u += nb) scan_unit(p, layer, u);
            EpiPw e; e.bias = p.b_pw + layer * 512; e.ZC = (const bf16_t*)(p.ws + OFF_ZC); e.MIX = BUFA;
            const bf16_t* A = (const bf16_t*)(p.ws + OFF_CVG); const bf16_t* Bt = (const bf16_t*)(p.ws + OFF_WPW) + (size_t)layer * 512 * 512;
            int pm, pn;
            for (int it = 0; gemm_next(it, 4, pm, pn); ++it) gemm_unit(A, 512, Bt, 512, 512, pm * 128, pn * 128, lds, e, pn); }
        }
        GSYNC();
        for (int rep = 0; rep < REP_P4; ++rep)
        for (int u = bid; u < 1024; u += nb) gla_out_unit(p, layer, u, lds);
        GSYNC();
        {
            EpiOut e; e.p = &p; e.layer = layer; e.XO = p.out + OUT_Y; e.XB = BUFB; e.ssq = SSQ;
            const bf16_t* Bt = (const bf16_t*)(p.ws + OFF_WOUT) + (size_t)layer * 1024 * 1024;
            int pm, pn;
            for (int rep = 0; rep < (layer == 0 ? REP_OUT : 1); ++rep)
            for (int it = 0; gemm_next(it, 8, pm, pn); ++it) gemm_unit(BUFA, 1024, Bt, 1024, 1024, pm * 128, pn * 128, lds, e, pn);
        }
        GSYNC();
    }
    {
        const int tid0 = tid_(); const int wid = tid0 >> 6, lane = tid0 & 63;
        for (int row = bid * 4 + wid; row < NTOK; row += nb * 4) {
            float s = lane < 16 ? SSQ[(size_t)row * 16 + lane] : 0.f; s = wave_sum(s);
            const float r = rsqrtf(s * (1.0f / 1024.0f) + EPS);
            float* xr = p.out + OUT_Y + (size_t)row * 1024;
#pragma unroll
            for (int i = 0; i < 4; ++i) { const int col = i * 256 + lane * 4; f32x4 a = *(const f32x4*)(xr + col); const f32x4 g = *(const f32x4*)(p.final_g + col);
                a = a * r * g; __builtin_nontemporal_store(a, (f32x4*)(xr + col)); }
        }
    }
    if (PROBE_MASK) {
        if (blockIdx.x == 0 && threadIdx.x == 0) {
            const unsigned long long tend = __builtin_amdgcn_s_memrealtime(); tsl[12] = tend;
            unsigned long long d = 0;
            for (int i = 0; i < 12; ++i) if ((PROBE_MASK >> i) & 1) d += tsl[i + 1] - tsl[i];
            while (__builtin_amdgcn_s_memrealtime() - tend < (unsigned long long)PROBE_MULT * d) __builtin_amdgcn_s_sleep(8);
        }
    }
}

extern "C" void kernel_launch(void* const* d_in, const int* in_sizes, int n_in, void* d_out, int out_size, void* d_ws, size_t ws_size, hipStream_t stream) {
    static int grid_blocks = 0;
    if (!grid_blocks) {
        int dev = 0, cus = 0, per_cu = 0;
        (void)hipGetDevice(&dev);
        (void)hipDeviceGetAttribute(&cus, hipDeviceAttributeMultiprocessorCount, dev);
        (void)hipOccupancyMaxActiveBlocksPerMultiprocessor(&per_cu, hymba_mega, 256, 0);
        if (per_cu > 2) per_cu = 2;
        if (per_cu < 1) per_cu = 1;
        grid_blocks = cus * per_cu;
    }
    if (ws_size < WS_NEED) fprintf(stderr, "workspace too small: %zu < %zu\n", ws_size, (size_t)WS_NEED);
    Params p{};
    p.x_prompt = (const float*)d_in[0]; p.x_sample = (const float*)d_in[1]; p.cache_conv = (const float*)d_in[2]; p.state_gla = (const float*)d_in[3];
    p.norm_g = (const float*)d_in[4]; p.w_in = (const float*)d_in[5]; p.w_alpha = (const float*)d_in[6]; p.b_alpha = (const float*)d_in[7];
    p.conv_w = (const float*)d_in[8]; p.conv_b = (const float*)d_in[9]; p.cn_g = (const float*)d_in[10]; p.cn_b = (const float*)d_in[11];
    p.w_pw = (const float*)d_in[12]; p.b_pw = (const float*)d_in[13]; p.gla_g = (const float*)d_in[14]; p.w_out = (const float*)d_in[15]; p.final_g = (const float*)d_in[16];
    p.out = (float*)d_out; p.ws = (unsigned char*)d_ws;
    (void)hipMemsetAsync((unsigned char*)d_ws + OFF_BAR, 0, 16384, stream);
    void* args[] = {&p};
    hipError_t e = hipLaunchCooperativeKernel((void*)hymba_mega, dim3(grid_blocks), dim3(256), args, 0, stream);
    if (e != hipSuccess) fprintf(stderr, "cooperative launch failed: %s (grid %d)\n", hipGetErrorString(e), grid_blocks);
}
```

```cpp
#include <hip/hip_runtime.h>
#include <hip/hip_cooperative_groups.h>
#include <cstdint>
#include <cstdio>
namespace cg = cooperative_groups;

#define LAS __attribute__((address_space(3)))
typedef unsigned short bf16_t;
typedef short bf16x8 __attribute__((ext_vector_type(8)));
typedef float f32x4 __attribute__((ext_vector_type(4)));
typedef unsigned u32x2 __attribute__((ext_vector_type(2)));
typedef unsigned u32x4 __attribute__((ext_vector_type(4)));

constexpr int NTOK = 17408, NPROMPT = 16384;
constexpr int SEQ = 2048, BATCH = 8, DEC_B = 128, DEC_T = 8;
constexpr int NIN = 3200;
constexpr float EPS = 1e-6f;

constexpr size_t OFF_WIN  = 0;
constexpr size_t OFF_WPW  = OFF_WIN  + (size_t)2 * NIN * 1024 * 2;
constexpr size_t OFF_WOUT = OFF_WPW  + (size_t)2 * 512 * 512 * 2;
constexpr size_t OFF_BUFA = OFF_WOUT + (size_t)2 * 1024 * 1024 * 2;
constexpr size_t OFF_BUFB = OFF_BUFA + (size_t)NTOK * 1024 * 2;
constexpr size_t OFF_U    = OFF_BUFB + (size_t)NTOK * 1024 * 2;
constexpr size_t OFF_ZC   = OFF_U    + (size_t)NTOK * 512 * 2;
constexpr size_t OFF_Q    = OFF_ZC   + (size_t)NTOK * 512 * 2;
constexpr size_t OFF_K    = OFF_Q    + (size_t)NTOK * 256 * 2;
constexpr size_t OFF_V    = OFF_K    + (size_t)NTOK * 256 * 2;
constexpr size_t OFF_ZG   = OFF_V    + (size_t)NTOK * 512 * 2;
constexpr size_t OFF_LR   = OFF_ZG   + (size_t)NTOK * 512 * 2;
constexpr size_t OFF_CVG  = OFF_LR   + (size_t)NTOK * 16 * 4;
constexpr size_t OFF_DS   = OFF_CVG  + (size_t)NTOK * 512 * 2;
constexpr size_t OFF_SB   = OFF_DS   + (size_t)1024 * 8192 * 4;
constexpr size_t OFF_DEC  = OFF_SB   + (size_t)1024 * 8192 * 2;
constexpr size_t OFF_SSQ  = OFF_DEC  + (size_t)1024 * 64 * 4;
constexpr size_t OFF_BAR  = OFF_SSQ  + (size_t)NTOK * 16 * 4;
constexpr size_t WS_NEED  = OFF_BAR  + 16384;

constexpr size_t OUT_Y    = 0;
constexpr size_t OUT_CCP  = (size_t)NTOK * 1024;
constexpr size_t OUT_SGP  = OUT_CCP + (size_t)2 * 8 * 30 * 512;
constexpr size_t OUT_CCS  = OUT_SGP + (size_t)2 * 8 * 4 * 64 * 128;
constexpr size_t OUT_SGS  = OUT_CCS + (size_t)2 * 128 * 30 * 512;

struct Params {
    const float *x_prompt, *x_sample, *cache_conv, *state_gla, *norm_g, *w_in, *w_alpha, *b_alpha, *conv_w, *conv_b,
                *cn_g, *cn_b, *w_pw, *b_pw, *gla_g, *w_out, *final_g;
    float* out;
    unsigned char* ws;
};

__device__ __forceinline__ unsigned pk2(float lo, float hi) { unsigned r; asm("v_cvt_pk_bf16_f32 %0, %1, %2" : "=v"(r) : "v"(lo), "v"(hi)); return r; }
__device__ __forceinline__ float bf2f(bf16_t h) { return __uint_as_float(((unsigned)h) << 16); }
__device__ __forceinline__ float bflo(unsigned w) { return __uint_as_float(w << 16); }
__device__ __forceinline__ float bfhi(unsigned w) { return __uint_as_float(w & 0xffff0000u); }
__device__ __forceinline__ float sigmoidf_(float x) { return __builtin_amdgcn_rcpf(1.0f + __expf(-x)); }
__device__ __forceinline__ float siluf_(float x) { return x * sigmoidf_(x); }
__device__ __forceinline__ float wave_sum(float v) {
#pragma unroll
    for (int o = 32; o >= 1; o >>= 1) v += __shfl_xor(v, o);
    return v;
}
__device__ __forceinline__ int tid_() { int t = threadIdx.x; asm volatile("" : "+v"(t)); return t; }
__device__ __forceinline__ const float* xrow_in(const Params& p, int row) {
    return row < NPROMPT ? p.x_prompt + (size_t)row * 1024 : p.x_sample + (size_t)(row - NPROMPT) * 1024;
}

template <class Epi>
__device__ __forceinline__ void gemm_unit(const bf16_t* __restrict__ A, int lda, const bf16_t* __restrict__ Bt, int ldb, int K,
                                          int row0, int brow0, LAS unsigned char* lds, const Epi& epi, int pn) {
    const int tid = tid_(), wid = tid >> 6, lane = tid & 63, wr = wid >> 1, wc = wid & 1, fr = lane & 15, fq = lane >> 4;
    f32x4 acc[4][4];
#pragma unroll
    for (int m = 0; m < 4; ++m)
#pragma unroll
        for (int n = 0; n < 4; ++n) acc[m][n] = (f32x4){0.f, 0.f, 0.f, 0.f};
    const int srow = wid * 32 + (lane >> 3), schunk = (lane & 7) ^ (lane >> 3);
    const bf16_t* ga = A + (size_t)(row0 + srow) * lda + schunk * 8;
    const bf16_t* gb = Bt + (size_t)(brow0 + srow) * ldb + schunk * 8;
    const size_t astep = (size_t)8 * lda, bstep = (size_t)8 * ldb;
    const unsigned sdst = (unsigned)(wid * 4096 + lane * 16);
    const int nt = K >> 6;
    epi.pre(row0, lds);
#define GEMM_STAGE(t, buf) do { _Pragma("unroll") for (int i = 0; i < 4; ++i) { \
        __builtin_amdgcn_global_load_lds((const unsigned*)(ga + i * astep + (t) * 64), (LAS unsigned*)(lds + (buf) * 32768 + sdst + i * 1024), 16, 0, 0); \
        __builtin_amdgcn_global_load_lds((const unsigned*)(gb + i * bstep + (t) * 64), (LAS unsigned*)(lds + (buf) * 32768 + 16384 + sdst + i * 1024), 16, 0, 0); } } while (0)
    const unsigned sw0 = (unsigned)((fq ^ (fr & 7)) * 16), sw1 = (unsigned)(((4 + fq) ^ (fr & 7)) * 16);
    const unsigned arow = (unsigned)((wr * 64 + fr) * 128), brow = (unsigned)(16384 + (wc * 64 + fr) * 128);
    GEMM_STAGE(0, 0);
#pragma unroll 2
    for (int t = 0; t < nt; ++t) {
        asm volatile("s_waitcnt vmcnt(0)" ::: "memory");
        __syncthreads();
        if (t + 1 < nt) GEMM_STAGE(t + 1, (t + 1) & 1);
        LAS unsigned char* sb = lds + (t & 1) * 32768;
#pragma unroll
        for (int kk = 0; kk < 2; ++kk) {
            const unsigned sw = kk ? sw1 : sw0;
            bf16x8 af[4], bfr[4];
#pragma unroll
            for (int m = 0; m < 4; ++m) af[m] = *(LAS bf16x8*)(sb + arow + sw + m * 2048);
#pragma unroll
            for (int n = 0; n < 4; ++n) bfr[n] = *(LAS bf16x8*)(sb + brow + sw + n * 2048);
            __builtin_amdgcn_s_setprio(1);
#pragma unroll
            for (int m = 0; m < 4; ++m)
#pragma unroll
                for (int n = 0; n < 4; ++n) acc[m][n] = __builtin_amdgcn_mfma_f32_16x16x32_bf16(bfr[n], af[m], acc[m][n], 0, 0, 0);
            __builtin_amdgcn_s_setprio(0);
        }
    }
#undef GEMM_STAGE
    epi(acc, row0, pn, wr, wc, fr, fq, lds);
    __syncthreads();
}

__device__ __forceinline__ bool gemm_next(int it, int nN, int& pm, int& pn, int first_unit_offset = 0) {
    const int nb = gridDim.x, bid = blockIdx.x;
    if ((nb & 7) == 0) {
        const int xcd = bid & 7, j = bid >> 3, nj = nb >> 3; const int u = j + it * nj;
        if (u >= 17 * nN) return false;
        pm = xcd + 8 * (u / nN); pn = u % nN; return true;
    } else {
        const int u = bid + it * nb; if (u >= 136 * nN) return false; pm = u / nN; pn = u % nN; return true;
    }
}

struct EpiIn {
    const float* ssq; bf16_t *U, *ZC, *Q, *Kb, *V, *ZG; float* LR;
    __device__ __forceinline__ void pre(int row0, LAS unsigned char* lds) const {
        LAS float* rs = (LAS float*)(lds + 65536);
        const int tid = tid_();
        if (tid < 128) { const f32x4* s = (const f32x4*)(ssq + (size_t)(row0 + tid) * 16); f32x4 a = s[0], b = s[1], c = s[2], d = s[3];
            float t = (a[0] + a[1] + a[2] + a[3]) + (b[0] + b[1] + b[2] + b[3]) + (c[0] + c[1] + c[2] + c[3]) + (d[0] + d[1] + d[2] + d[3]);
            rs[tid] = rsqrtf(t * (1.0f / 1024.0f) + EPS); }
    }
    __device__ __forceinline__ void operator()(f32x4 (&acc)[4][4], int row0, int pn, int wr, int wc, int fr, int fq, LAS unsigned char* lds) const {
        const LAS float* rs = (const LAS float*)(lds + 65536);
#pragma unroll
        for (int m = 0; m < 4; ++m) {
            const int rl = wr * 64 + m * 16 + fr; const size_t row = (size_t)(row0 + rl); const float r = rs[rl];
            if (pn < 8) {
#pragma unroll
                for (int n = 0; n < 2; ++n) { f32x4 a = acc[m][n] * r, g = acc[m][n + 2] * r; u32x2 w;
                    w.x = pk2(a[0] * sigmoidf_(g[0]), a[1] * sigmoidf_(g[1])); w.y = pk2(a[2] * sigmoidf_(g[2]), a[3] * sigmoidf_(g[3]));
                    *(u32x2*)(U + row * 512 + pn * 64 + wc * 32 + n * 16 + fq * 4) = w; }
            } else if (pn < 12) {
#pragma unroll
                for (int n = 0; n < 4; ++n) { f32x4 a = acc[m][n] * r; u32x2 w; w.x = pk2(siluf_(a[0]), siluf_(a[1])); w.y = pk2(siluf_(a[2]), siluf_(a[3]));
                    *(u32x2*)(ZC + row * 512 + (pn - 8) * 128 + wc * 64 + n * 16 + fq * 4) = w; }
            } else if (pn < 14) {
#pragma unroll
                for (int n = 0; n < 4; ++n) { f32x4 a = acc[m][n] * (r * 0.125f); u32x2 w; w.x = pk2(a[0], a[1]); w.y = pk2(a[2], a[3]);
                    *(u32x2*)(Q + row * 256 + (pn - 12) * 128 + wc * 64 + n * 16 + fq * 4) = w; }
            } else if (pn < 16) {
#pragma unroll
                for (int n = 0; n < 4; ++n) { f32x4 a = acc[m][n] * r; u32x2 w; w.x = pk2(a[0], a[1]); w.y = pk2(a[2], a[3]);
                    *(u32x2*)(Kb + row * 256 + (pn - 14) * 128 + wc * 64 + n * 16 + fq * 4) = w; }
            } else if (pn < 20) {
#pragma unroll
                for (int n = 0; n < 4; ++n) { f32x4 a = acc[m][n] * r; u32x2 w; w.x = pk2(a[0], a[1]); w.y = pk2(a[2], a[3]);
                    *(u32x2*)(V + row * 512 + (pn - 16) * 128 + wc * 64 + n * 16 + fq * 4) = w; }
            } else if (pn < 24) {
#pragma unroll
                for (int n = 0; n < 4; ++n) { f32x4 a = acc[m][n] * r; u32x2 w; w.x = pk2(siluf_(a[0]), siluf_(a[1])); w.y = pk2(siluf_(a[2]), siluf_(a[3]));
                    *(u32x2*)(ZG + row * 512 + (pn - 20) * 128 + wc * 64 + n * 16 + fq * 4) = w; }
            } else {
                if (wc == 0) { f32x4 a = acc[m][0] * r; *(f32x4*)(LR + row * 16 + fq * 4) = a; }
            }
        }
    }
};

struct EpiPw {
    const float* bias; const bf16_t* ZC; bf16_t* MIX;
    __device__ __forceinline__ void pre(int, LAS unsigned char*) const {}
    __device__ __forceinline__ void operator()(f32x4 (&acc)[4][4], int row0, int pn, int wr, int wc, int fr, int fq, LAS unsigned char*) const {
#pragma unroll
        for (int n = 0; n < 4; ++n) {
            const int col = pn * 128 + wc * 64 + n * 16 + fq * 4; const f32x4 b = *(const f32x4*)(bias + col);
#pragma unroll
            for (int m = 0; m < 4; ++m) { const size_t row = (size_t)(row0 + wr * 64 + m * 16 + fr);
                const u32x2 z = *(const u32x2*)(ZC + row * 512 + col); f32x4 a = acc[m][n] + b; u32x2 w;
                w.x = pk2(a[0] * bflo(z.x), a[1] * bfhi(z.x)); w.y = pk2(a[2] * bflo(z.y), a[3] * bfhi(z.y));
                *(u32x2*)(MIX + row * 1024 + col) = w; }
        }
    }
};

struct EpiOut {
    const Params* p; int layer; float* XO; bf16_t* XB; float* ssq;
    __device__ __forceinline__ void pre(int, LAS unsigned char*) const {}
    __device__ __forceinline__ void operator()(f32x4 (&acc)[4][4], int row0, int pn, int wr, int wc, int fr, int fq, LAS unsigned char*) const {
#pragma unroll
        for (int m = 0; m < 4; ++m) {
            const int row = row0 + wr * 64 + m * 16 + fr;
            float s = 0.f;
            if (layer == 0) {
                const float* xr = xrow_in(*p, row);
#pragma unroll
                for (int n = 0; n < 4; ++n) { const int col = pn * 128 + wc * 64 + n * 16 + fq * 4;
                    const f32x4 a = acc[m][n] + __builtin_nontemporal_load((const f32x4*)(xr + col));
                    u32x2 w; w.x = pk2(a[0], a[1]); w.y = pk2(a[2], a[3]); *(u32x2*)(XB + (size_t)row * 1024 + col) = w;
                    const float b0 = bflo(w.x), b1 = bfhi(w.x), b2 = bflo(w.y), b3 = bfhi(w.y);
                    s += (b0 * b0 + b1 * b1) + (b2 * b2 + b3 * b3); }
            } else {
#pragma unroll
                for (int n = 0; n < 4; ++n) { const int col = pn * 128 + wc * 64 + n * 16 + fq * 4;
                    const u32x2 xr = *(const u32x2*)(XB + (size_t)row * 1024 + col);
                    f32x4 a = acc[m][n]; a[0] += bflo(xr.x); a[1] += bfhi(xr.x); a[2] += bflo(xr.y); a[3] += bfhi(xr.y);
                    *(f32x4*)(XO + (size_t)row * 1024 + col) = a;
                    s += (a[0] * a[0] + a[1] * a[1]) + (a[2] * a[2] + a[3] * a[3]); }
            }
            s += __shfl_xor(s, 16); s += __shfl_xor(s, 32);
            if (fq == 0) ssq[(size_t)row * 16 + pn * 2 + wc] = s;
        }
    }
};

__device__ __forceinline__ int inproj_dst_row(int n) {
    if (n < 1024) { const int gl = n >= 512, ch = n & 511; const int T = ch >> 6, wc = (ch >> 5) & 1, f1 = (ch >> 4) & 1, i = ch & 15;
        return T * 128 + wc * 64 + (f1 + 2 * gl) * 16 + i; }
    return n;
}
__device__ void prep_w_tile(const float* W, int ldw, int ncols, const float* g, bf16_t* Wt, int K, int k0, int n0, bool permute, LAS unsigned char* lds) {
    LAS bf16_t* tile = (LAS bf16_t*)lds;
    const int tid = tid_(), c = tid & 63, kq = tid >> 6;
    const int n = n0 + c * 4;
    f32x4 v[8];
#pragma unroll
    for (int i = 0; i < 8; ++i) v[i] = n < ncols ? __builtin_nontemporal_load((const f32x4*)(W + (size_t)(k0 + kq + 4 * i) * ldw + n)) : (f32x4){0.f, 0.f, 0.f, 0.f};
    if (g) {
#pragma unroll
        for (int i = 0; i < 8; ++i) v[i] = v[i] * g[k0 + kq + 4 * i];
    }
#pragma unroll
    for (int i = 0; i < 8; ++i) { u32x2 w; w.x = pk2(v[i][0], v[i][1]); w.y = pk2(v[i][2], v[i][3]); *(LAS u32x2*)(tile + (kq + 4 * i) * 264 + c * 4) = w; }
    __syncthreads();
#pragma unroll
    for (int j = 0; j < 4; ++j) { const int item = tid + j * 256, col = item & 255, ch = item >> 8; const int ns = n0 + col;
        if (ns < ncols) { const int r = permute ? inproj_dst_row(ns) : ns;
            unsigned short e[8];
#pragma unroll
            for (int q = 0; q < 8; ++q) e[q] = tile[(ch * 8 + q) * 264 + col];
            u32x4 w; w.x = e[0] | ((unsigned)e[1] << 16); w.y = e[2] | ((unsigned)e[3] << 16); w.z = e[4] | ((unsigned)e[5] << 16); w.w = e[6] | ((unsigned)e[7] << 16);
            *(u32x4*)(Wt + (size_t)r * K + k0 + ch * 8) = w; } }
    __syncthreads();
}
__device__ __forceinline__ void prep_w_unit(const Params& p, int u, LAS unsigned char* lds) {
    bf16_t* WIN = (bf16_t*)(p.ws + OFF_WIN); bf16_t* WPW = (bf16_t*)(p.ws + OFF_WPW); bf16_t* WOUT = (bf16_t*)(p.ws + OFF_WOUT);
    if (u < 832) { const int l = u / 416, v = u % 416, kt = v / 13, nt = v % 13;
        prep_w_tile(p.w_in + (size_t)l * 1024 * 3088, 3088, 3088, p.norm_g + l * 1024, WIN + (size_t)l * NIN * 1024, 1024, kt * 32, nt * 256, true, lds);
    } else if (u < 896) { const int w = u - 832, l = w / 32, v = w % 32, kt = v / 2, nt = v % 2;
        prep_w_tile(p.w_pw + (size_t)l * 512 * 512, 512, 512, nullptr, WPW + (size_t)l * 512 * 512, 512, kt * 32, nt * 256, false, lds);
    } else if (u < 1152) { const int w = u - 896, l = w / 128, v = w % 128, kt = v / 4, nt = v % 4;
        prep_w_tile(p.w_out + (size_t)l * 1024 * 1024, 1024, 1024, nullptr, WOUT + (size_t)l * 1024 * 1024, 1024, kt * 32, nt * 256, false, lds);
    } else { const int l = u - 1152; u32x4* z = (u32x4*)(WIN + (size_t)l * NIN * 1024 + (size_t)3088 * 1024);
        for (int i = tid_(); i < 112 * 1024 / 8; i += 256) z[i] = (u32x4){0u, 0u, 0u, 0u}; }
}
__device__ void phase_prep(const Params& p, LAS unsigned char* lds) {
    bf16_t* XB = (bf16_t*)(p.ws + OFF_BUFA); float* SSQ = (float*)(p.ws + OFF_SSQ);
    const int nb = gridDim.x, bid = blockIdx.x;
    const int tid0 = tid_(); const int wid = tid0 >> 6, lane = tid0 & 63;
    for (int row = (bid * 4 + wid) * 2; row < NTOK; row += nb * 8) {
        const float* xr0 = xrow_in(p, row); const float* xr1 = xrow_in(p, row + 1);
        f32x4 a[2][4];
#pragma unroll
        for (int i = 0; i < 4; ++i) { a[0][i] = __builtin_nontemporal_load((const f32x4*)(xr0 + i * 256 + lane * 4)); a[1][i] = __builtin_nontemporal_load((const f32x4*)(xr1 + i * 256 + lane * 4)); }
#pragma unroll
        for (int q = 0; q < 2; ++q) { float s = 0.f;
#pragma unroll
            for (int i = 0; i < 4; ++i) { const f32x4 v = a[q][i]; s += (v[0] * v[0] + v[1] * v[1]) + (v[2] * v[2] + v[3] * v[3]);
                u32x2 w; w.x = pk2(v[0], v[1]); w.y = pk2(v[2], v[3]); *(u32x2*)(XB + (size_t)(row + q) * 1024 + i * 256 + lane * 4) = w; }
            s = wave_sum(s);
            if (lane < 16) SSQ[(size_t)(row + q) * 16 + lane] = lane == 0 ? s : 0.f; }
    }
    for (int u = bid; u < 416; u += nb) prep_w_unit(p, u, lds);
    if (bid == nb - 1) prep_w_unit(p, 1152, lds);
}

template <int NT>
__device__ __forceinline__ void compute_bcum(const Params& p, int layer, int h, const float* LR, int row0, LAS float* G, LAS float* LRS) {
    const int tid = tid_(), d = tid & 63, tq = tid >> 6;
    if (tid < NT * 4) *(LAS f32x4*)(LRS + tid * 4) = *(const f32x4*)(LR + (size_t)row0 * 16 + tid * 4);
    float wa[16];
#pragma unroll
    for (int r = 0; r < 16; ++r) wa[r] = p.w_alpha[(size_t)layer * 16 * 256 + r * 256 + h * 64 + d];
    const float ba = p.b_alpha[layer * 256 + h * 64 + d];
    __syncthreads();
    constexpr int PER = NT / 4;
#pragma unroll 4
    for (int i = 0; i < PER; ++i) { const int t = tq * PER + i;
        const LAS f32x4* lp = (const LAS f32x4*)(LRS + t * 16);
        float z = ba;
#pragma unroll
        for (int r4 = 0; r4 < 4; ++r4) { const f32x4 v = lp[r4]; z += v[0] * wa[r4 * 4] + v[1] * wa[r4 * 4 + 1] + v[2] * wa[r4 * 4 + 2] + v[3] * wa[r4 * 4 + 3]; }
        const float ls = fminf(z, 0.f) - __logf(1.0f + __expf(-fabsf(z)));
        G[t * 64 + d] = ls * (1.0f / 16.0f);
    }
    __syncthreads();
    if (tid < 64) { float run = 0.f;
#pragma unroll 8
        for (int t = 0; t < NT; ++t) { run += G[t * 64 + d]; G[t * 64 + d] = run; } }
    __syncthreads();
}

__device__ void conv_unit(const Params& p, int layer, bool sample, int b_or_pair, int tile, int cs, LAS unsigned char* lds) {
    const bf16_t* U = (const bf16_t*)(p.ws + OFF_U); bf16_t* CVG = (bf16_t*)(p.ws + OFF_CVG);
    LAS bf16_t* ub = (LAS bf16_t*)lds;
    const int tid = tid_(), wid = tid >> 6, lane = tid & 63;
    const int t0 = tile * 64;
    if (!sample) {
        for (int c = tid; c < 94 * 16; c += 256) { const int i = c >> 4, cc = c & 15; const int time = t0 - 30 + i;
            u32x4 v = (u32x4){0u, 0u, 0u, 0u};
            if (time >= 0) v = *(const u32x4*)(U + (size_t)(b_or_pair * SEQ + time) * 512 + cs * 128 + cc * 8);
            *(LAS u32x4*)(ub + i * 128 + cc * 8) = v; }
    } else {
        for (int c = tid; c < 76 * 16; c += 256) { const int i = c >> 4, cc = c & 15; const int sq = i >= 38, ii = i - sq * 38; const int s = b_or_pair * 2 + sq;
            u32x4 v;
            if (ii < 30) { const float* src = p.cache_conv + (((size_t)layer * DEC_B + s) * 30 + ii) * 512 + cs * 128 + cc * 8;
                const f32x4 a = __builtin_nontemporal_load((const f32x4*)src), bb = __builtin_nontemporal_load((const f32x4*)(src + 4));
                v.x = pk2(a[0], a[1]); v.y = pk2(a[2], a[3]); v.z = pk2(bb[0], bb[1]); v.w = pk2(bb[2], bb[3]);
                if (ii >= 8) { float* dst = p.out + OUT_CCS + (((size_t)layer * DEC_B + s) * 30 + (ii - 8)) * 512 + cs * 128 + cc * 8;
                    __builtin_nontemporal_store(a, (f32x4*)dst); __builtin_nontemporal_store(bb, (f32x4*)(dst + 4)); }
            } else v = *(const u32x4*)(U + (size_t)(NPROMPT + s * 8 + (ii - 30)) * 512 + cs * 128 + cc * 8);
            *(LAS u32x4*)(ub + i * 128 + cc * 8) = v; }
    }
    __syncthreads();
    const int gi = wid & 1, half = wid >> 1; const int chl = gi * 64 + lane, ch = cs * 128 + chl;
    float w[31];
#pragma unroll
    for (int j = 0; j < 31; ++j) w[j] = p.conv_w[((size_t)layer * 31 + j) * 512 + ch];
    const float cb = p.conv_b[layer * 512 + ch], lg = p.cn_g[layer * 512 + ch], lb = p.cn_b[layer * 512 + ch];
    const int rb = sample ? half * 38 : half * 32;
    const int nsteps = sample ? 2 : 8;
    const size_t grow0 = sample ? (size_t)(NPROMPT + (b_or_pair * 2 + half) * 8) : (size_t)(b_or_pair * SEQ + t0 + half * 32);
    for (int st = 0; st < nsteps; ++st) {
        float vals[34];
#pragma unroll
        for (int i = 0; i < 34; ++i) vals[i] = bf2f(ub[(rb + st * 4 + i) * 128 + chl]);
#pragma unroll
        for (int q = 0; q < 4; ++q) {
            float x = cb;
#pragma unroll
            for (int j = 0; j < 31; ++j) x = fmaf(w[j], vals[q + j], x);
            const float mu = wave_sum(x) * (1.0f / 64.0f); const float dlt = x - mu;
            const float var = wave_sum(dlt * dlt) * (1.0f / 64.0f);
            const float y = dlt * rsqrtf(var + EPS) * lg + lb;
            const float sv = siluf_(y);
            CVG[(grow0 + st * 4 + q) * 512 + ch] = (bf16_t)(pk2(sv, 0.f) & 0xffffu);
        }
    }
    if (!sample) {
        if (tile == 31) { for (int c = tid; c < 30 * 128; c += 256) { const int j = c >> 7, cc = c & 127;
            p.out[OUT_CCP + (((size_t)layer * BATCH + b_or_pair) * 30 + j) * 512 + cs * 128 + cc] = bf2f(ub[(64 + j) * 128 + cc]); } }
    } else {
        for (int c = tid; c < 2 * 8 * 128; c += 256) { const int sq = c >> 10, j = (c >> 7) & 7, cc = c & 127; const int s = b_or_pair * 2 + sq;
            p.out[OUT_CCS + (((size_t)layer * DEC_B + s) * 30 + 22 + j) * 512 + cs * 128 + cc] = bf2f(ub[(sq * 38 + 30 + j) * 128 + cc]); }
    }
    __syncthreads();
}

__device__ void gla_ds_unit(const Params& p, int layer, int unit, LAS unsigned char* lds) {
    const int h = unit & 3, bc = unit >> 2; const int row0 = bc * 64;
    const bf16_t* Kb = (const bf16_t*)(p.ws + OFF_K); const bf16_t* V = (const bf16_t*)(p.ws + OFF_V); const float* LR = (const float*)(p.ws + OFF_LR);
    float* DS = (float*)(p.ws + OFF_DS) + (size_t)unit * 8192; float* DEC = (float*)(p.ws + OFF_DEC) + (size_t)unit * 64;
    LAS float* G = (LAS float*)lds;
    LAS bf16_t* KT = (LAS bf16_t*)(lds + 16384);
    LAS bf16_t* VT = (LAS bf16_t*)(lds + 16384 + 9216);
    const int tid = tid_(), t = tid >> 2, qd = tid & 3;
    const u32x4* src = (const u32x4*)(Kb + (size_t)(row0 + t) * 256 + h * 64 + qd * 16);
    const u32x4* vs = (const u32x4*)(V + (size_t)(row0 + t) * 512 + h * 128 + qd * 32);
    const u32x4 a = src[0], b = src[1]; u32x4 vreg[4];
#pragma unroll
    for (int c = 0; c < 4; ++c) vreg[c] = vs[c];
    compute_bcum<64>(p, layer, h, LR, row0, G, (LAS float*)(lds + 16384 + 9216 + 18432));
    {
        const unsigned wv[8] = {a.x, a.y, a.z, a.w, b.x, b.y, b.z, b.w};
#pragma unroll
        for (int e = 0; e < 8; ++e) { const int d0 = qd * 16 + 2 * e;
            const float f0 = bflo(wv[e]) * __expf(G[63 * 64 + d0] - G[t * 64 + d0]);
            const float f1 = bfhi(wv[e]) * __expf(G[63 * 64 + d0 + 1] - G[t * 64 + d0 + 1]);
            const unsigned pk = pk2(f0, f1);
            KT[d0 * 72 + t] = (bf16_t)(pk & 0xffffu); KT[(d0 + 1) * 72 + t] = (bf16_t)(pk >> 16); }
#pragma unroll
        for (int c = 0; c < 4; ++c) { const u32x4 a2 = vreg[c]; const unsigned w2[4] = {a2.x, a2.y, a2.z, a2.w};
#pragma unroll
            for (int e = 0; e < 4; ++e) { const int dv = qd * 32 + c * 8 + 2 * e;
                VT[dv * 72 + t] = (bf16_t)(w2[e] & 0xffffu); VT[(dv + 1) * 72 + t] = (bf16_t)(w2[e] >> 16); } }
        if (tid < 64) DEC[tid] = __expf(G[63 * 64 + tid]);
    }
    __syncthreads();
    const int wid = tid >> 6, lane = tid & 63, fr = lane & 15, fq = lane >> 4;
    f32x4 acc[2][4];
#pragma unroll
    for (int m = 0; m < 2; ++m)
#pragma unroll
        for (int n = 0; n < 4; ++n) acc[m][n] = (f32x4){0.f, 0.f, 0.f, 0.f};
#pragma unroll
    for (int kk = 0; kk < 2; ++kk) {
        bf16x8 vf[2], kf[4];
#pragma unroll
        for (int m = 0; m < 2; ++m) vf[m] = *(LAS bf16x8*)(VT + (wid * 32 + m * 16 + fr) * 72 + kk * 32 + fq * 8);
#pragma unroll
        for (int n = 0; n < 4; ++n) kf[n] = *(LAS bf16x8*)(KT + (n * 16 + fr) * 72 + kk * 32 + fq * 8);
#pragma unroll
        for (int m = 0; m < 2; ++m)
#pragma unroll
            for (int n = 0; n < 4; ++n) acc[m][n] = __builtin_amdgcn_mfma_f32_16x16x32_bf16(kf[n], vf[m], acc[m][n], 0, 0, 0);
    }
#pragma unroll
    for (int m = 0; m < 2; ++m)
#pragma unroll
        for (int n = 0; n < 4; ++n) *(f32x4*)(DS + (size_t)(wid * 32 + m * 16 + fr) * 64 + n * 16 + fq * 4) = acc[m][n];
    __syncthreads();
}

__device__ void gla_sample_unit(const Params& p, int layer, int unit, LAS unsigned char* lds) {
    const int h = unit & 3, s = unit >> 2; const int row0 = NPROMPT + s * 8;
    const bf16_t* Q = (const bf16_t*)(p.ws + OFF_Q); const bf16_t* Kb = (const bf16_t*)(p.ws + OFF_K); const bf16_t* V = (const bf16_t*)(p.ws + OFF_V);
    const bf16_t* ZG = (const bf16_t*)(p.ws + OFF_ZG); const float* LR = (const float*)(p.ws + OFF_LR); bf16_t* MIX = (bf16_t*)(p.ws + OFF_BUFA);
    const float* S0 = p.state_gla + (((size_t)layer * DEC_B + s) * 4 + h) * 8192;
    float* SN = p.out + OUT_SGS + (((size_t)layer * DEC_B + s) * 4 + h) * 8192;
    LAS float* G = (LAS float*)lds;
    LAS float* QT = G + 512;
    LAS float* KT = QT + 512;
    LAS float* KD = KT + 512;
    LAS float* DCY = KD + 512;
    LAS float* ATT = DCY + 64;
    LAS float* VV = ATT + 64;
    LAS float* OP = VV + 1024;
    LAS float* RED = OP + 2048;
    compute_bcum<8>(p, layer, h, LR, row0, G, (LAS float*)(lds + 32768));
    const int tid = tid_();
#pragma unroll
    for (int i = 0; i < 2; ++i) { const int e = tid + i * 256, t = e >> 6, d = e & 63;
        const float bc = G[t * 64 + d], bl = G[7 * 64 + d];
        const float q = bf2f(Q[(size_t)(row0 + t) * 256 + h * 64 + d]), k = bf2f(Kb[(size_t)(row0 + t) * 256 + h * 64 + d]);
        QT[e] = q * __expf(bc); KT[e] = k * __expf(-bc); KD[e] = k * __expf(bl - bc);
        if (t == 7) DCY[d] = __expf(bl); }
#pragma unroll
    for (int i = 0; i < 4; ++i) { const int e = tid + i * 256, t = e >> 7, v = e & 127; VV[e] = bf2f(V[(size_t)(row0 + t) * 512 + h * 128 + v]); }
    __syncthreads();
    if (tid < 64) { const int t = tid >> 3, s2 = tid & 7; float a = 0.f;
        if (s2 <= t) { for (int d = 0; d < 64; ++d) a += QT[t * 64 + d] * KT[s2 * 64 + d]; }
        ATT[tid] = a; }
    __syncthreads();
    const int vcol = tid & 127, dh = tid >> 7;
    float o[8], v8[8];
#pragma unroll
    for (int t = 0; t < 8; ++t) { o[t] = 0.f; v8[t] = VV[t * 128 + vcol]; }
    float s0r[32];
#pragma unroll
    for (int dd = 0; dd < 32; ++dd) s0r[dd] = __builtin_nontemporal_load(S0 + (dh * 32 + dd) * 128 + vcol);
#pragma unroll
    for (int dd = 0; dd < 32; ++dd) { const int d = dh * 32 + dd; const float s0 = s0r[dd];
        float sn = s0 * DCY[d];
#pragma unroll
        for (int t = 0; t < 8; ++t) { o[t] = fmaf(QT[t * 64 + d], s0, o[t]); sn = fmaf(KD[t * 64 + d], v8[t], sn); }
        __builtin_nontemporal_store(sn, SN + d * 128 + vcol); }
    if (dh == 0) {
#pragma unroll
        for (int t = 0; t < 8; ++t)
#pragma unroll
            for (int s2 = 0; s2 < 8; ++s2) o[t] = fmaf(ATT[t * 8 + s2], v8[s2], o[t]);
    }
#pragma unroll
    for (int t = 0; t < 8; ++t) OP[(dh * 8 + t) * 128 + vcol] = o[t];
    __syncthreads();
    float val[4];
#pragma unroll
    for (int i = 0; i < 4; ++i) { const int t = dh * 4 + i; val[i] = OP[t * 128 + vcol] + OP[(8 + t) * 128 + vcol];
        const float ps = wave_sum(val[i] * val[i]); if ((tid & 63) == 0) RED[t * 4 + ((tid >> 6) & 1)] = ps; }
    __syncthreads();
    const float gg = p.gla_g[layer * 128 + vcol];
#pragma unroll
    for (int i = 0; i < 4; ++i) { const int t = dh * 4 + i; const float ms = (RED[t * 4] + RED[t * 4 + 1]) * (1.0f / 128.0f);
        const float zg = bf2f(ZG[(size_t)(row0 + t) * 512 + h * 128 + vcol]);
        const float r = val[i] * rsqrtf(ms + EPS) * gg * zg;
        MIX[(size_t)(row0 + t) * 1024 + 512 + h * 128 + vcol] = (bf16_t)(pk2(r, 0.f) & 0xffffu); }
    __syncthreads();
}

__device__ void scan_unit(const Params& p, int layer, int unit) {
    typedef float f32x2 __attribute__((ext_vector_type(2)));
    const int part = unit & 15, h = (unit >> 4) & 3, b = unit >> 6;
    const float* DS = (const float*)(p.ws + OFF_DS); const float* DEC = (const float*)(p.ws + OFF_DEC); bf16_t* SB = (bf16_t*)(p.ws + OFF_SB);
    const int e = part * 512 + tid_() * 2; const int dk = e & 63, dv = e >> 6;
    f32x2 S = (f32x2){0.f, 0.f};
#pragma unroll
    for (int i0 = 0; i0 < 32; i0 += 16) {
        f32x2 cur[16], dc[16];
#pragma unroll
        for (int i = 0; i < 16; ++i) { const size_t ug = (size_t)((b * 32 + i0 + i) * 4 + h);
            cur[i] = __builtin_nontemporal_load((const f32x2*)(DS + ug * 8192 + e)); dc[i] = *(const f32x2*)(DEC + ug * 64 + dk); }
#pragma unroll
        for (int i = 0; i < 16; ++i) { const size_t ug = (size_t)((b * 32 + i0 + i) * 4 + h);
            *(unsigned*)(SB + ug * 8192 + e) = pk2(S[0], S[1]);
            S = S * dc[i] + cur[i]; }
    }
    float* o = p.out + OUT_SGP + (((size_t)layer * BATCH + b) * 4 + h) * 8192;
    __builtin_nontemporal_store(S[0], o + dk * 128 + dv); __builtin_nontemporal_store(S[1], o + (dk + 1) * 128 + dv);
}

__device__ void gla_out_unit(const Params& p, int layer, int unit, LAS unsigned char* lds) {
    const int h = unit & 3, bc = unit >> 2; const int row0 = bc * 64;
    const bf16_t* Q = (const bf16_t*)(p.ws + OFF_Q); const bf16_t* Kb = (const bf16_t*)(p.ws + OFF_K); const bf16_t* V = (const bf16_t*)(p.ws + OFF_V);
    const bf16_t* ZG = (const bf16_t*)(p.ws + OFF_ZG); const float* LR = (const float*)(p.ws + OFF_LR); bf16_t* MIX = (bf16_t*)(p.ws + OFF_BUFA);
    const bf16_t* SB = (const bf16_t*)(p.ws + OFF_SB) + (size_t)unit * 8192;
    LAS float* G = (LAS float*)lds;
    LAS bf16_t* QT = (LAS bf16_t*)(lds + 16384);
    LAS bf16_t* KT = (LAS bf16_t*)(lds + 16384 + 9216);
    LAS bf16_t* VT = (LAS bf16_t*)(lds + 16384 + 18432);
    LAS bf16_t* PP = (LAS bf16_t*)(lds + 16384 + 18432 + 18432);
    const int tid = tid_();
    const int t = tid >> 2, qd = tid & 3;
    const u32x4* qs = (const u32x4*)(Q + (size_t)(row0 + t) * 256 + h * 64 + qd * 16);
    const u32x4* ks = (const u32x4*)(Kb + (size_t)(row0 + t) * 256 + h * 64 + qd * 16);
    const u32x4* vs = (const u32x4*)(V + (size_t)(row0 + t) * 512 + h * 128 + qd * 32);
    const u32x4 qa = qs[0], qb = qs[1], ka = ks[0], kb = ks[1]; u32x4 vreg[4], sreg[4];
#pragma unroll
    for (int c = 0; c < 4; ++c) vreg[c] = vs[c];
#pragma unroll
    for (int c = 0; c < 4; ++c) sreg[c] = __builtin_nontemporal_load((const u32x4*)(SB + (size_t)(tid + c * 256) * 8));
    compute_bcum<64>(p, layer, h, LR, row0, G, (LAS float*)PP);
    {
        const unsigned qw[8] = {qa.x, qa.y, qa.z, qa.w, qb.x, qb.y, qb.z, qb.w}; const unsigned kw[8] = {ka.x, ka.y, ka.z, ka.w, kb.x, kb.y, kb.z, kb.w};
        unsigned qo[8], ko[8];
#pragma unroll
        for (int e = 0; e < 8; ++e) { const int d0 = qd * 16 + 2 * e; const float g0 = G[t * 64 + d0], g1 = G[t * 64 + d0 + 1];
            const float e0 = __expf(g0), e1 = __expf(g1);
            qo[e] = pk2(bflo(qw[e]) * e0, bfhi(qw[e]) * e1);
            ko[e] = pk2(bflo(kw[e]) * __builtin_amdgcn_rcpf(e0), bfhi(kw[e]) * __builtin_amdgcn_rcpf(e1)); }
        *(LAS u32x4*)(QT + t * 72 + qd * 16) = (u32x4){qo[0], qo[1], qo[2], qo[3]}; *(LAS u32x4*)(QT + t * 72 + qd * 16 + 8) = (u32x4){qo[4], qo[5], qo[6], qo[7]};
        *(LAS u32x4*)(KT + t * 72 + qd * 16) = (u32x4){ko[0], ko[1], ko[2], ko[3]}; *(LAS u32x4*)(KT + t * 72 + qd * 16 + 8) = (u32x4){ko[4], ko[5], ko[6], ko[7]};
#pragma unroll
        for (int c = 0; c < 4; ++c) { const u32x4 a2 = vreg[c]; const unsigned w2[4] = {a2.x, a2.y, a2.z, a2.w};
#pragma unroll
            for (int e = 0; e < 4; ++e) { const int dv = qd * 32 + c * 8 + 2 * e;
                VT[dv * 72 + t] = (bf16_t)(w2[e] & 0xffffu); VT[(dv + 1) * 72 + t] = (bf16_t)(w2[e] >> 16); } }
    }
    __syncthreads();
    {
#pragma unroll
        for (int c = 0; c < 4; ++c) { const int ci = tid + c * 256, r = ci >> 3, ch = ci & 7;
            *(LAS u32x4*)(lds + r * 128 + ((ch ^ (r & 7)) * 16)) = sreg[c]; }
    }
    __syncthreads();
    const int wid = tid >> 6, lane = tid & 63, fr = lane & 15, fq = lane >> 4;
    LAS bf16_t* PW = PP + wid * 16 * 72;
    {
        bf16x8 qf[2];
#pragma unroll
        for (int kk = 0; kk < 2; ++kk) qf[kk] = *(LAS bf16x8*)(QT + (wid * 16 + fr) * 72 + kk * 32 + fq * 8);
#pragma unroll
        for (int n = 0; n < 4; ++n) {
            f32x4 a = (f32x4){0.f, 0.f, 0.f, 0.f};
#pragma unroll
            for (int kk = 0; kk < 2; ++kk) { const bf16x8 kf = *(LAS bf16x8*)(KT + (n * 16 + fr) * 72 + kk * 32 + fq * 8);
                a = __builtin_amdgcn_mfma_f32_16x16x32_bf16(kf, qf[kk], a, 0, 0, 0); }
            const int tg = wid * 16 + fr, sg = n * 16 + fq * 4;
            u32x2 w; w.x = pk2(sg <= tg ? a[0] : 0.f, sg + 1 <= tg ? a[1] : 0.f); w.y = pk2(sg + 2 <= tg ? a[2] : 0.f, sg + 3 <= tg ? a[3] : 0.f);
            *(LAS u32x2*)(PW + fr * 72 + n * 16 + fq * 4) = w;
        }
    }
    __builtin_amdgcn_s_waitcnt(0xc07f);
    __builtin_amdgcn_wave_barrier();
    f32x4 acc[8];
#pragma unroll
    for (int n = 0; n < 8; ++n) acc[n] = (f32x4){0.f, 0.f, 0.f, 0.f};
#pragma unroll
    for (int kk = 0; kk < 2; ++kk) {
        const bf16x8 qf = *(LAS bf16x8*)(QT + (wid * 16 + fr) * 72 + kk * 32 + fq * 8);
        const bf16x8 pf = *(LAS bf16x8*)(PW + fr * 72 + kk * 32 + fq * 8);
#pragma unroll
        for (int n = 0; n < 8; ++n) {
            const bf16x8 sf = *(LAS bf16x8*)(lds + (n * 16 + fr) * 128 + (((kk * 4 + fq) ^ (fr & 7)) * 16));
            const bf16x8 vf = *(LAS bf16x8*)(VT + (n * 16 + fr) * 72 + kk * 32 + fq * 8);
            acc[n] = __builtin_amdgcn_mfma_f32_16x16x32_bf16(sf, qf, acc[n], 0, 0, 0);
            acc[n] = __builtin_amdgcn_mfma_f32_16x16x32_bf16(vf, pf, acc[n], 0, 0, 0);
        }
    }
    float ss = 0.f;
#pragma unroll
    for (int n = 0; n < 8; ++n) ss += (acc[n][0] * acc[n][0] + acc[n][1] * acc[n][1]) + (acc[n][2] * acc[n][2] + acc[n][3] * acc[n][3]);
    ss += __shfl_xor(ss, 16); ss += __shfl_xor(ss, 32);
    const float rinv = rsqrtf(ss * (1.0f / 128.0f) + EPS);
    const size_t row = (size_t)(row0 + wid * 16 + fr);
#pragma unroll
    for (int n = 0; n < 8; ++n) { const int dv = n * 16 + fq * 4; const f32x4 gg = *(const f32x4*)(p.gla_g + layer * 128 + dv);
        const u32x2 z = *(const u32x2*)(ZG + row * 512 + h * 128 + dv); u32x2 w;
        w.x = pk2(acc[n][0] * rinv * gg[0] * bflo(z.x), acc[n][1] * rinv * gg[1] * bfhi(z.x));
        w.y = pk2(acc[n][2] * rinv * gg[2] * bflo(z.y), acc[n][3] * rinv * gg[3] * bfhi(z.y));
        *(u32x2*)(MIX + row * 1024 + 512 + h * 128 + dv) = w; }
    __syncthreads();
}


#define XB_TMO      128
#define XB_XCNT(j)  (256  + 64 * (j))
#define XB_XSUB(j)  (1280 + 64 * (j))
#define XB_XGEN(j)  (2304 + 64 * (j))
#define XB_TOP      3328
#define XB_TOPGEN   3392
#define XCD_BAR_WORDS 3456
#define XB_SPIN_CAP (1u << 22)
__device__ __forceinline__ unsigned xb_ld(unsigned* p)              { return __hip_atomic_load(p, __ATOMIC_RELAXED, __HIP_MEMORY_SCOPE_AGENT); }
__device__ __forceinline__ unsigned xb_add(unsigned* p, unsigned v) { return __hip_atomic_fetch_add(p, v, __ATOMIC_RELAXED, __HIP_MEMORY_SCOPE_AGENT); }
__device__ __forceinline__ unsigned xb_xcc_id() { return (unsigned)__builtin_amdgcn_s_getreg((3 << 11) | 20) & 0xFu; }
#define XB_SPIN(cond, bar) do { unsigned _sp = 0; while (cond) { __builtin_amdgcn_s_sleep(1); \
    if ((++_sp & 255u) == 0u) { if (xb_ld(&(bar)[XB_TMO])) break; if (_sp > XB_SPIN_CAP) { atomicAdd(&(bar)[XB_TMO], 1u); break; } } } } while (0)
struct XcdBarrier { unsigned* bar; unsigned x; volatile LAS unsigned* st; };
__device__ __forceinline__ XcdBarrier xcd_barrier_post(unsigned* bar, volatile LAS unsigned* st) {
    XcdBarrier b; b.bar = bar; b.x = xb_xcc_id(); b.st = st;
    if (threadIdx.x == 0) (void)xb_add(&bar[XB_XCNT(b.x)], 1u);
    return b;
}
__device__ __forceinline__ void xcd_barrier_complete(unsigned* bar, unsigned x, unsigned& nloc, unsigned& nx) {
    const unsigned G = gridDim.x * gridDim.y * gridDim.z;
    unsigned sum, cnt, mine, sp = 0u;
    for (;;) {
        sum = 0u; cnt = 0u; mine = 0u;
#pragma unroll
        for (unsigned j = 0; j < 16; ++j) { const unsigned c = xb_ld(&bar[XB_XCNT(j)]); sum += c; cnt += (c > 0u) ? 1u : 0u; mine = (j == x) ? c : mine; }
        if (sum == G) break;
        __builtin_amdgcn_s_sleep(1);
        if ((++sp & 255u) == 0u) { if (xb_ld(&bar[XB_TMO])) break; if (sp > XB_SPIN_CAP) { atomicAdd(&bar[XB_TMO], 1u); break; } }
    }
    nloc = mine > 0u ? mine : 1u; nx = cnt > 0u ? cnt : 1u;
}
__device__ __forceinline__ void xcd_barrier(const XcdBarrier& b) {
    asm volatile("s_waitcnt vmcnt(0)" ::: "memory");
    __syncthreads();
    if (threadIdx.x == 0) {
        unsigned* bar = b.bar;
        __builtin_amdgcn_s_waitcnt(0);
        unsigned nloc = b.st[0], nx = b.st[1];
        if (nloc == 0u) { xcd_barrier_complete(bar, b.x, nloc, nx); b.st[0] = nloc; b.st[1] = nx; }
        const unsigned old = xb_add(&bar[XB_XSUB(b.x)], 1u);
        const unsigned gen = old / nloc;
        if (old + 1u == (gen + 1u) * nloc) {
            __builtin_amdgcn_fence(__ATOMIC_RELEASE, "agent");
            asm volatile("s_waitcnt vmcnt(0)" ::: "memory");
            const unsigned og = xb_add(&bar[XB_TOP], 1u);
            const unsigned tg = og / nx;
            if (og + 1u == (tg + 1u) * nx) xb_add(&bar[XB_TOPGEN], 1u);
            else XB_SPIN(xb_add(&bar[XB_TOPGEN], 0u) == tg, bar);
            __builtin_amdgcn_fence(__ATOMIC_ACQUIRE, "agent");
            xb_add(&bar[XB_XGEN(b.x)], 1u);
            asm volatile("s_waitcnt vmcnt(0)" ::: "memory");
        } else {
            XB_SPIN(xb_ld(&bar[XB_XGEN(b.x)]) == gen, bar);
            __builtin_amdgcn_fence(__ATOMIC_ACQUIRE, "agent");
            asm volatile("s_waitcnt vmcnt(0)" ::: "memory");
        }
    }
    __syncthreads();
}

#ifndef REP_PREP
#define REP_PREP 1
#endif
#ifndef REP_IN
#define REP_IN 1
#endif
#ifndef REP_P2
#define REP_P2 1
#endif
#ifndef REP_P3
#define REP_P3 1
#endif
#ifndef REP_P4
#define REP_P4 1
#endif
#ifndef REP_OUT
#define REP_OUT 1
#endif
#ifndef REP_SYNC
#define REP_SYNC 1
#endif
#ifndef PROBE_MASK
#define PROBE_MASK 0
#endif
#define PROBE_MULT 4
#define TSTAMP() do { if (PROBE_MASK) { if (blockIdx.x == 0 && threadIdx.x == 0) { tsl[tsi] = __builtin_amdgcn_s_memrealtime(); } ++tsi; } } while (0)
#define GSYNC() do { for (int _r = 0; _r < REP_SYNC; ++_r) xcd_barrier(xb); TSTAMP(); } while (0)
__global__ void __launch_bounds__(256, 2) hymba_mega(Params p) {
    __shared__ __attribute__((aligned(16))) unsigned char smem[66560];
    LAS unsigned char* lds = (LAS unsigned char*)smem;
    cg::grid_group grid = cg::this_grid();
    const int nb = gridDim.x, bid = blockIdx.x;
    if (p.ws == nullptr) grid.sync();
    volatile LAS unsigned* xst = (volatile LAS unsigned*)(lds + 66048);
    if (threadIdx.x == 0) { xst[0] = 0u; xst[1] = 0u; }
    __syncthreads();
    XcdBarrier xb = xcd_barrier_post((unsigned*)(p.ws + OFF_BAR), xst);
    volatile LAS unsigned long long* tsl = (volatile LAS unsigned long long*)(lds + 66064); int tsi = 0;
    TSTAMP();
    float* SSQ = (float*)(p.ws + OFF_SSQ);
    bf16_t* BUFA = (bf16_t*)(p.ws + OFF_BUFA); bf16_t* BUFB = (bf16_t*)(p.ws + OFF_BUFB);

    for (int rep = 0; rep < REP_PREP; ++rep) phase_prep(p, lds);
    GSYNC();
#pragma unroll 1
    for (int layer = 0; layer < 2; ++layer) {
        {
            EpiIn e; e.ssq = SSQ; e.U = (bf16_t*)(p.ws + OFF_U); e.ZC = (bf16_t*)(p.ws + OFF_ZC); e.Q = (bf16_t*)(p.ws + OFF_Q); e.Kb = (bf16_t*)(p.ws + OFF_K);
            e.V = (bf16_t*)(p.ws + OFF_V); e.ZG = (bf16_t*)(p.ws + OFF_ZG); e.LR = (float*)(p.ws + OFF_LR);
            const bf16_t* A = layer == 0 ? BUFA : BUFB; const bf16_t* Bt = (const bf16_t*)(p.ws + OFF_WIN) + (size_t)layer * NIN * 1024;
            int pm, pn;
            for (int rep = 0; rep < REP_IN; ++rep)
            for (int it = 0; gemm_next(it, 25, pm, pn); ++it) gemm_unit(A, 1024, Bt, 1024, 1024, pm * 128, pn * 128, lds, e, pn);
        }
        GSYNC();
        for (int rep = 0; rep < REP_P2; ++rep)
        for (int u = bid; u < 2816; u += nb) {
            if (u < 1024) gla_ds_unit(p, layer, u, lds);
            else if (u < 2048) { const int v = u - 1024; conv_unit(p, layer, false, v >> 7, (v >> 2) & 31, v & 3, lds); }
            else if (u < 2304) { const int v = u - 2048; conv_unit(p, layer, true, v >> 2, 0, v & 3, lds); }
            else gla_sample_unit(p, layer, u - 2304, lds);
        }
        if (layer == 0) { for (int u = 416 + bid; u < 1152; u += nb) prep_w_unit(p, u, lds); if (bid == nb - 1) prep_w_unit(p, 1153, lds); }
        GSYNC();
        {
            for (int rep = 0; rep < REP_P3; ++rep) {
            for (int u = bid; u < 512; u += nb) scan_unit(p, layer, u);
            EpiPw e; e.bias = p.b_pw + layer * 512; e.ZC = (const bf16_t*)(p.ws + OFF_ZC); e.MIX = BUFA;
            const bf16_t* A = (const bf16_t*)(p.ws + OFF_CVG); const bf16_t* Bt = (const bf16_t*)(p.ws + OFF_WPW) + (size_t)layer * 512 * 512;
            int pm, pn;
            for (int it = 0; gemm_next(it, 4, pm, pn); ++it) gemm_unit(A, 512, Bt, 512, 512, pm * 128, pn * 128, lds, e, pn); }
        }
        GSYNC();
        for (int rep = 0; rep < REP_P4; ++rep)
        for (int u = bid; u < 1024; u += nb) gla_out_unit(p, layer, u, lds);
        GSYNC();
        {
            EpiOut e; e.p = &p; e.layer = layer; e.XO = p.out + OUT_Y; e.XB = BUFB; e.ssq = SSQ;
            const bf16_t* Bt = (const bf16_t*)(p.ws + OFF_WOUT) + (size_t)layer * 1024 * 1024;
            int pm, pn;
            for (int rep = 0; rep < (layer == 0 ? REP_OUT : 1); ++rep)
            for (int it = 0; gemm_next(it, 8, pm, pn); ++it) gemm_unit(BUFA, 1024, Bt, 1024, 1024, pm * 128, pn * 128, lds, e, pn);
        }
        GSYNC();
    }
    {
        const int tid0 = tid_(); const int wid = tid0 >> 6, lane = tid0 & 63;
        for (int row = bid * 4 + wid; row < NTOK; row += nb * 4) {
            float s = lane < 16 ? SSQ[(size_t)row * 16 + lane] : 0.f; s = wave_sum(s);
            const float r = rsqrtf(s * (1.0f / 1024.0f) + EPS);
            float* xr = p.out + OUT_Y + (size_t)row * 1024;
#pragma unroll
            for (int i = 0; i < 4; ++i) { const int col = i * 256 + lane * 4; f32x4 a = *(const f32x4*)(xr + col); const f32x4 g = *(const f32x4*)(p.final_g + col);
                a = a * r * g; __builtin_nontemporal_store(a, (f32x4*)(xr + col)); }
        }
    }
    if (PROBE_MASK) {
        if (blockIdx.x == 0 && threadIdx.x == 0) {
            const unsigned long long tend = __builtin_amdgcn_s_memrealtime(); tsl[12] = tend;
            unsigned long long d = 0;
            for (int i = 0; i < 12; ++i) if ((PROBE_MASK >> i) & 1) d += tsl[i + 1] - tsl[i];
            while (__builtin_amdgcn_s_memrealtime() - tend < (unsigned long long)PROBE_MULT * d) __builtin_amdgcn_s_sleep(8);
        }
    }
}

extern "C" void kernel_launch(void* const* d_in, const int* in_sizes, int n_in, void* d_out, int out_size, void* d_ws, size_t ws_size, hipStream_t stream) {
    static int grid_blocks = 0;
    if (!grid_blocks) {
        int dev = 0, cus = 0, per_cu = 0;
        (void)hipGetDevice(&dev);
        (void)hipDeviceGetAttribute(&cus, hipDeviceAttributeMultiprocessorCount, dev);
        (void)hipOccupancyMaxActiveBlocksPerMultiprocessor(&per_cu, hymba_mega, 256, 0);
        if (per_cu > 2) per_cu = 2;
        if (per_cu < 1) per_cu = 1;
        grid_blocks = cus * per_cu;
    }
    if (ws_size < WS_NEED) fprintf(stderr, "workspace too small: %zu < %zu\n", ws_size, (size_t)WS_NEED);
    Params p{};
    p.x_prompt = (const float*)d_in[0]; p.x_sample = (const float*)d_in[1]; p.cache_conv = (const float*)d_in[2]; p.state_gla = (const float*)d_in[3];
    p.norm_g = (const float*)d_in[4]; p.w_in = (const float*)d_in[5]; p.w_alpha = (const float*)d_in[6]; p.b_alpha = (const float*)d_in[7];
    p.conv_w = (const float*)d_in[8]; p.conv_b = (const float*)d_in[9]; p.cn_g = (const float*)d_in[10]; p.cn_b = (const float*)d_in[11];
    p.w_pw = (const float*)d_in[12]; p.b_pw = (const float*)d_in[13]; p.gla_g = (const float*)d_in[14]; p.w_out = (const float*)d_in[15]; p.final_g = (const float*)d_in[16];
    p.out = (float*)d_out; p.ws = (unsigned char*)d_ws;
    (void)hipMemsetAsync((unsigned char*)d_ws + OFF_BAR, 0, 16384, stream);
    void* args[] = {&p};
    hipError_t e = hipLaunchCooperativeKernel((void*)hymba_mega, dim3(grid_blocks), dim3(256), args, 0, stream);
    if (e != hipSuccess) fprintf(stderr, "cooperative launch failed: %s (grid %d)\n", hipGetErrorString(e), grid_blocks);
}
```
